# Optimizing an MI355X kernel written in HIP

```python
import jax, jax.numpy as jnp
from jax import lax
import numpy as np

D_MODEL = 2048
BATCH = 8
SEQ = 4096
DEPTH = 4

NORM_EPS = 1e-6
D_FF = 5632
D_MIX = D_MODEL

LRU_WIDTH = D_MIX // 4
LRU_BLOCKS = 8
LRU_BLOCK_SIZE = LRU_WIDTH // LRU_BLOCKS
CONV_WIDTH = 4
LRU_C = 8.0

HEAD_DIM = 128
NSA_HEADS = (D_MIX // 2) // HEAD_DIM
NSA_KV_HEADS = 2
NSA_GROUP = NSA_HEADS // NSA_KV_HEADS
NSA_WIDTH = NSA_HEADS * HEAD_DIM
NSA_KV_WIDTH = NSA_KV_HEADS * HEAD_DIM
ROPE_DIM = HEAD_DIM // 4
ROPE_THETA = 500000.0
CMP_BLOCK = 32
CMP_STRIDE = 16
SEL_BLOCK = 64
N_SELECT = 16
WINDOW = 512
Q_BLOCK = 128
MASK_VALUE = 1e30

GLA_DV = 128
GLA_HEADS = (D_MIX // 4) // GLA_DV
GLA_DK = GLA_DV // 2
GLA_WIDTH = GLA_HEADS * GLA_DV
GLA_QK_WIDTH = GLA_HEADS * GLA_DK
GLA_RANK = 16
GLA_TAU = 16.0
GLA_CHUNK = 64

IN_SPLITS = (LRU_WIDTH, LRU_WIDTH, NSA_WIDTH) + (NSA_KV_WIDTH,) * 6 + (
    NSA_HEADS * 3, GLA_QK_WIDTH, GLA_QK_WIDTH, GLA_WIDTH, GLA_WIDTH, GLA_RANK)
D_IN = sum(IN_SPLITS)

kernel_name = 'hymba_style_rglru_nsa_gla_macaron'


def rms_norm(x, g):
    xf = x.astype(jnp.float32)
    y = xf * lax.rsqrt(jnp.mean(xf * xf, axis=-1, keepdims=True) + NORM_EPS)
    return (y * g.astype(jnp.float32)).astype(x.dtype)


def swiglu(h, w_gate, w_up, w_down):
    return (jax.nn.silu(h @ w_gate) * (h @ w_up)) @ w_down


def rope_tables(T):
    inv = 1.0 / (ROPE_THETA ** (jnp.arange(0, ROPE_DIM, 2, dtype=jnp.float32) / ROPE_DIM))
    ang = jnp.arange(T, dtype=jnp.float32)[:, None] * inv[None, :]
    return jnp.cos(ang), jnp.sin(ang)


def partial_rope(x, cos, sin):
    half = ROPE_DIM // 2
    x1, x2, xp = x[..., :half], x[..., half:ROPE_DIM], x[..., ROPE_DIM:]
    rot = jnp.concatenate([x1 * cos - x2 * sin, x2 * cos + x1 * sin], axis=-1)
    return jnp.concatenate([rot.astype(x.dtype), xp], axis=-1)


def split_cols(p):
    idx = np.cumsum(np.array(IN_SPLITS))[:-1].tolist()
    return jnp.split(p, idx, axis=-1)


def block_diag_linear(x, w, b):
    B, T, W = x.shape
    xb = x.reshape(B, T, LRU_BLOCKS, LRU_BLOCK_SIZE)
    return jnp.einsum('btni,nio->btno', xb, w).reshape(B, T, W) + b


def rg_lru(x, ga_w, ga_b, gx_w, gx_b, lam):
    f32 = jnp.float32
    r = jax.nn.sigmoid(block_diag_linear(x, ga_w, ga_b).astype(f32))
    i = jax.nn.sigmoid(block_diag_linear(x, gx_w, gx_b).astype(f32))
    log_a = -LRU_C * r * jax.nn.softplus(-lam.astype(f32))
    a = jnp.exp(log_a)
    mult = jnp.sqrt(-jnp.expm1(2.0 * log_a))
    bx = mult * i * x.astype(f32)

    def step(h, inp):
        a_t, b_t = inp
        h = a_t * h + b_t
        return h, h

    h0 = jnp.zeros((x.shape[0], x.shape[2]), f32)
    _, hs = lax.scan(step, h0, (a.swapaxes(0, 1), bx.swapaxes(0, 1)))
    return hs.swapaxes(0, 1).astype(x.dtype)


def recurrent_block(u, y_in, conv_w, conv_b, ga_w, ga_b, gx_w, gx_b, lam):
    xc = lax.conv_general_dilated(
        u, conv_w[:, None, :], window_strides=(1,), padding=[(CONV_WIDTH - 1, 0)],
        dimension_numbers=('NWC', 'WIO', 'NWC'), feature_group_count=u.shape[-1]) + conv_b
    h = rg_lru(xc, ga_w, ga_b, gx_w, gx_b, lam)
    return h * jax.nn.gelu(y_in)


def compress(k, pe, w1, w2):
    T = k.shape[2]
    nc = (T - CMP_BLOCK) // CMP_STRIDE + 1
    idx = np.arange(nc)[:, None] * CMP_STRIDE + np.arange(CMP_BLOCK)[None, :]
    blocks = k[:, :, idx] + pe
    flat = blocks.reshape(blocks.shape[0], blocks.shape[1], nc, CMP_BLOCK * HEAD_DIM)
    return jax.nn.gelu(flat @ w1) @ w2


def gather_blocks(blocks, idx):
    return jax.vmap(jax.vmap(lambda bl, ix: bl[ix]))(blocks, idx)


def masked_softmax(s, mask):
    return jax.nn.softmax(jnp.where(mask, s, -MASK_VALUE), axis=-1)


def nsa_mixer(q, k_cmp, v_cmp, k_sel, v_sel, k_win, v_win, gate_logits, gate_b,
              q_norm, kc_norm, ks_norm, kw_norm, pe_k, w1_k, w2_k, pe_v, w1_v, w2_v, cos, sin):
    B, T, _ = q.shape
    KV, G, HD = NSA_KV_HEADS, NSA_GROUP, HEAD_DIM
    f32 = jnp.float32
    scale = HEAD_DIM ** -0.5

    def to_heads(t, n):
        return t.reshape(B, T, n, HD).transpose(0, 2, 1, 3)

    qh = rms_norm(to_heads(q, NSA_HEADS), q_norm)
    q_c = qh.reshape(B, KV, G, T, HD)
    q_r = partial_rope(qh, cos, sin).reshape(B, KV, G, T, HD)

    kc = rms_norm(compress(to_heads(k_cmp, KV), pe_k, w1_k, w2_k), kc_norm)
    vc = compress(to_heads(v_cmp, KV), pe_v, w1_v, w2_v)
    nc = kc.shape[2]

    ns = T // SEL_BLOCK
    n_sel = min(N_SELECT, ns)
    ks = partial_rope(rms_norm(to_heads(k_sel, KV), ks_norm), cos, sin)
    ks_blocks = ks.reshape(B, KV, ns, SEL_BLOCK, HD)
    vs_blocks = to_heads(v_sel, KV).reshape(B, KV, ns, SEL_BLOCK, HD)

    pad = ((0, 0), (0, 0), (WINDOW, 0), (0, 0))
    kw_pad = jnp.pad(partial_rope(rms_norm(to_heads(k_win, KV), kw_norm), cos, sin), pad)
    vw_pad = jnp.pad(to_heads(v_win, KV), pad)

    gates = jax.nn.sigmoid((gate_logits + gate_b).astype(f32)).astype(q.dtype)
    gates = gates.reshape(B, T, KV, G, 3).transpose(0, 2, 3, 1, 4)

    cmp_start = np.arange(nc) * CMP_STRIDE
    sel_start = np.arange(ns) * SEL_BLOCK
    cmp_end = jnp.asarray(cmp_start + CMP_BLOCK - 1)
    overlap = jnp.asarray(((cmp_start[:, None] < sel_start[None, :] + SEL_BLOCK) &
                           (cmp_start[:, None] + CMP_BLOCK > sel_start[None, :])).astype(np.float32))
    sel_ids = jnp.arange(ns)

    def q_block(qb):
        s = qb * Q_BLOCK
        t = s + jnp.arange(Q_BLOCK)
        qc = lax.dynamic_slice_in_dim(q_c, s, Q_BLOCK, axis=3)
        qr = lax.dynamic_slice_in_dim(q_r, s, Q_BLOCK, axis=3)
        g = lax.dynamic_slice_in_dim(gates, s, Q_BLOCK, axis=3)

        sc = jnp.einsum('bkgqd,bknd->bkgqn', qc, kc).astype(f32) * scale
        cmask = cmp_end[None, :] <= t[:, None]
        pc = jnp.where(cmask, masked_softmax(sc, cmask), 0.0)
        o_cmp = jnp.einsum('bkgqn,bknd->bkgqd', pc.astype(vc.dtype), vc)

        imp = jnp.einsum('bkgqn,ns->bkqs', pc, overlap)
        cur = t // SEL_BLOCK
        forced = (sel_ids[None, :] == 0) | (sel_ids[None, :] == cur[:, None]) | (sel_ids[None, :] == cur[:, None] - 1)
        valid = sel_ids[None, :] * SEL_BLOCK <= t[:, None]
        imp = jnp.where(forced, MASK_VALUE, jnp.where(valid, imp, -MASK_VALUE))
        _, sel = lax.top_k(imp, n_sel)
        k_g = gather_blocks(ks_blocks, sel)
        v_g = gather_blocks(vs_blocks, sel)
        ss = jnp.einsum('bkgqd,bkqnjd->bkgqnj', qr, k_g).astype(f32) * scale
        kpos_sel = sel[..., None] * SEL_BLOCK + jnp.arange(SEL_BLOCK)
        smask = (kpos_sel <= t[:, None, None])[:, :, None]
        ss = jnp.where(smask, ss, -MASK_VALUE)
        ps = jax.nn.softmax(ss.reshape(ss.shape[:4] + (n_sel * SEL_BLOCK,)), axis=-1).reshape(ss.shape)
        o_sel = jnp.einsum('bkgqnj,bkqnjd->bkgqd', ps.astype(v_g.dtype), v_g)

        k_w = lax.dynamic_slice_in_dim(kw_pad, s, WINDOW + Q_BLOCK, axis=2)
        v_w = lax.dynamic_slice_in_dim(vw_pad, s, WINDOW + Q_BLOCK, axis=2)
        kpos = s - WINDOW + jnp.arange(WINDOW + Q_BLOCK)
        wmask = (kpos[None, :] <= t[:, None]) & (kpos[None, :] > t[:, None] - WINDOW) & (kpos[None, :] >= 0)
        sw = jnp.einsum('bkgqd,bkjd->bkgqj', qr, k_w).astype(f32) * scale
        pw = masked_softmax(sw, wmask)
        o_win = jnp.einsum('bkgqj,bkjd->bkgqd', pw.astype(v_w.dtype), v_w)

        return g[..., 0:1] * o_cmp + g[..., 1:2] * o_sel + g[..., 2:3] * o_win

    outs = lax.map(q_block, jnp.arange(T // Q_BLOCK))
    return outs.transpose(1, 0, 4, 2, 3, 5).reshape(B, T, NSA_WIDTH)


def gla_mixer(q, k, v, g, a_lr, a_w2, a_b, out_norm):
    B, T, _ = q.shape
    n = T // GLA_CHUNK
    f32 = jnp.float32
    log_alpha = jax.nn.log_sigmoid((a_lr @ a_w2 + a_b).astype(f32)) / GLA_TAU

    def chunks(t, d):
        return t.reshape(B, n, GLA_CHUNK, GLA_HEADS, d).transpose(1, 0, 3, 2, 4).astype(f32)

    qc = chunks(q, GLA_DK) * GLA_DK ** -0.5
    kc = chunks(k, GLA_DK)
    vc = chunks(v, GLA_DV)
    lc = chunks(log_alpha, GLA_DK)
    causal = jnp.tril(jnp.ones((GLA_CHUNK, GLA_CHUNK), dtype=bool))[:, :, None]

    def step(S, inp):
        q_, k_, v_, la = inp
        b = jnp.cumsum(la, axis=2)
        o_inter = jnp.einsum('bhid,bhde->bhie', q_ * jnp.exp(b), S)
        decay = jnp.exp(jnp.where(causal, b[:, :, :, None] - b[:, :, None], -jnp.inf))
        A = jnp.einsum('bhid,bhjd,bhijd->bhij', q_, k_, decay)
        o = o_inter + jnp.einsum('bhij,bhje->bhie', A, v_)
        b_last = b[:, :, -1]
        S = jnp.exp(b_last)[..., None] * S + jnp.einsum(
            'bhjd,bhje->bhde', k_ * jnp.exp(b_last[:, :, None] - b), v_)
        return S, o

    S0 = jnp.zeros((B, GLA_HEADS, GLA_DK, GLA_DV), f32)
    _, o = lax.scan(step, S0, (qc, kc, vc, lc))
    o = o.transpose(1, 0, 3, 2, 4).reshape(B, T, GLA_HEADS, GLA_DV)
    o = rms_norm(o, out_norm).reshape(B, T, GLA_WIDTH)
    return (o * jax.nn.silu(g.astype(f32))).astype(q.dtype)


def setup_inputs(seed: int = 0) -> dict:
    key = jax.random.key(seed)
    keys = iter(jax.random.split(key, 64))
    L = DEPTH

    def nrm(shape, scale):
        return scale * jax.random.normal(next(keys), shape, jnp.float32)

    def gain(shape):
        return 1.0 + 0.02 * jax.random.normal(next(keys), shape, jnp.float32)

    u = jax.random.uniform(next(keys), (L, LRU_WIDTH), jnp.float32, 0.9 ** 2, 0.999 ** 2)
    lru_lambda = -jnp.log(jnp.expm1(-0.5 * jnp.log(u)))
    return {
        'x': nrm((BATCH, SEQ, D_MODEL), 1.0),
        'ffn1_norm': gain((L, D_MODEL)),
        'ffn1_w_gate': nrm((L, D_MODEL, D_FF), D_MODEL ** -0.5),
        'ffn1_w_up': nrm((L, D_MODEL, D_FF), D_MODEL ** -0.5),
        'ffn1_w_down': nrm((L, D_FF, D_MODEL), D_FF ** -0.5),
        'mix_norm': gain((L, D_MODEL)),
        'w_in': nrm((L, D_MODEL, D_IN), D_MODEL ** -0.5),
        'lru_conv_w': nrm((L, CONV_WIDTH, LRU_WIDTH), CONV_WIDTH ** -0.5),
        'lru_conv_b': nrm((L, LRU_WIDTH), 0.02),
        'lru_gate_a_w': nrm((L, LRU_BLOCKS, LRU_BLOCK_SIZE, LRU_BLOCK_SIZE), LRU_BLOCK_SIZE ** -0.5),
        'lru_gate_a_b': nrm((L, LRU_WIDTH), 0.02),
        'lru_gate_x_w': nrm((L, LRU_BLOCKS, LRU_BLOCK_SIZE, LRU_BLOCK_SIZE), LRU_BLOCK_SIZE ** -0.5),
        'lru_gate_x_b': nrm((L, LRU_WIDTH), 0.02),
        'lru_lambda': lru_lambda,
        'lru_out_norm': gain((L, LRU_WIDTH)),
        'nsa_q_norm': gain((L, HEAD_DIM)),
        'nsa_k_cmp_norm': gain((L, HEAD_DIM)),
        'nsa_k_sel_norm': gain((L, HEAD_DIM)),
        'nsa_k_win_norm': gain((L, HEAD_DIM)),
        'nsa_cmp_pe_k': nrm((L, CMP_BLOCK, HEAD_DIM), 0.1),
        'nsa_cmp_w1_k': nrm((L, CMP_BLOCK * HEAD_DIM, HEAD_DIM), (CMP_BLOCK * HEAD_DIM) ** -0.5),
        'nsa_cmp_w2_k': nrm((L, HEAD_DIM, HEAD_DIM), HEAD_DIM ** -0.5),
        'nsa_cmp_pe_v': nrm((L, CMP_BLOCK, HEAD_DIM), 0.1),
        'nsa_cmp_w1_v': nrm((L, CMP_BLOCK * HEAD_DIM, HEAD_DIM), (CMP_BLOCK * HEAD_DIM) ** -0.5),
        'nsa_cmp_w2_v': nrm((L, HEAD_DIM, HEAD_DIM), HEAD_DIM ** -0.5),
        'nsa_gate_b': nrm((L, NSA_HEADS * 3), 0.02),
        'nsa_out_norm': gain((L, NSA_WIDTH)),
        'gla_a_w2': nrm((L, GLA_RANK, GLA_QK_WIDTH), GLA_RANK ** -0.5),
        'gla_a_b': nrm((L, GLA_QK_WIDTH), 0.02),
        'gla_out_norm': gain((L, GLA_DV)),
        'w_out': nrm((L, D_MIX, D_MODEL), D_MIX ** -0.5),
        'ffn2_norm': gain((L, D_MODEL)),
        'ffn2_w_gate': nrm((L, D_MODEL, D_FF), D_MODEL ** -0.5),
        'ffn2_w_up': nrm((L, D_MODEL, D_FF), D_MODEL ** -0.5),
        'ffn2_w_down': nrm((L, D_FF, D_MODEL), D_FF ** -0.5),
    }


def reference(x, ffn1_norm, ffn1_w_gate, ffn1_w_up, ffn1_w_down, mix_norm, w_in,
              lru_conv_w, lru_conv_b, lru_gate_a_w, lru_gate_a_b, lru_gate_x_w, lru_gate_x_b,
              lru_lambda, lru_out_norm, nsa_q_norm, nsa_k_cmp_norm, nsa_k_sel_norm, nsa_k_win_norm,
              nsa_cmp_pe_k, nsa_cmp_w1_k, nsa_cmp_w2_k, nsa_cmp_pe_v, nsa_cmp_w1_v, nsa_cmp_w2_v,
              nsa_gate_b, nsa_out_norm, gla_a_w2, gla_a_b, gla_out_norm, w_out,
              ffn2_norm, ffn2_w_gate, ffn2_w_up, ffn2_w_down):
    T = x.shape[1]
    cos, sin = rope_tables(T)
    for l in range(DEPTH):
        x = x + 0.5 * swiglu(rms_norm(x, ffn1_norm[l]), ffn1_w_gate[l], ffn1_w_up[l], ffn1_w_down[l])

        h = rms_norm(x, mix_norm[l])
        (lru_x, lru_y, nq, nkc, nvc, nks, nvs, nkw, nvw, ngate,
         gq, gk, gv, gg, ga) = split_cols(h @ w_in[l])
        y_a = recurrent_block(lru_x, lru_y, lru_conv_w[l], lru_conv_b[l], lru_gate_a_w[l],
                              lru_gate_a_b[l], lru_gate_x_w[l], lru_gate_x_b[l], lru_lambda[l])
        y_b = nsa_mixer(nq, nkc, nvc, nks, nvs, nkw, nvw, ngate, nsa_gate_b[l],
                        nsa_q_norm[l], nsa_k_cmp_norm[l], nsa_k_sel_norm[l], nsa_k_win_norm[l],
                        nsa_cmp_pe_k[l], nsa_cmp_w1_k[l], nsa_cmp_w2_k[l],
                        nsa_cmp_pe_v[l], nsa_cmp_w1_v[l], nsa_cmp_w2_v[l], cos, sin)
        y_c = gla_mixer(gq, gk, gv, gg, ga, gla_a_w2[l], gla_a_b[l], gla_out_norm[l])
        mix = jnp.concatenate([rms_norm(y_a, lru_out_norm[l]), rms_norm(y_b, nsa_out_norm[l]), y_c], axis=-1)
        x = x + mix @ w_out[l]

        x = x + 0.5 * swiglu(rms_norm(x, ffn2_norm[l]), ffn2_w_gate[l], ffn2_w_up[l], ffn2_w_down[l])
    return x
```

```cpp
#include <hip/hip_runtime.h>
#include <cstdio>
#include <cstdint>
namespace pg8 {
#define PG8_LAS __attribute__((address_space(3)))
typedef unsigned short bf16_t;
typedef short bf16x8 __attribute__((ext_vector_type(8)));
typedef float f32x4 __attribute__((ext_vector_type(4)));
typedef unsigned u32x4 __attribute__((ext_vector_type(4)));
constexpr int BM = 256, BK = 64, HALF = 128, HTB = HALF * BK * 2  , STAGE_BYTES = 8 * HTB, NXCD = 8, WGM = 8;

__host__ __device__ __forceinline__ int lds_byte(int r, int c) { const int st = (r >> 4) * 2 + (c >> 5), rr = r & 15, cc = c & 31, ob = rr * 64 + cc * 2; return st * 1024 + (ob ^ (((ob >> 9) & 1) << 5)); }
__host__ __device__ __forceinline__ void stage_rc(int b, int& R, int& C) { const int st = b / 1024, sb = b % 1024, swz = sb ^ (((sb >> 9) & 1) << 5); R = (st >> 1) * 16 + swz / 64; C = (st & 1) * 32 + (swz % 64) / 2; }
__host__ __device__ __forceinline__ int perm32(int rho) { const int n = rho >> 4, i = rho & 15; return 8 * (i >> 2) + 4 * n + (i & 3); }

struct Unit { int pm, pn; };
struct Gemm { const bf16_t* A; const bf16_t* Bt; int M, N, K; };

struct StaticOrder {
    int nM, nN, nwg, G, c;
    __host__ __device__ void init(int M, int N, int G_, int c_) { nM = M / BM; nN = N / BM; nwg = nM * nN; G = G_; c = c_; }
    __host__ __device__ bool next(int i, Unit& u) const {
        const long L = (long)i * G + c; if (L >= nwg) return false;
        int wgid = (int)L; { const int q = nwg / NXCD, r = nwg % NXCD, xcd = wgid % NXCD, off = wgid / NXCD; wgid = (xcd < r ? xcd * (q + 1) : r * (q + 1) + (xcd - r) * q) + off; }
        const int nig = WGM * nN, gid = wgid / nig, fm = gid * WGM, gsz = (nM - fm) < WGM ? (nM - fm) : WGM;
        u.pm = fm + ((wgid % nig) % gsz); u.pn = (wgid % nig) / gsz; return true;
    }
    __device__ __forceinline__ void a_ready(const Unit&) const {}
    __device__ __forceinline__ void done(const Unit&) const {}
};

typedef float f32x2n __attribute__((ext_vector_type(2))); typedef __bf16 bf16x2n __attribute__((ext_vector_type(2)));
__device__ __forceinline__ unsigned cvt_pk_bf16(float lo, float hi) { const f32x2n v = {lo, hi}; return __builtin_bit_cast(unsigned, __builtin_convertvector(v, bf16x2n)); }
typedef float f32x2 __attribute__((ext_vector_type(2)));
typedef int i32x4 __attribute__((ext_vector_type(4)));
__device__ __forceinline__ f32x4 mma_frag(bf16x8 b, bf16x8 a, f32x4 c) { return __builtin_amdgcn_mfma_f32_16x16x32_bf16(b, a, c, 0, 0, 0); }
__device__ __forceinline__ i32x4 mma_frag(bf16x8 b, bf16x8 a, i32x4 c) { return __builtin_amdgcn_mfma_i32_16x16x64_i8(__builtin_bit_cast(i32x4, b), __builtin_bit_cast(i32x4, a), c, 0, 0, 0); }
#ifdef NOISE_P
#ifndef NOISE_P_COLS
#define NOISE_P_COLS(c) true
#endif
__device__ __forceinline__ float nzp(float v, unsigned row, unsigned col) { unsigned x = row * 5376u + col; x ^= x >> 16; x *= 0x7feb352du; x ^= x >> 15; x *= 0x846ca68bu; x ^= x >> 16;
        return v + ((float)x * 2.3283064e-10f * 2.0f - 1.0f) * (1.7320508f * NOISE_P); }
#endif
struct EpiBf16Plain {
    static constexpr bool PERM = true, AFTER_DRAIN = false; typedef f32x4 acc_t;
    bf16_t* O; int ldc;
    __device__ __forceinline__ void operator()(const f32x4 (&acc)[2][2][4][2], const Unit& u, int wr, int wc, int fr, int fq) const {
        const int row0 = u.pm * BM + wr * 64 + fr, col0 = u.pn * BM + wc * 32 + 8 * fq;
#pragma unroll
        for (int ai = 0; ai < 2; ++ai)
#pragma unroll
            for (int m = 0; m < 4; ++m) { bf16_t* rowp = O + (size_t)(row0 + ai * HALF + m * 16) * ldc + col0;
#pragma unroll
                for (int bj = 0; bj < 2; ++bj) { f32x4 v0 = acc[ai][bj][m][0], v1 = acc[ai][bj][m][1];
#ifdef NOISE_P
                    { const unsigned rr = row0 + ai * HALF + m * 16, cc = col0 + bj * HALF;
                      if (NOISE_P_COLS(cc))
#pragma unroll
                      for (int j = 0; j < 4; ++j) { v0[j] = nzp(v0[j], rr, cc + j); v1[j] = nzp(v1[j], rr, cc + 4 + j); } }
#endif
                    u32x4 w; w.x = cvt_pk_bf16(v0[0], v0[1]); w.y = cvt_pk_bf16(v0[2], v0[3]); w.z = cvt_pk_bf16(v1[0], v1[1]); w.w = cvt_pk_bf16(v1[2], v1[3]);
                    *(u32x4*)(rowp + bj * HALF) = w; } }
    }
};
struct EpiBf16Plain8 {
    static constexpr bool PERM = true, AFTER_DRAIN = false; typedef i32x4 acc_t;
    bf16_t* O; int ldc; const float* sa; const float* sw;
    __device__ __forceinline__ void operator()(const i32x4 (&acc)[2][2][4][2], const Unit& u, int wr, int wc, int fr, int fq) const {
        const int row0 = u.pm * BM + wr * 64 + fr, col0 = u.pn * BM + wc * 32 + 8 * fq;
        f32x4 cw[2][2];
#pragma unroll
        for (int bj = 0; bj < 2; ++bj) { cw[bj][0] = *(const f32x4*)(sw + col0 + bj * HALF); cw[bj][1] = *(const f32x4*)(sw + col0 + bj * HALF + 4); }
        float rav[2][4];
#pragma unroll
        for (int ai = 0; ai < 2; ++ai)
#pragma unroll
            for (int m = 0; m < 4; ++m) rav[ai][m] = sa[row0 + ai * HALF + m * 16];
        __builtin_amdgcn_sched_barrier(0);
#pragma unroll
        for (int ai = 0; ai < 2; ++ai)
#pragma unroll
            for (int m = 0; m < 4; ++m) rav[ai][m] *= (1.0f / 127.0f);
#pragma unroll
        for (int ai = 0; ai < 2; ++ai)
#pragma unroll
            for (int m = 0; m < 4; ++m) { const int row = row0 + ai * HALF + m * 16; bf16_t* rowp = O + (size_t)row * ldc + col0; const float ra = rav[ai][m];
#pragma unroll
                for (int bj = 0; bj < 2; ++bj) { const f32x4 v0 = __builtin_convertvector(acc[ai][bj][m][0], f32x4) * (cw[bj][0] * ra), v1 = __builtin_convertvector(acc[ai][bj][m][1], f32x4) * (cw[bj][1] * ra);
                    u32x4 w; w.x = cvt_pk_bf16(v0[0], v0[1]); w.y = cvt_pk_bf16(v0[2], v0[3]); w.z = cvt_pk_bf16(v1[0], v1[1]); w.w = cvt_pk_bf16(v1[2], v1[3]);
                    *(u32x4*)(rowp + bj * HALF) = w; } }
    }
};
struct EpiSwiGLU {
    static constexpr bool PERM = true, AFTER_DRAIN = false; typedef f32x4 acc_t;
    bf16_t* O; int ldc;
    static __device__ __forceinline__ float sg(float g, float up) { const float e = __builtin_amdgcn_exp2f(g * -1.44269504089f); return g * __builtin_amdgcn_rcpf(1.0f + e) * up; }
#ifdef NOISE_PROBE
    static __device__ __forceinline__ float nz(float v, unsigned row, unsigned col) { unsigned x = row * 5632u + col; x ^= x >> 16; x *= 0x7feb352du; x ^= x >> 15; x *= 0x846ca68bu; x ^= x >> 16;
        return v * (1.0f + ((float)x * 2.3283064e-10f * 2.0f - 1.0f) * (1.7320508f * NOISE_PROBE)); }
#endif
    __device__ __forceinline__ void operator()(const f32x4 (&acc)[2][2][4][2], const Unit& u, int wr, int wc, int fr, int fq) const {
        const int row0 = u.pm * BM + wr * 64 + fr, col0 = u.pn * HALF + wc * 32 + 8 * fq;
#pragma unroll
        for (int ai = 0; ai < 2; ++ai)
#pragma unroll
            for (int m = 0; m < 4; ++m) { bf16_t* rowp = O + (size_t)(row0 + ai * HALF + m * 16) * ldc + col0;
                const f32x4 g0 = acc[ai][0][m][0], g1 = acc[ai][0][m][1], u0 = acc[ai][1][m][0], u1 = acc[ai][1][m][1];
#ifdef NOISE_PROBE
                const unsigned rr = row0 + ai * HALF + m * 16; float hv[8];
#pragma unroll
                for (int j = 0; j < 4; ++j) { hv[j] = nz(sg(g0[j], u0[j]), rr, col0 + j); hv[4 + j] = nz(sg(g1[j], u1[j]), rr, col0 + 4 + j); }
                u32x4 w; w.x = cvt_pk_bf16(hv[0], hv[1]); w.y = cvt_pk_bf16(hv[2], hv[3]); w.z = cvt_pk_bf16(hv[4], hv[5]); w.w = cvt_pk_bf16(hv[6], hv[7]);
#else
                u32x4 w; w.x = cvt_pk_bf16(sg(g0[0], u0[0]), sg(g0[1], u0[1])); w.y = cvt_pk_bf16(sg(g0[2], u0[2]), sg(g0[3], u0[3]));
                w.z = cvt_pk_bf16(sg(g1[0], u1[0]), sg(g1[1], u1[1])); w.w = cvt_pk_bf16(sg(g1[2], u1[2]), sg(g1[3], u1[3]));
#endif
                *(u32x4*)rowp = w; }
    }
};
typedef unsigned u32x2_t __attribute__((ext_vector_type(2)));
__device__ __forceinline__ f32x4 res_load(const void* base, bool f32, size_t idx) {
    if (f32) return *(const f32x4*)((const float*)base + idx);
    const u32x2_t w = *(const u32x2_t*)((const bf16_t*)base + idx);
    return (f32x4){__builtin_bit_cast(float, w.x << 16), __builtin_bit_cast(float, w.x & 0xffff0000u), __builtin_bit_cast(float, w.y << 16), __builtin_bit_cast(float, w.y & 0xffff0000u)}; }
__device__ __forceinline__ void res_store(void* out, bool f32, size_t idx, f32x4 v) {
    if (f32) { *(f32x4*)((float*)out + idx) = v; return; }
    u32x2_t w; w.x = cvt_pk_bf16(v[0], v[1]); w.y = cvt_pk_bf16(v[2], v[3]); *(u32x2_t*)((bf16_t*)out + idx) = w; }
struct EpiSwiGLU8 {
    static constexpr bool PERM = true, AFTER_DRAIN = false; typedef i32x4 acc_t;
    bf16_t* O; int ldc; const float* sa; const float* sw;
    __device__ __forceinline__ void operator()(const i32x4 (&acc)[2][2][4][2], const Unit& u, int wr, int wc, int fr, int fq) const {
        const int row0 = u.pm * BM + wr * 64 + fr, col0 = u.pn * HALF + wc * 32 + 8 * fq, wrow0 = u.pn * BM + wc * 32 + 8 * fq;
        const f32x4 sg0 = *(const f32x4*)(sw + wrow0) * 1.44269504089f, sg1 = *(const f32x4*)(sw + wrow0 + 4) * 1.44269504089f, su0 = *(const f32x4*)(sw + wrow0 + HALF) * 0.69314718056f, su1 = *(const f32x4*)(sw + wrow0 + HALF + 4) * 0.69314718056f;
        float rav[2][4];
#pragma unroll
        for (int ai = 0; ai < 2; ++ai)
#pragma unroll
            for (int m = 0; m < 4; ++m) rav[ai][m] = sa[row0 + ai * HALF + m * 16];
        __builtin_amdgcn_sched_barrier(0);
#pragma unroll
        for (int ai = 0; ai < 2; ++ai)
#pragma unroll
            for (int m = 0; m < 4; ++m) rav[ai][m] *= (1.0f / 127.0f);
#pragma unroll
        for (int ai = 0; ai < 2; ++ai)
#pragma unroll
            for (int m = 0; m < 4; ++m) { const int row = row0 + ai * HALF + m * 16; bf16_t* rowp = O + (size_t)row * ldc + col0; const float ra = rav[ai][m];
                const f32x4 g0 = __builtin_convertvector(acc[ai][0][m][0], f32x4) * (sg0 * ra), g1 = __builtin_convertvector(acc[ai][0][m][1], f32x4) * (sg1 * ra),
                            u0 = __builtin_convertvector(acc[ai][1][m][0], f32x4) * (su0 * ra), u1 = __builtin_convertvector(acc[ai][1][m][1], f32x4) * (su1 * ra);
                u32x4 w; w.x = cvt_pk_bf16(sg2(g0[0], u0[0]), sg2(g0[1], u0[1])); w.y = cvt_pk_bf16(sg2(g0[2], u0[2]), sg2(g0[3], u0[3]));
                w.z = cvt_pk_bf16(sg2(g1[0], u1[0]), sg2(g1[1], u1[1])); w.w = cvt_pk_bf16(sg2(g1[2], u1[2]), sg2(g1[3], u1[3]));
                *(u32x4*)rowp = w; }
    }
    static __device__ __forceinline__ float sg2(float gl, float ul) { return gl * __builtin_amdgcn_rcpf(1.0f + __builtin_amdgcn_exp2f(-gl)) * ul; }
};
struct EpiResid8 {
    static constexpr bool PERM = false, AFTER_DRAIN = false; typedef i32x4 acc_t;
    const void* base; void* out; int ldc; float scale; const float* sa; const float* sw; bool base_f32, out_f32;
    __device__ __forceinline__ void operator()(const i32x4 (&acc)[2][2][4][2], const Unit& u, int wr, int wc, int fr, int fq) const {
        const int row0 = u.pm * BM + wr * 64 + fr, col0 = u.pn * BM + wc * 32 + 4 * fq;
        float sc = scale * (1.0f / 127.0f); asm volatile("" : "+s"(sc));
        f32x4 cw[2][2];
#pragma unroll
        for (int bj = 0; bj < 2; ++bj)
#pragma unroll
            for (int n = 0; n < 2; ++n) cw[bj][n] = *(const f32x4*)(sw + col0 + bj * HALF + n * 16) * sc;
        float rav[2][4];
#pragma unroll
        for (int ai = 0; ai < 2; ++ai)
#pragma unroll
            for (int m = 0; m < 4; ++m) rav[ai][m] = sa[row0 + ai * HALF + m * 16];
        __builtin_amdgcn_sched_barrier(0);
#pragma unroll
        for (int ai = 0; ai < 2; ++ai)
#pragma unroll
            for (int mp = 0; mp < 2; ++mp) {
                f32x4 bs[2][2][2]; float ra[2]; u32x2_t rw[2][2][2];
#pragma unroll
                for (int mm = 0; mm < 2; ++mm) { const int row = row0 + ai * HALF + (2 * mp + mm) * 16; const size_t off = (size_t)row * ldc + col0; ra[mm] = rav[ai][2 * mp + mm];
#pragma unroll
                    for (int bj = 0; bj < 2; ++bj)
#pragma unroll
                        for (int n = 0; n < 2; ++n) rw[mm][bj][n] = *(const u32x2_t*)((const bf16_t*)base + off + bj * HALF + n * 16); }
                __builtin_amdgcn_sched_barrier(0);
#pragma unroll
                for (int mm = 0; mm < 2; ++mm)
#pragma unroll
                    for (int bj = 0; bj < 2; ++bj)
#pragma unroll
                        for (int n = 0; n < 2; ++n) { const u32x2_t w = rw[mm][bj][n];
                            bs[mm][bj][n] = (f32x4){__builtin_bit_cast(float, w.x << 16), __builtin_bit_cast(float, w.x & 0xffff0000u), __builtin_bit_cast(float, w.y << 16), __builtin_bit_cast(float, w.y & 0xffff0000u)}; }
#pragma unroll
                for (int mm = 0; mm < 2; ++mm) { const int m = 2 * mp + mm; const size_t off = (size_t)(row0 + ai * HALF + m * 16) * ldc + col0;
#pragma unroll
                    for (int bj = 0; bj < 2; ++bj)
#pragma unroll
                        for (int n = 0; n < 2; ++n) res_store(out, out_f32, off + bj * HALF + n * 16, bs[mm][bj][n] + __builtin_convertvector(acc[ai][bj][m][n], f32x4) * (cw[bj][n] * ra[mm])); }
                asm volatile("" ::: "memory"); }
    }
};
struct EpiResid {
    static constexpr bool PERM = false, AFTER_DRAIN = false; typedef f32x4 acc_t;
    const void* base; void* out; int ldc; float scale;
    __device__ __forceinline__ void operator()(const f32x4 (&acc)[2][2][4][2], const Unit& u, int wr, int wc, int fr, int fq) const {
        const int row0 = u.pm * BM + wr * 64 + fr, col0 = u.pn * BM + wc * 32 + 4 * fq;
#pragma unroll
        for (int ai = 0; ai < 2; ++ai) {
            f32x4 bs[4][2][2];
#pragma unroll
            for (int m = 0; m < 4; ++m) { const size_t off = (size_t)(row0 + ai * HALF + m * 16) * ldc + col0;
#pragma unroll
                for (int bj = 0; bj < 2; ++bj)
#pragma unroll
                    for (int n = 0; n < 2; ++n) bs[m][bj][n] = res_load(base, false, off + bj * HALF + n * 16); }
#pragma unroll
            for (int m = 0; m < 4; ++m) { const size_t off = (size_t)(row0 + ai * HALF + m * 16) * ldc + col0;
#pragma unroll
                for (int bj = 0; bj < 2; ++bj)
#pragma unroll
                    for (int n = 0; n < 2; ++n) { f32x4 a = acc[ai][bj][m][n];
#ifdef NOISE_WOUT
                        { const unsigned rr = row0 + ai * HALF + m * 16, cc = col0 + bj * HALF + n * 16;
#pragma unroll
                          for (int j = 0; j < 4; ++j) { unsigned x = rr * 2048u + cc + j; x ^= x >> 16; x *= 0x7feb352du; x ^= x >> 15; x *= 0x846ca68bu; x ^= x >> 16; a[j] += ((float)x * 2.3283064e-10f * 2.0f - 1.0f) * (1.7320508f * NOISE_WOUT); } }
#endif
                        res_store(out, false, off + bj * HALF + n * 16, bs[m][bj][n] + a * scale); } }
            asm volatile("" ::: "memory"); }
    }
};
template <class Epi, class Sched, bool ALIGN_EPI = false, bool SP2 = false>
__device__ __forceinline__ void gemm_phase(PG8_LAS unsigned char* lds, const Gemm g, const Sched& S, const Epi& E, int tid_in) {
    int tid_ = tid_in; asm volatile("" : "+v"(tid_));
    const int tid = tid_, wid = __builtin_amdgcn_readfirstlane(tid >> 6), lane = tid & 63, wr = wid >> 2, wc = wid & 3, fr = lane & 15, fq = lane >> 4;
    const int K = g.K, nt = K / BK;
    unsigned voffA[2], voffB[2];
#pragma unroll
    for (int i = 0; i < 2; ++i) { int R, C; stage_rc(tid * 16 + i * 8192, R, C); const int Rb = Epi::PERM ? ((R & ~31) + perm32(R & 31)) : R;
        voffA[i] = (unsigned)(R * K + C) * 2u; voffB[i] = (unsigned)(Rb * K + C) * 2u; }
    const size_t kstep = (size_t)(BK * 2);
    const size_t hstep = (size_t)HALF * K * 2;
    const size_t tstep = 2 * hstep;
    const unsigned ldsw = (unsigned)wid * 1024u;
    const int aoff = lds_byte(wr * 64 + fr, fq * 8), boff = lds_byte(wc * 32 + fr, fq * 8);
#define PG8_SA(b, h) (((b) * 2 + (h)) * HTB)
#define PG8_SB(b, h) ((4 + (b) * 2 + (h)) * HTB)
#define PG8_STAGE(bufoff, gbase, voff) do { _Pragma("unroll") for (int _i = 0; _i < 2; ++_i) \
        __builtin_amdgcn_global_load_lds((const unsigned*)((const char*)(gbase) + (voff)[_i]), (PG8_LAS unsigned*)(lds + (bufoff) + ldsw + _i * 8192), 16, 0, 0); } while (0)
#define PG8_LDA(dst, b, h) do { _Pragma("unroll") for (int m = 0; m < 4; ++m) _Pragma("unroll") for (int k = 0; k < 2; ++k) dst[m][k] = *(const PG8_LAS bf16x8*)(lds + PG8_SA(b, h) + aoff + m * 2048 + k * 1024); } while (0)
#define PG8_LDB(dst, b, h) do { _Pragma("unroll") for (int n = 0; n < 2; ++n) _Pragma("unroll") for (int k = 0; k < 2; ++k) dst[n][k] = *(const PG8_LAS bf16x8*)(lds + PG8_SB(b, h) + boff + n * 2048 + k * 1024); } while (0)
#define PG8_MMA(ai, bj, At, Bt) do { __builtin_amdgcn_s_setprio(1); _Pragma("unroll") for (int m = 0; m < 4; ++m) _Pragma("unroll") for (int n = 0; n < 2; ++n) _Pragma("unroll") for (int k = 0; k < 2; ++k) \
        acc[ai][bj][m][n] = mma_frag(Bt[n][k], At[m][k], acc[ai][bj][m][n]); __builtin_amdgcn_s_setprio(0); } while (0)
#define PG8_WAIT_V(n) asm volatile("s_waitcnt vmcnt(" #n ")" ::: "memory")
#define PG8_WAIT_L(n) asm volatile("s_waitcnt lgkmcnt(" #n ")" ::: "memory")
#define PG8_BAR __builtin_amdgcn_s_barrier()
#define PG8_SCHED __builtin_amdgcn_sched_barrier(0)
    Unit cur, nxt; int ui = 0;
    if (!S.next(0, cur)) return;
    typedef typename Epi::acc_t acc_t;
    acc_t acc[2][2][4][2];
#pragma unroll
    for (int a = 0; a < 2; ++a)
#pragma unroll
        for (int b = 0; b < 2; ++b)
#pragma unroll
            for (int m = 0; m < 4; ++m)
#pragma unroll
                for (int n = 0; n < 2; ++n) acc[a][b][m][n] = acc_t{};
    bf16x8 At[4][2], B0[2][2], B1[2][2];
    const char* cA = (const char*)g.A + (size_t)cur.pm * tstep; const char* cB = (const char*)g.Bt + (size_t)cur.pn * tstep;
    S.a_ready(cur);
    if constexpr (SP2) {
        PG8_STAGE(PG8_SB(0, 0), cB, voffB); PG8_STAGE(PG8_SB(0, 1), cB + hstep, voffB); PG8_STAGE(PG8_SA(0, 0), cA, voffA); PG8_STAGE(PG8_SA(0, 1), cA + hstep, voffA);
        if (wr == 1) PG8_BAR;
        PG8_WAIT_V(2); PG8_BAR;
        PG8_STAGE(PG8_SB(1, 0), cB + kstep, voffB); PG8_STAGE(PG8_SA(1, 0), cA + kstep, voffA); PG8_STAGE(PG8_SB(1, 1), cB + hstep + kstep, voffB);
        PG8_WAIT_V(6); PG8_BAR;
    } else {
        PG8_STAGE(PG8_SB(0, 0), cB, voffB); PG8_STAGE(PG8_SA(0, 0), cA, voffA); PG8_STAGE(PG8_SB(0, 1), cB + hstep, voffB); PG8_STAGE(PG8_SA(0, 1), cA + hstep, voffA);
        if (wr == 1) PG8_BAR;
        PG8_WAIT_V(4); PG8_BAR;
        PG8_STAGE(PG8_SB(1, 0), cB + kstep, voffB); PG8_STAGE(PG8_SA(1, 0), cA + kstep, voffA); PG8_STAGE(PG8_SB(1, 1), cB + hstep + kstep, voffB);
        PG8_WAIT_V(6); PG8_BAR;
    }
    for (;;) {
        const bool has_next = S.next(ui + 1, nxt);
        const char* nA = has_next ? (const char*)g.A + (size_t)nxt.pm * tstep : cA; const char* nB = has_next ? (const char*)g.Bt + (size_t)nxt.pn * tstep : cB;
        for (int t = 0; t < nt; t += 2) {
            const bool last = (t == nt - 2);
            const char* a1 = cA + (size_t)(t + 1) * kstep;
            const char* a2 = last ? nA : cA + (size_t)(t + 2) * kstep; const char* b2 = last ? nB : cB + (size_t)(t + 2) * kstep;
            const char* a3 = a2 + kstep; const char* b3 = b2 + kstep;
            if (last && has_next) S.a_ready(nxt);
            if constexpr (SP2) {
            PG8_LDB(B0, 0, 0); PG8_LDB(B1, 0, 1); PG8_SCHED; PG8_LDA(At, 0, 0); PG8_STAGE(PG8_SA(1, 1), a1 + hstep, voffA);
            PG8_WAIT_V(8); PG8_WAIT_L(0); PG8_BAR; PG8_MMA(0, 0, At, B0); PG8_MMA(0, 1, At, B1); PG8_BAR; PG8_SCHED;
            PG8_LDA(At, 0, 1); PG8_STAGE(PG8_SB(0, 0), b2, voffB); PG8_STAGE(PG8_SB(0, 1), b2 + hstep, voffB); PG8_STAGE(PG8_SA(0, 0), a2, voffA);
            PG8_WAIT_V(8); PG8_WAIT_L(0); PG8_BAR; PG8_MMA(1, 0, At, B0); PG8_MMA(1, 1, At, B1); PG8_BAR; PG8_SCHED;
            PG8_LDB(B0, 1, 0); PG8_LDB(B1, 1, 1); PG8_SCHED; PG8_LDA(At, 1, 0); PG8_STAGE(PG8_SA(0, 1), a2 + hstep, voffA);
            PG8_WAIT_V(8); PG8_WAIT_L(0); PG8_BAR; PG8_MMA(0, 0, At, B0); PG8_MMA(0, 1, At, B1); PG8_BAR; PG8_SCHED;
            PG8_LDA(At, 1, 1); PG8_STAGE(PG8_SB(1, 0), b3, voffB); PG8_STAGE(PG8_SB(1, 1), b3 + hstep, voffB); PG8_STAGE(PG8_SA(1, 0), a3, voffA);
            PG8_WAIT_V(8); PG8_WAIT_L(0); PG8_BAR; PG8_MMA(1, 0, At, B0); PG8_MMA(1, 1, At, B1); PG8_BAR; PG8_SCHED;
            } else {
            PG8_LDB(B0, 0, 0); PG8_SCHED; PG8_LDA(At, 0, 0); PG8_STAGE(PG8_SA(1, 1), a1 + hstep, voffA);
            PG8_WAIT_L(8); PG8_BAR; PG8_WAIT_L(0); PG8_MMA(0, 0, At, B0); PG8_BAR; PG8_SCHED;
            PG8_LDB(B1, 0, 1); PG8_STAGE(PG8_SB(0, 0), b2, voffB);
            PG8_BAR; PG8_WAIT_L(0); PG8_MMA(0, 1, At, B1); PG8_BAR;
            PG8_LDA(At, 0, 1); PG8_STAGE(PG8_SA(0, 0), a2, voffA);
            PG8_BAR; PG8_WAIT_L(0); PG8_MMA(1, 0, At, B0); PG8_BAR; PG8_SCHED;
            PG8_STAGE(PG8_SB(0, 1), b2 + hstep, voffB);
            PG8_WAIT_V(6); PG8_BAR; PG8_MMA(1, 1, At, B1); PG8_BAR;
            PG8_LDB(B0, 1, 0); PG8_SCHED; PG8_LDA(At, 1, 0); PG8_STAGE(PG8_SA(0, 1), a2 + hstep, voffA);
            PG8_WAIT_L(8); PG8_BAR; PG8_WAIT_L(0); PG8_MMA(0, 0, At, B0); PG8_BAR; PG8_SCHED;
            PG8_LDB(B1, 1, 1); PG8_STAGE(PG8_SB(1, 0), b3, voffB);
            PG8_BAR; PG8_WAIT_L(0); PG8_MMA(0, 1, At, B1); PG8_BAR;
            PG8_LDA(At, 1, 1); PG8_STAGE(PG8_SA(1, 0), a3, voffA);
            PG8_BAR; PG8_WAIT_L(0); PG8_MMA(1, 0, At, B0); PG8_BAR; PG8_SCHED;
            PG8_STAGE(PG8_SB(1, 1), b3 + hstep, voffB);
            PG8_WAIT_V(6); PG8_BAR; PG8_MMA(1, 1, At, B1); PG8_BAR;
            }
        }
        if constexpr (ALIGN_EPI) { if (wr == 0) PG8_BAR; }
        if constexpr (!Epi::AFTER_DRAIN) { E(acc, cur, wr, wc, fr, fq); S.done(cur); }
        if (!has_next) break;
#pragma unroll
        for (int a = 0; a < 2; ++a)
#pragma unroll
            for (int b = 0; b < 2; ++b)
#pragma unroll
                for (int m = 0; m < 4; ++m)
#pragma unroll
                    for (int n = 0; n < 2; ++n) acc[a][b][m][n] = acc_t{};
        cur = nxt; cA = nA; cB = nB; ++ui;
        if constexpr (ALIGN_EPI) { if (wr == 1) PG8_BAR; }
    }
    PG8_WAIT_V(0);
    if constexpr (!ALIGN_EPI) { if (wr == 0) PG8_BAR; }
    PG8_BAR;
    if constexpr (Epi::AFTER_DRAIN) { E.fused(acc, cur, wr, wc, fr, fq, lds, wid, lane); S.done(cur); }
#undef PG8_SA
#undef PG8_SB
#undef PG8_STAGE
#undef PG8_LDA
#undef PG8_LDB
#undef PG8_MMA
#undef PG8_WAIT_V
#undef PG8_WAIT_L
#undef PG8_BAR
#undef PG8_SCHED
}
}
constexpr int NWAVES = 8;
constexpr int BATCH = 8, T = 4096, D = 2048, M = BATCH * T, DFF = 5632, DEPTH = 4;
constexpr int DIN = 5160, LDP = 5376;
constexpr float NORM_EPS = 1e-6f;
constexpr int C_LRUX = 0, C_LRUY = 512, C_NQ = 1024, C_NKC = 2048, C_NVC = 2304, C_NKS = 2560, C_NVS = 2816, C_NKW = 3072, C_NVW = 3328,
              C_GQ = 3584, C_GK = 3840, C_GV = 4096, C_GG = 4608, C_NGATE = 5120, C_GA = 5144;
constexpr int MIX_A = 0, MIX_B = 512, MIX_C = 1536;
constexpr int NCMP = 255, NCMP_PAD = 256;
enum { I_X = 0, I_F1N, I_F1G, I_F1U, I_F1D, I_MIXN, I_WIN, I_CONVW, I_CONVB, I_GAW, I_GAB, I_GXW, I_GXB, I_LAM, I_LRUN, I_QN, I_KCN, I_KSN, I_KWN,
       I_PEK, I_W1K, I_W2K, I_PEV, I_W1V, I_W2V, I_GATEB, I_NSAN, I_AW2, I_AB, I_GLAN, I_WOUT, I_F2N, I_F2G, I_F2U, I_F2D, N_IN };

constexpr size_t MiB = 1u << 20;
constexpr size_t WS_CTL = 0, CTL_ZERO_BYTES = 1 * MiB;
constexpr size_t WS_ROPE = 1 * MiB;
constexpr size_t SZ_WGU = (size_t)2 * DFF * D * 2, SZ_WD = (size_t)D * DFF * 2, SZ_WIN = (size_t)LDP * D * 2, SZ_WOUT = (size_t)D * D * 2,
                 SZ_W1 = (size_t)128 * 4096 * 2, SZ_W2 = (size_t)128 * 128 * 2;
constexpr size_t WS_WGU = 2 * MiB;
constexpr size_t WS_WD = WS_WGU + (size_t)DEPTH * 2 * (SZ_WGU / 2);
constexpr size_t WS_WIN = WS_WD + (size_t)DEPTH * 2 * (SZ_WD / 2);
constexpr size_t WS_WOUT = WS_WIN + (size_t)DEPTH * SZ_WIN;
constexpr size_t WS_W1 = WS_WOUT + (size_t)DEPTH * SZ_WOUT;
constexpr size_t WS_W2 = WS_W1 + (size_t)DEPTH * 2 * SZ_W1;
constexpr size_t WS_HN = ((WS_W2 + (size_t)DEPTH * 2 * SZ_W2 + MiB - 1) / MiB) * MiB;
constexpr size_t WS_HP = WS_HN + (size_t)M * D * 2;
constexpr size_t WS_MIX = WS_HP + (size_t)M * DFF * 2;
constexpr size_t WS_KC = WS_MIX + (size_t)M * D * 2;
constexpr size_t WS_VC = WS_KC + (size_t)BATCH * 2 * NCMP_PAD * 128 * 2;
constexpr size_t WS_SA = WS_VC + (size_t)BATCH * 2 * NCMP_PAD * 128 * 2;
constexpr size_t WS_SA2 = WS_SA + (size_t)M * 4;
constexpr size_t WS_HQ2 = ((WS_SA2 + (size_t)M * 4 + MiB - 1) / MiB) * MiB;
constexpr size_t WS_XB = WS_HQ2 + (size_t)M * DFF;
constexpr size_t WS_END = WS_XB + (size_t)M * D * 2;
static_assert((size_t)M * LDP * 2 <= (size_t)M * DFF * 2, "p fits in the hidden buffer");
constexpr int CW_TMO = 0, CW_QUEUE = 64  , CW_BAR = 4096;
constexpr int CW_CMAX = 32768;
constexpr int CW_CMAX2 = CW_CMAX + DEPTH * 2 * 2 * DFF;
constexpr int CW_CMAX3 = CW_CMAX2 + DEPTH * 2 * D;
constexpr size_t SZ_WGU8 = (size_t)2 * DFF * D, SZ_WD8 = (size_t)D * DFF, SZ_WIN8 = (size_t)LDP * D;
static_assert((CW_CMAX3 + DEPTH * LDP) * 4 <= (int)CTL_ZERO_BYTES, "CMAX inside the zeroed region");

constexpr int RING_BYTES = 131072;
constexpr int LDS_BYTES = 147456;
constexpr int LDSCTL_OFF = LDS_BYTES - 512, MISC_OFF = LDSCTL_OFF;

#define GAS __attribute__((address_space(1)))
#define LAS __attribute__((address_space(3)))
typedef unsigned short bf16;
typedef unsigned v4u __attribute__((ext_vector_type(4)));
typedef unsigned v2u __attribute__((ext_vector_type(2)));
typedef float f32x4 __attribute__((ext_vector_type(4)));
typedef float f32x16 __attribute__((ext_vector_type(16)));
typedef short bf16x8 __attribute__((ext_vector_type(8)));
typedef short s16x4 __attribute__((ext_vector_type(4)));
typedef GAS unsigned gu32;
#define RLX_AGENT __ATOMIC_RELAXED, __HIP_MEMORY_SCOPE_AGENT
#define LDS_WAIT() asm volatile("s_waitcnt lgkmcnt(0)" ::: "memory")
#define VM_WAIT() asm volatile("s_waitcnt vmcnt(0)" ::: "memory")
__device__ __forceinline__ unsigned f2bf(float f) { unsigned u = __builtin_bit_cast(unsigned, f); return (u + 0x7fffu + ((u >> 16) & 1u)) >> 16; }
__device__ __forceinline__ unsigned pk2(float lo, float hi) { return f2bf(lo) | (f2bf(hi) << 16); }
__device__ __forceinline__ float bflo(unsigned w) { return __builtin_bit_cast(float, w << 16); }
__device__ __forceinline__ float bfhi(unsigned w) { return __builtin_bit_cast(float, w & 0xffff0000u); }
__device__ __forceinline__ float bf2f(bf16 b) { return __builtin_bit_cast(float, (unsigned)b << 16); }
__device__ __forceinline__ int lane_now() { unsigned ones = ~0u; asm volatile("" : "+s"(ones)); return (int)__builtin_amdgcn_mbcnt_hi(ones, __builtin_amdgcn_mbcnt_lo(ones, 0u)); }
template <int O> __device__ __forceinline__ float shx(float x, int lane) {
    if (O < 32) return __builtin_bit_cast(float, __builtin_amdgcn_ds_swizzle(__builtin_bit_cast(int, x), (O << 10) | 0x1f));
    return __builtin_bit_cast(float, __builtin_amdgcn_ds_bpermute((lane ^ 32) << 2, __builtin_bit_cast(int, x)));
}
__device__ __forceinline__ float wave_sum(float v, int lane) {
    v += shx<1>(v, lane); v += shx<2>(v, lane); v += shx<4>(v, lane); v += shx<8>(v, lane); v += shx<16>(v, lane); v += shx<32>(v, lane);
    return v;
}
__device__ __forceinline__ float sigmoidf_(float z) { return __builtin_amdgcn_rcpf(1.0f + __builtin_amdgcn_exp2f(z * -1.44269504089f)); }
__device__ __forceinline__ float gelu_tanh(float x) {
    const float u2 = 1.5957691216f * (x + 0.044715f * x * x * x);
    return x * sigmoidf_(u2);
}
__device__ __forceinline__ f32x4 mfma16(bf16x8 a, bf16x8 b, f32x4 c) { return __builtin_amdgcn_mfma_f32_16x16x32_bf16(a, b, c, 0, 0, 0); }
__device__ __forceinline__ f32x16 mfma32(bf16x8 a, bf16x8 b, f32x16 c) { return __builtin_amdgcn_mfma_f32_32x32x16_bf16(a, b, c, 0, 0, 0); }
#define XB_TMO      128
#define XB_XCNT(j)  (256  + 64 * (j))
#define XB_XSUB(j)  (1280 + 64 * (j))
#define XB_XGEN(j)  (2304 + 64 * (j))
#define XB_TOP      3328
#define XB_TOPGEN   3392
#define XCD_BAR_WORDS 3456
#define XB_SPIN_CAP (1u << 18)

__device__ __forceinline__ unsigned xb_ld(unsigned* p)              { return __hip_atomic_load(p, __ATOMIC_RELAXED, __HIP_MEMORY_SCOPE_AGENT); }
__device__ __forceinline__ unsigned xb_add(unsigned* p, unsigned v) { return __hip_atomic_fetch_add(p, v, __ATOMIC_RELAXED, __HIP_MEMORY_SCOPE_AGENT); }
__device__ __forceinline__ unsigned xb_xcc_id() { return (unsigned)__builtin_amdgcn_s_getreg((3 << 11) | 20) & 0xFu; }
#define XB_SPIN(cond, bar) do { unsigned _sp = 0; while (cond) { __builtin_amdgcn_s_sleep(1); \
    if ((++_sp & 255u) == 0u) { if (xb_ld(&(bar)[XB_TMO])) break; if (_sp > XB_SPIN_CAP) { atomicAdd(&(bar)[XB_TMO], 1u); break; } } } } while (0)

struct XcdBarrier {
    int wave;
    unsigned* bar; unsigned x;
    volatile LAS unsigned* st;
};

__device__ __forceinline__ XcdBarrier xcd_barrier_post(unsigned* bar, volatile LAS unsigned* st) {
    XcdBarrier b; b.bar = bar; b.x = xb_xcc_id(); b.st = st;
    if (threadIdx.x == 0) (void)xb_add(&bar[XB_XCNT(b.x)], 1u);
    return b;
}
__device__ __forceinline__ void xcd_barrier_complete(unsigned* bar, unsigned x, unsigned& nloc, unsigned& nx) {
    const unsigned G = gridDim.x * gridDim.y * gridDim.z;
    unsigned sum, cnt, mine, sp = 0u;
    for (;;) {
        sum = 0u; cnt = 0u; mine = 0u;
#pragma unroll
        for (unsigned j = 0; j < 16; ++j) { const unsigned c = xb_ld(&bar[XB_XCNT(j)]); sum += c; cnt += (c > 0u) ? 1u : 0u; mine = (j == x) ? c : mine; }
        if (sum == G) break;
        __builtin_amdgcn_s_sleep(1);
        if ((++sp & 255u) == 0u) { if (xb_ld(&bar[XB_TMO])) break; if (sp > XB_SPIN_CAP) { atomicAdd(&bar[XB_TMO], 1u); break; } }
    }
    nloc = mine > 0u ? mine : 1u; nx = cnt > 0u ? cnt : 1u;
}

__device__ __forceinline__ void xcd_barrier(const XcdBarrier& b) {
    asm volatile("s_waitcnt vmcnt(0)" ::: "memory");
    __syncthreads();
    if (b.wave == 0 && lane_now() == 0) {
        unsigned* bar = b.bar;
        __builtin_amdgcn_s_waitcnt(0);
        unsigned nloc = b.st[0], nx = b.st[1];
        if (nloc == 0u) { xcd_barrier_complete(bar, b.x, nloc, nx); b.st[0] = nloc; b.st[1] = nx; }
        const unsigned old = xb_add(&bar[XB_XSUB(b.x)], 1u);
        const unsigned gen = old / nloc;
        if (old + 1u == (gen + 1u) * nloc) {
            __builtin_amdgcn_fence(__ATOMIC_RELEASE, "agent");
            asm volatile("s_waitcnt vmcnt(0)" ::: "memory");
            const unsigned og = xb_add(&bar[XB_TOP], 1u);
            const unsigned tg = og / nx;
            if (og + 1u == (tg + 1u) * nx) xb_add(&bar[XB_TOPGEN], 1u);
            else XB_SPIN(xb_ld(&bar[XB_TOPGEN]) == tg, bar);
            __builtin_amdgcn_fence(__ATOMIC_ACQUIRE, "agent");
            xb_add(&bar[XB_XGEN(b.x)], 1u);
            asm volatile("s_waitcnt vmcnt(0)" ::: "memory");
        } else {
            XB_SPIN(xb_ld(&bar[XB_XGEN(b.x)]) == gen, bar);
            __builtin_amdgcn_fence(__ATOMIC_ACQUIRE, "agent");
            asm volatile("s_waitcnt vmcnt(0)" ::: "memory");
        }
    }
    __syncthreads();
}
struct Ctx {
    LAS unsigned char* lds;
    gu32* ctl;
    unsigned char* ws;
    int tid, lane, wave, vcu, G;
};

struct RowMapRt { int kind; __device__ __forceinline__ int operator()(int n) const {
    if (kind == 1) return ((n >> 7) << 8) + (n & 127);
    if (kind == 2) return ((n >> 7) << 8) + 128 + (n & 127);
    if (kind == 3) return n < 3584 ? n : (n < 3608 ? n + (C_NGATE - 3584) : (n < 5144 ? n - 24 : n));
    return n; } };
__device__ __forceinline__ void transpose_item(const float* W, int K, int N, bf16* WT, RowMapRt rm, LAS float* scr, int item, int lane, const unsigned* cmax  ) {
    const int nblk = (N + 31) >> 5, kb = item / nblk, nb = item - kb * nblk, k0 = 64 * kb, n0 = 32 * nb;
    const int n4 = 4 * (lane & 7), kr = lane >> 3;
    f32x4 v[8];
#pragma unroll
    for (int i = 0; i < 8; ++i) v[i] = (n0 + n4 < N) ? *(const GAS f32x4*)(W + (size_t)(k0 + kr + 8 * i) * N + n0 + n4) : (f32x4){0.f, 0.f, 0.f, 0.f};
#pragma unroll
    for (int i = 0; i < 8; ++i) { LAS float* d = scr + (kr + 8 * i) * 33 + n4; d[0] = v[i].x; d[1] = v[i].y; d[2] = v[i].z; d[3] = v[i].w; }
    LDS_WAIT(); asm volatile("" ::: "memory");
    const int c = lane & 7;
#pragma unroll
    for (int j = 0; j < 4; ++j) { const int nl = (lane >> 3) + 8 * j; const LAS float* s = scr + (8 * c) * 33 + nl;
        if (n0 + nl < N) {
            if (cmax) { const int row = rm(n0 + nl); const float cm = __builtin_bit_cast(float, cmax[row]), inv = cm > 0.f ? 127.0f / cm : 0.f;
                int q[8];
#pragma unroll
                for (int i = 0; i < 8; ++i) q[i] = (int)__builtin_rintf(s[i * 33] * inv) & 0xff;
                v2u o; o.x = (unsigned)(q[0] | (q[1] << 8) | (q[2] << 16) | (q[3] << 24)); o.y = (unsigned)(q[4] | (q[5] << 8) | (q[6] << 16) | (q[7] << 24));
                *(GAS v2u*)((unsigned char*)WT + (size_t)row * K + k0 + 8 * c) = o; }
            else { v4u o; o.x = pk2(s[0 * 33], s[1 * 33]); o.y = pk2(s[2 * 33], s[3 * 33]); o.z = pk2(s[4 * 33], s[5 * 33]); o.w = pk2(s[6 * 33], s[7 * 33]);
                *(GAS v4u*)(WT + (size_t)rm(n0 + nl) * K + k0 + 8 * c) = o; } } }
    LDS_WAIT(); asm volatile("" ::: "memory");
}
constexpr int IT_FF = (D / 64) * (DFF / 32), IT_WIN = (D / 64) * ((DIN + 31) / 32), IT_WOUT = (D / 64) * (D / 32), IT_W1 = (4096 / 64) * (128 / 32), IT_W2 = (128 / 64) * (128 / 32);
constexpr int IT_LAYER = 6 * IT_FF + IT_WIN + IT_WOUT + 2 * IT_W1 + 2 * IT_W2, IT_REST = IT_WOUT + 2 * IT_W1 + 2 * IT_W2;
__device__ __forceinline__ void p0_strip_store(LAS float* scr, const f32x4 (&v)[8], unsigned char* WT, int K, int k0, const int (&row)[4], const float (&inv)[4], int lane) {
    const int n4 = 4 * (lane & 7), kr = lane >> 3, c = lane & 7;
#pragma unroll
    for (int i = 0; i < 8; ++i) { LAS float* d = scr + (kr + 8 * i) * 33 + n4; d[0] = v[i].x; d[1] = v[i].y; d[2] = v[i].z; d[3] = v[i].w; }
    LDS_WAIT(); asm volatile("" ::: "memory");
#pragma unroll
    for (int j = 0; j < 4; ++j) { const int nl = (lane >> 3) + 8 * j; const LAS float* s = scr + (8 * c) * 33 + nl;
        int q[8];
#pragma unroll
        for (int i = 0; i < 8; ++i) q[i] = (int)__builtin_rintf(s[i * 33] * inv[j]) & 0xff;
        v2u o; o.x = (unsigned)(q[0] | (q[1] << 8) | (q[2] << 16) | (q[3] << 24)); o.y = (unsigned)(q[4] | (q[5] << 8) | (q[6] << 16) | (q[7] << 24));
        if (row[j] >= 0) *(GAS v2u*)(WT + (size_t)row[j] * K + k0 + 8 * c) = o; }
    LDS_WAIT(); asm volatile("" ::: "memory");
}
__device__ __forceinline__ void p0_ffn_strips(const Ctx& F0, const float* const* in) {
    Ctx F = F0; { int w_ = F0.wave; asm volatile("" : "+s"(w_)); F.wave = w_; F.lane = lane_now(); F.tid = 64 * w_ + F.lane; }
    const int lane = F.lane, w = F.wave, n4 = 4 * (lane & 7), kr = lane >> 3;
    LAS float* scr = (LAS float*)(F.lds + w * 16384);
    LAS float* cmx = (LAS float*)(F.lds + 131072);
    for (int s = F.vcu; s < DEPTH * 4 * (DFF / 32); s += F.G) {
        const int m4 = s / (DFF / 32), nb = s - m4 * (DFF / 32), l = m4 >> 2, ffn = (m4 >> 1) & 1, which = m4 & 1, n0 = 32 * nb;
        const float* W = in[(ffn ? I_F2G : I_F1G) + which] + (size_t)l * D * DFF;
        unsigned char* WT = F.ws + WS_WGU + (size_t)(l * 2 + ffn) * SZ_WGU8;
        unsigned* cm = (unsigned*)(F.ctl + CW_CMAX) + (size_t)(l * 2 + ffn) * 2 * DFF;
        f32x4 v[4][8];
#pragma unroll
        for (int t = 0; t < 4; ++t)
#pragma unroll
            for (int i = 0; i < 8; ++i) v[t][i] = *(const GAS f32x4*)(W + (size_t)(256 * w + 64 * t + kr + 8 * i) * DFF + n0 + n4);
        float mx[4] = {0.f, 0.f, 0.f, 0.f};
#pragma unroll
        for (int t = 0; t < 4; ++t)
#pragma unroll
            for (int i = 0; i < 8; ++i) { mx[0] = fmaxf(mx[0], fabsf(v[t][i].x)); mx[1] = fmaxf(mx[1], fabsf(v[t][i].y)); mx[2] = fmaxf(mx[2], fabsf(v[t][i].z)); mx[3] = fmaxf(mx[3], fabsf(v[t][i].w)); }
#pragma unroll
        for (int c = 0; c < 4; ++c) { float x = mx[c]; x = fmaxf(x, shx<8>(x, lane)); x = fmaxf(x, shx<16>(x, lane)); x = fmaxf(x, shx<32>(x, lane)); mx[c] = x; }
        if (lane < 8) {
#pragma unroll
            for (int c = 0; c < 4; ++c) cmx[w * 32 + n4 + c] = mx[c]; }
        __syncthreads();
        int row[4]; float inv[4];
#pragma unroll
        for (int j = 0; j < 4; ++j) { const int nl = (lane >> 3) + 8 * j, n = n0 + nl; float m = cmx[nl];
#pragma unroll
            for (int ww = 1; ww < 8; ++ww) m = fmaxf(m, cmx[ww * 32 + nl]);
            row[j] = ((n >> 7) << 8) + (which ? 128 : 0) + (n & 127); inv[j] = m > 0.f ? 127.0f / m : 0.f;
            if (w == 0 && (lane & 7) == 0) cm[row[j]] = __builtin_bit_cast(unsigned, m); }
#pragma unroll
        for (int t = 0; t < 4; ++t) p0_strip_store(scr, v[t], WT, D, 256 * w + 64 * t, row, inv, lane);
        __syncthreads();
    }
    for (int s = F.vcu; s < DEPTH * ((DIN + 31) / 32); s += F.G) {
        const int l = s / ((DIN + 31) / 32), nb = s - l * ((DIN + 31) / 32), n0 = 32 * nb;
        const float* W = in[I_WIN] + (size_t)l * D * DIN;
        unsigned char* WT = F.ws + WS_WIN + (size_t)l * SZ_WIN8;
        unsigned* cm = (unsigned*)(F.ctl + CW_CMAX3) + (size_t)l * LDP;
        const bool inr = n0 + n4 < DIN;
        f32x4 v[4][8];
#pragma unroll
        for (int t = 0; t < 4; ++t)
#pragma unroll
            for (int i = 0; i < 8; ++i) v[t][i] = inr ? *(const GAS f32x4*)(W + (size_t)(256 * w + 64 * t + kr + 8 * i) * DIN + n0 + n4) : (f32x4){0.f, 0.f, 0.f, 0.f};
        float mx[4] = {0.f, 0.f, 0.f, 0.f};
#pragma unroll
        for (int t = 0; t < 4; ++t)
#pragma unroll
            for (int i = 0; i < 8; ++i) { mx[0] = fmaxf(mx[0], fabsf(v[t][i].x)); mx[1] = fmaxf(mx[1], fabsf(v[t][i].y)); mx[2] = fmaxf(mx[2], fabsf(v[t][i].z)); mx[3] = fmaxf(mx[3], fabsf(v[t][i].w)); }
#pragma unroll
        for (int c = 0; c < 4; ++c) { float x = mx[c]; x = fmaxf(x, shx<8>(x, lane)); x = fmaxf(x, shx<16>(x, lane)); x = fmaxf(x, shx<32>(x, lane)); mx[c] = x; }
        if (lane < 8) {
#pragma unroll
            for (int c = 0; c < 4; ++c) cmx[w * 32 + n4 + c] = mx[c]; }
        __syncthreads();
        int row[4]; float inv[4];
#pragma unroll
        for (int j = 0; j < 4; ++j) { const int nl = (lane >> 3) + 8 * j, n = n0 + nl; float m = cmx[nl];
#pragma unroll
            for (int ww = 1; ww < 8; ++ww) m = fmaxf(m, cmx[ww * 32 + nl]);
            row[j] = n < DIN ? RowMapRt{3}(n) : -1; inv[j] = m > 0.f ? 127.0f / m : 0.f;
            if (w == 0 && (lane & 7) == 0 && n < DIN) cm[row[j]] = __builtin_bit_cast(unsigned, m); }
#pragma unroll
        for (int t = 0; t < 4; ++t) p0_strip_store(scr, v[t], WT, D, 256 * w + 64 * t, row, inv, lane);
        __syncthreads();
    }
    for (int s = F.vcu; s < DEPTH * 2 * (D / 32); s += F.G) {
        const int m2 = s / (D / 32), nb = s - m2 * (D / 32), l = m2 >> 1, ffn = m2 & 1, n0 = 32 * nb;
        const float* W = in[ffn ? I_F2D : I_F1D] + (size_t)l * D * DFF;
        unsigned char* WT = F.ws + WS_WD + (size_t)(l * 2 + ffn) * SZ_WD8;
        unsigned* cm = (unsigned*)(F.ctl + CW_CMAX2) + (size_t)(l * 2 + ffn) * D;
        float mx[4] = {0.f, 0.f, 0.f, 0.f};
        for (int kb = w; kb < DFF / 64; kb += 8) {
#pragma unroll
            for (int i = 0; i < 8; ++i) { const f32x4 x = *(const GAS f32x4*)(W + (size_t)(64 * kb + kr + 8 * i) * D + n0 + n4);
                mx[0] = fmaxf(mx[0], fabsf(x.x)); mx[1] = fmaxf(mx[1], fabsf(x.y)); mx[2] = fmaxf(mx[2], fabsf(x.z)); mx[3] = fmaxf(mx[3], fabsf(x.w)); } }
#pragma unroll
        for (int c = 0; c < 4; ++c) { float x = mx[c]; x = fmaxf(x, shx<8>(x, lane)); x = fmaxf(x, shx<16>(x, lane)); x = fmaxf(x, shx<32>(x, lane)); mx[c] = x; }
        if (lane < 8) {
#pragma unroll
            for (int c = 0; c < 4; ++c) cmx[w * 32 + n4 + c] = mx[c]; }
        __syncthreads();
        int row[4]; float inv[4];
#pragma unroll
        for (int j = 0; j < 4; ++j) { const int nl = (lane >> 3) + 8 * j; float m = cmx[nl];
#pragma unroll
            for (int ww = 1; ww < 8; ++ww) m = fmaxf(m, cmx[ww * 32 + nl]);
            row[j] = n0 + nl; inv[j] = m > 0.f ? 127.0f / m : 0.f;
            if (w == 0 && (lane & 7) == 0) cm[row[j]] = __builtin_bit_cast(unsigned, m); }
        for (int kb = w; kb < DFF / 64; kb += 8) { f32x4 x[8];
#pragma unroll
            for (int i = 0; i < 8; ++i) x[i] = *(const GAS f32x4*)(W + (size_t)(64 * kb + kr + 8 * i) * D + n0 + n4);
            p0_strip_store(scr, x, WT, DFF, 64 * kb, row, inv, lane); }
        __syncthreads();
    }
}
__device__ __forceinline__ void p0_prologue(const Ctx& F0, const float* const* in) {
    Ctx F = F0; { int w_ = F0.wave; asm volatile("" : "+s"(w_)); F.wave = w_; F.lane = lane_now(); F.tid = 64 * w_ + F.lane; }
    LAS float* scr = (LAS float*)(F.lds + F.wave * 16384);
    const int gw = F.vcu * NWAVES + F.wave, NGW = F.G * NWAVES;
    for (int it = gw; it < DEPTH * IT_REST; it += NGW) {
        const int l = it / IT_REST; int r = it - l * IT_REST;
        const float* W; bf16* WT; int K, N, kind = 0; const unsigned* cmx = nullptr;
        if (r < IT_WOUT) { W = in[I_WOUT] + (size_t)l * D * D; K = D; N = D; WT = (bf16*)(F.ws + WS_WOUT + (size_t)l * SZ_WOUT); }
        else if ((r -= IT_WOUT) < 2 * IT_W1) { const int kv = r / IT_W1; r -= kv * IT_W1; W = in[kv ? I_W1V : I_W1K] + (size_t)l * 4096 * 128; K = 4096; N = 128; WT = (bf16*)(F.ws + WS_W1 + (size_t)(l * 2 + kv) * SZ_W1); }
        else { r -= 2 * IT_W1; const int kv = r / IT_W2; r -= kv * IT_W2; W = in[kv ? I_W2V : I_W2K] + (size_t)l * 128 * 128; K = 128; N = 128; WT = (bf16*)(F.ws + WS_W2 + (size_t)(l * 2 + kv) * SZ_W2); }
        transpose_item(W, K, N, WT, RowMapRt{kind}, scr, r, F.lane, cmx);
    }
    const int gt = (F.vcu * NWAVES + F.wave) * 64 + F.lane, NGT = NGW * 64;
    constexpr int PADCH = (LDP - DIN) * D / 16;
    for (int i = gt; i < DEPTH * PADCH; i += NGT) { const int l = i / PADCH, c = i - l * PADCH;
        *(GAS v4u*)(F.ws + WS_WIN + (size_t)l * SZ_WIN8 + (size_t)DIN * D + (size_t)c * 16) = (v4u){0u, 0u, 0u, 0u}; }
    float* ctab = (float*)(F.ws + WS_ROPE); float* stab = ctab + T * 16;
    for (int i = gt; i < T * 16; i += NGT) { const int t = i >> 4, k = i & 15;
        const double inv = exp2(-(double)k * (18.931568569324174 / 16.0));
        double rev = (double)t * inv * 0.15915494309189535;
        rev -= floor(rev); const float fr = (float)rev;
        ctab[i] = __builtin_amdgcn_cosf(fr); stab[i] = __builtin_amdgcn_sinf(fr); }
}

__device__ __forceinline__ void load_xrow(const void* x, bool x_f32, int m, int lane, f32x4 (&v)[8]) {
    if (x_f32) { const GAS f32x4* xr = (const GAS f32x4*)((const float*)x + (size_t)m * D) + lane;
#pragma unroll
        for (int j = 0; j < 8; ++j) v[j] = xr[64 * j]; }
    else { const GAS v2u* xr = (const GAS v2u*)((const bf16*)x + (size_t)m * D) + lane;
#pragma unroll
        for (int j = 0; j < 8; ++j) { const v2u w = xr[64 * j]; v[j] = (f32x4){bflo(w.x), bfhi(w.x), bflo(w.y), bfhi(w.y)}; } }
}
__device__ __forceinline__ void rmsnorm_phase(const Ctx& F0, const void* x, bool x_f32, const float* gain, bf16* out) {
    Ctx F = F0; { int w_ = F0.wave; asm volatile("" : "+s"(w_)); F.wave = w_; F.lane = lane_now(); F.tid = 64 * w_ + F.lane; }
    const int gw = F.vcu * NWAVES + F.wave, NGW = F.G * NWAVES;
    f32x4 g[8];
#pragma unroll
    for (int j = 0; j < 8; ++j) g[j] = ((const GAS f32x4*)gain + F.lane)[64 * j];
    for (int m = gw; m < M; m += NGW) {
        f32x4 v[8]; float s = 0.f;
        load_xrow(x, x_f32, m, F.lane, v);
#pragma unroll
        for (int j = 0; j < 8; ++j) s += (v[j].x * v[j].x + v[j].y * v[j].y) + (v[j].z * v[j].z + v[j].w * v[j].w);
        const float r = 1.0f / sqrtf(wave_sum(s, F.lane) * (1.f / D) + NORM_EPS);
        GAS v2u* o8 = (GAS v2u*)(out + (size_t)m * D) + F.lane;
#pragma unroll
        for (int j = 0; j < 8; ++j) { v2u w; w.x = pk2(v[j].x * r * g[j].x, v[j].y * r * g[j].y); w.y = pk2(v[j].z * r * g[j].z, v[j].w * r * g[j].w); o8[64 * j] = w; }
    }
}

__device__ __forceinline__ void rmsnorm_q8_phase(const Ctx& F0, const void* x, bool x_f32, const float* gain, unsigned char* out, float* sa, bf16* xb_copy = nullptr  ) {
    Ctx F = F0; { int w_ = F0.wave; asm volatile("" : "+s"(w_)); F.wave = w_; F.lane = lane_now(); F.tid = 64 * w_ + F.lane; }
    const int gw = F.vcu * NWAVES + F.wave, NGW = F.G * NWAVES, lane = F.lane;
    f32x4 g[8];
#pragma unroll
    for (int j = 0; j < 8; ++j) g[j] = ((const GAS f32x4*)gain + lane)[64 * j];
    for (int mi = gw; mi < M; mi += NGW) { const int m = M - 1 - mi;
        f32x4 v[8]; float s = 0.f;
        load_xrow(x, x_f32, m, lane, v);
        if (xb_copy) { GAS v2u* xo = (GAS v2u*)(xb_copy + (size_t)m * D) + lane;
#pragma unroll
            for (int j = 0; j < 8; ++j) { v2u w; w.x = pk2(v[j].x, v[j].y); w.y = pk2(v[j].z, v[j].w); xo[64 * j] = w; } }
#pragma unroll
        for (int j = 0; j < 8; ++j) s += (v[j].x * v[j].x + v[j].y * v[j].y) + (v[j].z * v[j].z + v[j].w * v[j].w);
        const float r = 1.0f / sqrtf(wave_sum(s, lane) * (1.f / D) + NORM_EPS);
        float am = 0.f;
#pragma unroll
        for (int j = 0; j < 8; ++j) { v[j] = v[j] * g[j] * r; am = fmaxf(am, fmaxf(fmaxf(fabsf(v[j].x), fabsf(v[j].y)), fmaxf(fabsf(v[j].z), fabsf(v[j].w)))); }
        am = fmaxf(am, shx<1>(am, lane)); am = fmaxf(am, shx<2>(am, lane)); am = fmaxf(am, shx<4>(am, lane)); am = fmaxf(am, shx<8>(am, lane)); am = fmaxf(am, shx<16>(am, lane)); am = fmaxf(am, shx<32>(am, lane));
        am = fmaxf(am, 1e-30f);
        const float inv = 127.0f / am;
        if (lane == 0) sa[m] = am * (1.0f / 127.0f);
        GAS unsigned* o4 = (GAS unsigned*)(out + (size_t)m * D) + lane;
#pragma unroll
        for (int j = 0; j < 8; ++j) { const int q0 = (int)__builtin_rintf(v[j].x * inv) & 0xff, q1 = (int)__builtin_rintf(v[j].y * inv) & 0xff, q2 = (int)__builtin_rintf(v[j].z * inv) & 0xff, q3 = (int)__builtin_rintf(v[j].w * inv) & 0xff;
            o4[64 * j] = (unsigned)(q0 | (q1 << 8) | (q2 << 16) | (q3 << 24)); }
    }
}

__device__ __forceinline__ void hidden_q8_phase(const Ctx& F0, const bf16* hid, unsigned char* out, float* sa) {
    Ctx F = F0; { int w_ = F0.wave; asm volatile("" : "+s"(w_)); F.wave = w_; F.lane = lane_now(); F.tid = 64 * w_ + F.lane; }
    const int gw = F.vcu * NWAVES + F.wave, NGW = F.G * NWAVES, lane = F.lane;
    for (int mi = gw; mi < M; mi += NGW) { const int m = M - 1 - mi;
        const GAS v4u* hr = (const GAS v4u*)(hid + (size_t)m * DFF) + lane;
        v4u raw[11]; float am = 0.f;
#pragma unroll
        for (int j = 0; j < 11; ++j) { raw[j] = hr[64 * j];
#pragma unroll
            for (int q = 0; q < 4; ++q) am = fmaxf(am, fmaxf(fabsf(bflo(raw[j][q])), fabsf(bfhi(raw[j][q])))); }
        am = fmaxf(am, shx<1>(am, lane)); am = fmaxf(am, shx<2>(am, lane)); am = fmaxf(am, shx<4>(am, lane)); am = fmaxf(am, shx<8>(am, lane)); am = fmaxf(am, shx<16>(am, lane)); am = fmaxf(am, shx<32>(am, lane));
        am = fmaxf(am, 1e-30f);
        const float inv = 127.0f / am;
        if (lane == 0) sa[m] = am * (1.0f / 127.0f);
        GAS v2u* o8 = (GAS v2u*)(out + (size_t)m * DFF) + lane;
#pragma unroll
        for (int j = 0; j < 11; ++j) { int q[8];
#pragma unroll
            for (int k = 0; k < 4; ++k) { q[2 * k] = (int)__builtin_rintf(bflo(raw[j][k]) * inv) & 0xff; q[2 * k + 1] = (int)__builtin_rintf(bfhi(raw[j][k]) * inv) & 0xff; }
            v2u o; o.x = (unsigned)(q[0] | (q[1] << 8) | (q[2] << 16) | (q[3] << 24)); o.y = (unsigned)(q[4] | (q[5] << 8) | (q[6] << 16) | (q[7] << 24)); o8[64 * j] = o; }
    }
}

__device__ __forceinline__ void outnorm_phase(const Ctx& F0, bf16* mix, const float* gain_a, const float* gain_b) {
    Ctx F = F0; { int w_ = F0.wave; asm volatile("" : "+s"(w_)); F.wave = w_; F.lane = lane_now(); F.tid = 64 * w_ + F.lane; }
    const int gw = F.vcu * NWAVES + F.wave, NGW = F.G * NWAVES, lane = F.lane;
    for (int mi = gw; mi < M; mi += NGW) { const int m = M - 1 - mi;
        GAS v4u* row = (GAS v4u*)(mix + (size_t)m * D);
        const v4u a = row[lane], b0 = row[64 + lane], b1 = row[128 + lane];
        float sa = 0.f, sb = 0.f;
#pragma unroll
        for (int j = 0; j < 4; ++j) { const float l0 = bflo(a[j]), h0 = bfhi(a[j]); sa += l0 * l0 + h0 * h0;
            const float l1 = bflo(b0[j]), h1 = bfhi(b0[j]), l2 = bflo(b1[j]), h2 = bfhi(b1[j]); sb += (l1 * l1 + h1 * h1) + (l2 * l2 + h2 * h2); }
        const float ra = 1.0f / sqrtf(wave_sum(sa, lane) * (1.f / 512.f) + NORM_EPS), rb = 1.0f / sqrtf(wave_sum(sb, lane) * (1.f / 1024.f) + NORM_EPS);
        const GAS f32x4* ga = (const GAS f32x4*)gain_a + 2 * lane; const GAS f32x4* gb0 = (const GAS f32x4*)gain_b + 2 * lane; const GAS f32x4* gb1 = gb0 + 128;
        v4u oa, ob0, ob1; const f32x4 g0 = ga[0], g1 = ga[1], h0 = gb0[0], h1 = gb0[1], k0 = gb1[0], k1 = gb1[1];
        oa.x = pk2(bflo(a.x) * ra * g0.x, bfhi(a.x) * ra * g0.y); oa.y = pk2(bflo(a.y) * ra * g0.z, bfhi(a.y) * ra * g0.w);
        oa.z = pk2(bflo(a.z) * ra * g1.x, bfhi(a.z) * ra * g1.y); oa.w = pk2(bflo(a.w) * ra * g1.z, bfhi(a.w) * ra * g1.w);
        ob0.x = pk2(bflo(b0.x) * rb * h0.x, bfhi(b0.x) * rb * h0.y); ob0.y = pk2(bflo(b0.y) * rb * h0.z, bfhi(b0.y) * rb * h0.w);
        ob0.z = pk2(bflo(b0.z) * rb * h1.x, bfhi(b0.z) * rb * h1.y); ob0.w = pk2(bflo(b0.w) * rb * h1.z, bfhi(b0.w) * rb * h1.w);
        ob1.x = pk2(bflo(b1.x) * rb * k0.x, bfhi(b1.x) * rb * k0.y); ob1.y = pk2(bflo(b1.y) * rb * k0.z, bfhi(b1.y) * rb * k0.w);
        ob1.z = pk2(bflo(b1.z) * rb * k1.x, bfhi(b1.z) * rb * k1.y); ob1.w = pk2(bflo(b1.w) * rb * k1.z, bfhi(b1.w) * rb * k1.w);
        row[lane] = oa; row[64 + lane] = ob0; row[128 + lane] = ob1;
    }
}
constexpr float QSCALE = 0.08838834764831845f * 1.4426950408889634f;
__device__ __forceinline__ void qknorm_rows(const Ctx& F0, bf16* p, const float* qn, const float* ksn, const float* kwn, const float* ctab, const float* stab) {
    Ctx F = F0; { int w_ = F0.wave; asm volatile("" : "+s"(w_)); F.wave = w_; F.lane = lane_now(); F.tid = 64 * w_ + F.lane; }
    const int gw = F.vcu * NWAVES + F.wave, NGW = F.G * NWAVES, lane = F.lane, l16 = lane & 15, grp = lane >> 4;
    int col[3]; float gg[3][8];
#pragma unroll
    for (int rnd = 0; rnd < 3; ++rnd) { const int hv = rnd * 4 + grp;
        col[rnd] = (hv < 8 ? C_NQ + hv * 128 : (hv < 10 ? C_NKS + (hv - 8) * 128 : C_NKW + (hv - 10) * 128)) + 8 * l16;
        const float* gp = hv < 8 ? qn : (hv < 10 ? ksn : kwn);
        const f32x4 g0 = *(const GAS f32x4*)(gp + 8 * l16), g1 = *(const GAS f32x4*)(gp + 8 * l16 + 4);
        gg[rnd][0] = g0.x; gg[rnd][1] = g0.y; gg[rnd][2] = g0.z; gg[rnd][3] = g0.w; gg[rnd][4] = g1.x; gg[rnd][5] = g1.y; gg[rnd][6] = g1.z; gg[rnd][7] = g1.w; }
    v4u cur[3], nxt[3];
    if (gw < M) {
#pragma unroll
        for (int rnd = 0; rnd < 3; ++rnd) cur[rnd] = *(const GAS v4u*)(p + (size_t)(M - 1 - gw) * LDP + col[rnd]); }
    for (int mi = gw; mi < M; mi += NGW) {
        const int m = M - 1 - mi, t = m & (T - 1);
        if (mi + NGW < M) {
#pragma unroll
            for (int rnd = 0; rnd < 3; ++rnd) nxt[rnd] = *(const GAS v4u*)(p + (size_t)(m - NGW) * LDP + col[rnd]); }
        f32x4 c0 = {0.f, 0.f, 0.f, 0.f}, c1 = c0, s0 = c0, s1 = c0;
        if (l16 < 4) { const GAS f32x4* cp = (const GAS f32x4*)(ctab + t * 16 + (l16 & 1) * 8); const GAS f32x4* sp = (const GAS f32x4*)(stab + t * 16 + (l16 & 1) * 8);
            c0 = cp[0]; c1 = cp[1]; s0 = sp[0]; s1 = sp[1]; }
#pragma unroll
        for (int rnd = 0; rnd < 3; ++rnd) {
            const v4u raw = cur[rnd];
            float v[8];
#pragma unroll
            for (int j = 0; j < 4; ++j) { v[2 * j] = bflo(raw[j]); v[2 * j + 1] = bfhi(raw[j]); }
            float ss = 0.f;
#pragma unroll
            for (int j = 0; j < 8; ++j) ss += v[j] * v[j];
            ss += shx<1>(ss, lane); ss += shx<2>(ss, lane); ss += shx<4>(ss, lane); ss += shx<8>(ss, lane);
            const float r = 1.0f / sqrtf(ss * (1.f / 128.f) + NORM_EPS);
            const float rs = rnd < 2 ? r * QSCALE : r;
#pragma unroll
            for (int j = 0; j < 8; ++j) v[j] *= rs * gg[rnd][j];
            float part[8];
#pragma unroll
            for (int j = 0; j < 8; ++j) part[j] = shx<2>(v[j], lane);
            if (rnd == 2 && l16 < 4) {
                const float cs[8] = {c0.x, c0.y, c0.z, c0.w, c1.x, c1.y, c1.z, c1.w}, sn[8] = {s0.x, s0.y, s0.z, s0.w, s1.x, s1.y, s1.z, s1.w};
#pragma unroll
                for (int j = 0; j < 8; ++j) v[j] = (l16 < 2) ? (v[j] * cs[j] - part[j] * sn[j]) : (v[j] * cs[j] + part[j] * sn[j]);
            }
            v4u o; o.x = pk2(v[0], v[1]); o.y = pk2(v[2], v[3]); o.z = pk2(v[4], v[5]); o.w = pk2(v[6], v[7]);
            *(GAS v4u*)(p + (size_t)m * LDP + col[rnd]) = o;
        }
#pragma unroll
        for (int rnd = 0; rnd < 3; ++rnd) cur[rnd] = nxt[rnd];
    }
}
__device__ __forceinline__ void compress_items(const Ctx& F0, const bf16* p, const float* pe_k, const float* pe_v, const bf16* w1t  , const bf16* w2t  ,
                                               const float* kcn, bf16* kc, bf16* vc) {
    Ctx F = F0; { int w_ = F0.wave; asm volatile("" : "+s"(w_)); F.wave = w_; F.lane = lane_now(); F.tid = 64 * w_ + F.lane; }
    const int lane = F.lane, r = lane & 15, quad = lane >> 4, w = F.wave;
    LAS f32x4* red = (LAS f32x4*)F.lds;
    for (int item = F.vcu; item < 256; item += F.G) {
        const int which = (item >> 7) & 1, b = (item >> 4) & 7, kv = (item >> 3) & 1, rt2 = item & 7;
        const bf16* src[2];
#pragma unroll
        for (int t2 = 0; t2 < 2; ++t2) { const int n = 32 * rt2 + 16 * t2 + r, nc = n < NCMP ? n : NCMP - 1;
            src[t2] = p + (size_t)(b * T + 16 * nc) * LDP + (which ? C_NVC : C_NKC) + kv * 128; }
        const float* pe = which ? pe_v : pe_k;
        const bf16* w1 = w1t + (size_t)which * 128 * 4096;
        f32x4 acc[2][8];
#pragma unroll
        for (int t2 = 0; t2 < 2; ++t2)
#pragma unroll
            for (int i = 0; i < 8; ++i) acc[t2][i] = (f32x4){0.f, 0.f, 0.f, 0.f};
        for (int s2 = 0; s2 < 8; ++s2) {
            v4u raw[2][2]; f32x4 pp[2][2]; v4u yb[2][8];
#pragma unroll
            for (int h = 0; h < 2; ++h) { const int k = 32 * (16 * w + 2 * s2 + h) + 8 * quad, j = k >> 7, d = k & 127;
                raw[h][0] = *(const GAS v4u*)(src[0] + (size_t)j * LDP + d); raw[h][1] = *(const GAS v4u*)(src[1] + (size_t)j * LDP + d);
                pp[h][0] = *(const GAS f32x4*)(pe + j * 128 + d); pp[h][1] = *(const GAS f32x4*)(pe + j * 128 + d + 4);
#pragma unroll
                for (int tl = 0; tl < 8; ++tl) yb[h][tl] = *(const GAS v4u*)(w1 + (size_t)(16 * tl + r) * 4096 + k); }
#pragma unroll
            for (int h = 0; h < 2; ++h)
#pragma unroll
                for (int t2 = 0; t2 < 2; ++t2) { const v4u rw = raw[h][t2];
                    v4u xa; xa.x = pk2(bflo(rw.x) + pp[h][0].x, bfhi(rw.x) + pp[h][0].y); xa.y = pk2(bflo(rw.y) + pp[h][0].z, bfhi(rw.y) + pp[h][0].w);
                    xa.z = pk2(bflo(rw.z) + pp[h][1].x, bfhi(rw.z) + pp[h][1].y); xa.w = pk2(bflo(rw.w) + pp[h][1].z, bfhi(rw.w) + pp[h][1].w);
                    const bf16x8 xf = __builtin_bit_cast(bf16x8, xa);
#pragma unroll
                    for (int tl = 0; tl < 8; ++tl) acc[t2][tl] = mfma16(xf, __builtin_bit_cast(bf16x8, yb[h][tl]), acc[t2][tl]); }
        }
#pragma unroll
        for (int t2 = 0; t2 < 2; ++t2)
#pragma unroll
            for (int tl = 0; tl < 8; ++tl) red[((w * 2 + t2) * 8 + tl) * 64 + lane] = acc[t2][tl];
        __syncthreads();
        LAS bf16* hsw = (LAS bf16*)(F.lds + 131072 + (w >> 2) * 4352);
#pragma unroll
        for (int c2 = 0; c2 < 2; ++c2) { const int tl = 2 * (w & 3) + c2, t2 = w >> 2;
            f32x4 a = red[((0 * 2 + t2) * 8 + tl) * 64 + lane];
#pragma unroll
            for (int ww = 1; ww < 8; ++ww) a += red[((ww * 2 + t2) * 8 + tl) * 64 + lane];
#pragma unroll
            for (int j = 0; j < 4; ++j) hsw[(4 * quad + j) * 136 + 16 * tl + r] = (bf16)f2bf(gelu_tanh(a[j])); }
        __syncthreads();
        if (w < 2) {
            const int t2 = w; const LAS bf16* hs = (const LAS bf16*)(F.lds + 131072 + t2 * 4352);
            v4u w2f[4][8];
            { const bf16* w2p = w2t + (size_t)which * 128 * 128;
#pragma unroll
                for (int s = 0; s < 4; ++s)
#pragma unroll
                    for (int tl = 0; tl < 8; ++tl) w2f[s][tl] = *(const GAS v4u*)(w2p + (size_t)(16 * tl + r) * 128 + 32 * s + 8 * quad); }
            __builtin_amdgcn_sched_barrier(0);
            f32x4 a2[8];
#pragma unroll
            for (int i = 0; i < 8; ++i) a2[i] = (f32x4){0.f, 0.f, 0.f, 0.f};
#pragma unroll
            for (int s = 0; s < 4; ++s) {
                const bf16x8 xf = *(const LAS bf16x8*)(hs + r * 136 + 32 * s + 8 * quad);
#pragma unroll
                for (int tl = 0; tl < 8; ++tl) a2[tl] = mfma16(xf, __builtin_bit_cast(bf16x8, w2f[s][tl]), a2[tl]);
            }
            float sc[4] = {1.f, 1.f, 1.f, 1.f};
            if (which == 0) {
#pragma unroll
                for (int j = 0; j < 4; ++j) { float ss = 0.f;
#pragma unroll
                    for (int tl = 0; tl < 8; ++tl) ss += a2[tl][j] * a2[tl][j];
                    ss += shx<1>(ss, lane); ss += shx<2>(ss, lane); ss += shx<4>(ss, lane); ss += shx<8>(ss, lane);
                    sc[j] = 1.0f / sqrtf(ss * (1.f / 128.f) + NORM_EPS); }
            }
            bf16* dst = (which ? vc : kc) + (size_t)((b * 2 + kv) * NCMP_PAD) * 128;
#pragma unroll
            for (int tl = 0; tl < 8; ++tl) { const float g = which ? 1.f : kcn[16 * tl + r];
#pragma unroll
                for (int j = 0; j < 4; ++j) { const int row = 32 * rt2 + 16 * t2 + 4 * quad + j; dst[(size_t)row * 128 + 16 * tl + r] = row < NCMP ? (bf16)f2bf(a2[tl][j] * sc[j] * g) : (bf16)0; } }
        }
        __syncthreads();
    }
}
constexpr int LRU_WA = 0, LRU_WX = 9216, LRU_XC = 18432, LRU_XCF = 27648, LRU_A = LRU_XCF + 16640, LRU_MU = LRU_A + 16640, LRU_IX = LRU_MU + 16640,
              LRU_SEG = LRU_IX + 16640, LRU_H = LRU_SEG + 4096, LRU_CONST = LRU_H + 512, LRU_END = LRU_CONST + 8 * 256;
#define LRU_BAR() do { asm volatile("s_waitcnt lgkmcnt(0)" ::: "memory"); __builtin_amdgcn_s_barrier(); asm volatile("" ::: "memory"); } while (0)
__device__ __forceinline__ void lru_unit(const Ctx& F, int b, int nb, const bf16* p, bf16* mix, const float* conv_w, const float* conv_b, const float* ga_w, const float* ga_b,
                                         const float* gx_w, const float* gx_b, const float* lam) {
    LAS unsigned char* L = F.lds;
    LAS bf16* WaT = (LAS bf16*)(L + LRU_WA); LAS bf16* WxT = (LAS bf16*)(L + LRU_WX); LAS bf16* Xc = (LAS bf16*)(L + LRU_XC);
    LAS float* XcF = (LAS float*)(L + LRU_XCF); LAS float* Aa = (LAS float*)(L + LRU_A); LAS float* Mu = (LAS float*)(L + LRU_MU); LAS float* IX = (LAS float*)(L + LRU_IX);
    LAS float* SEG = (LAS float*)(L + LRU_SEG); LAS float* H = (LAS float*)(L + LRU_H); LAS float* CST = (LAS float*)(L + LRU_CONST);
    int w = F.wave; asm volatile("" : "+s"(w));
    const int tid = 64 * w + lane_now();
    const int lane = tid & 63, c = tid & 63, seg = tid >> 6, r = lane & 15, quad = lane >> 4;
    const int c0 = 64 * nb;
    for (int e = tid; e < 4096; e += 512) { const int i = e >> 6, o = e & 63; WaT[o * 72 + i] = (bf16)f2bf(ga_w[(size_t)nb * 4096 + e]); WxT[o * 72 + i] = (bf16)f2bf(gx_w[(size_t)nb * 4096 + e]); }
    if (tid < 64) { CST[0 * 64 + tid] = conv_w[0 * 512 + c0 + tid]; CST[1 * 64 + tid] = conv_w[1 * 512 + c0 + tid]; CST[2 * 64 + tid] = conv_w[2 * 512 + c0 + tid]; CST[3 * 64 + tid] = conv_w[3 * 512 + c0 + tid];
        CST[4 * 64 + tid] = conv_b[c0 + tid]; CST[5 * 64 + tid] = ga_b[c0 + tid]; CST[6 * 64 + tid] = gx_b[c0 + tid];
        const float nl = -lam[c0 + tid]; CST[7 * 64 + tid] = fmaxf(nl, 0.f) + log1pf(expf(-fabsf(nl)));
        H[tid] = 0.f; H[64 + tid] = 0.f; }
    __syncthreads();
    const float cw0 = CST[c], cw1 = CST[64 + c], cw2 = CST[128 + c], cw3 = CST[192 + c], cb = CST[256 + c];
    const bf16* ubase = p + (long)(b * T + 8 * seg - 3) * LDP + C_LRUX + c0 + c;
    const bf16* ybase = p + (size_t)(b * T + 8 * seg) * LDP + C_LRUY + c0 + c;
    bf16 un[11], yn[8];
#pragma unroll
    for (int k = 0; k < 11; ++k) un[k] = (8 * seg - 3 + k >= 0) ? ubase[(long)k * LDP] : (bf16)0;
#pragma unroll
    for (int k = 0; k < 8; ++k) yn[k] = ybase[(size_t)k * LDP];
    for (int tt = 0; tt < T / 64; ++tt) {
        const int t0 = 64 * tt, cur = tt & 1;
        float u[11], yv[8];
#pragma unroll
        for (int k = 0; k < 11; ++k) u[k] = bf2f(un[k]);
#pragma unroll
        for (int k = 0; k < 8; ++k) yv[k] = bf2f(yn[k]);
        if (tt + 1 < T / 64) {
#pragma unroll
            for (int k = 0; k < 11; ++k) un[k] = ubase[(long)(t0 + 64 + k) * LDP];
#pragma unroll
            for (int k = 0; k < 8; ++k) yn[k] = ybase[(size_t)(t0 + 64 + k) * LDP];
        }
#pragma unroll
        for (int k = 0; k < 8; ++k) { const float xc = u[k] * cw0 + u[k + 1] * cw1 + u[k + 2] * cw2 + u[k + 3] * cw3 + cb;
            XcF[(8 * seg + k) * 65 + c] = xc; Xc[(8 * seg + k) * 72 + c] = (bf16)f2bf(xc); }
        LRU_BAR();
        { const int tm = w & 3, ch = w >> 2;
            f32x4 aa[2], ax[2];
#pragma unroll
            for (int c2 = 0; c2 < 2; ++c2) { aa[c2] = (f32x4){0.f, 0.f, 0.f, 0.f}; ax[c2] = (f32x4){0.f, 0.f, 0.f, 0.f}; }
#pragma unroll
            for (int s = 0; s < 2; ++s) { const bf16x8 xf = *(const LAS bf16x8*)(Xc + (16 * tm + r) * 72 + 32 * s + 8 * quad);
#pragma unroll
                for (int c2 = 0; c2 < 2; ++c2) { const int ct = 2 * ch + c2;
                    const bf16x8 ya = *(const LAS bf16x8*)(WaT + (16 * ct + r) * 72 + 32 * s + 8 * quad), yx = *(const LAS bf16x8*)(WxT + (16 * ct + r) * 72 + 32 * s + 8 * quad);
                    aa[c2] = mfma16(xf, ya, aa[c2]); ax[c2] = mfma16(xf, yx, ax[c2]); } }
#pragma unroll
            for (int c2 = 0; c2 < 2; ++c2) { const int o = 16 * (2 * ch + c2) + r; const float ba = CST[5 * 64 + o], bx = CST[6 * 64 + o], sp = CST[7 * 64 + o];
#pragma unroll
                for (int j = 0; j < 4; ++j) { const int t = 16 * tm + 4 * quad + j;
                    const float rg = sigmoidf_(aa[c2][j] + ba); const float a = __builtin_amdgcn_exp2f(-8.0f * 1.44269504089f * rg * sp);
                    Aa[t * 65 + o] = a; Mu[t * 65 + o] = __builtin_amdgcn_sqrtf(fmaxf(1.0f - a * a, 0.f));
                    const float ig = sigmoidf_(ax[c2][j] + bx); IX[t * 65 + o] = ig * XcF[t * 65 + o]; } } }
        LRU_BAR();
        float hl[8], pc[8];
        { float h = 0.f, P = 1.f;
#pragma unroll
            for (int k = 0; k < 8; ++k) { const int t = 8 * seg + k; const float a = Aa[t * 65 + c]; h = a * h + Mu[t * 65 + c] * IX[t * 65 + c]; P *= a; hl[k] = h; pc[k] = P; }
            SEG[(seg * 64 + c) * 2] = P; SEG[(seg * 64 + c) * 2 + 1] = h; }
        LRU_BAR();
        { float carry = H[cur * 64 + c];
            float sp_[7], sh_[7];
#pragma unroll
            for (int s = 0; s < 7; ++s) { sp_[s] = SEG[(s * 64 + c) * 2]; sh_[s] = SEG[(s * 64 + c) * 2 + 1]; }
#pragma unroll
            for (int s = 0; s < 7; ++s) if (s < w) carry = sp_[s] * carry + sh_[s];
            bf16* op = mix + (size_t)(b * T + t0 + 8 * seg) * D + MIX_A + c0 + c;
            float hf = 0.f;
#pragma unroll
            for (int k = 0; k < 8; ++k) { hf = hl[k] + pc[k] * carry; op[(size_t)k * D] = (bf16)f2bf(hf * gelu_tanh(yv[k])); }
            if (seg == 7) H[(cur ^ 1) * 64 + c] = hf; }
        LRU_BAR();
    }
}
constexpr int GL_QT = 0, GL_KT = 9216, GL_KHT = 18432, GL_AM = 27648, GL_VT = 36864, GL_ST = GL_VT + 18432, GL_ALR = GL_ST + 18432, GL_EB = GL_ALR + 2 * 4096, GL_SEGS = GL_EB + 256,
              GL_RS = GL_SEGS + 2048, GL_END = GL_RS + 512;
__device__ __forceinline__ float exp_fast(float x) { return __builtin_amdgcn_exp2f(x * 1.44269504089f); }
__device__ __forceinline__ void gla_unit(const Ctx& F, int b, int h, const bf16* p, bf16* mix, const float* a_w2, const float* a_b, const float* onorm) {
    LAS unsigned char* L = F.lds;
    LAS bf16* Qt = (LAS bf16*)(L + GL_QT); LAS bf16* Kt = (LAS bf16*)(L + GL_KT); LAS bf16* KhT = (LAS bf16*)(L + GL_KHT); LAS bf16* Am = (LAS bf16*)(L + GL_AM);
    LAS bf16* VT = (LAS bf16*)(L + GL_VT); LAS bf16* ST = (LAS bf16*)(L + GL_ST); LAS float* ALR = (LAS float*)(L + GL_ALR); LAS float* EB = (LAS float*)(L + GL_EB); LAS float* SEGS = (LAS float*)(L + GL_SEGS);
    LAS float* RS = (LAS float*)(L + GL_RS);
    int w = F.wave; asm volatile("" : "+s"(w));
    const int tid = 64 * w + lane_now();
    const int lane = tid & 63, d = tid & 63, seg = tid >> 6, r = lane & 15, quad = lane >> 4;
    float aw[16];
#pragma unroll
    for (int rr = 0; rr < 16; ++rr) aw[rr] = a_w2[rr * 256 + h * 64 + d];
    const float abd = a_b[h * 64 + d];
    const int dt = w & 3, eh = w >> 2, it = w & 3;
    f32x4 Sacc[4];
#pragma unroll
    for (int et = 0; et < 4; ++et) Sacc[et] = (f32x4){0.f, 0.f, 0.f, 0.f};
    float gn[4][4];
#pragma unroll
    for (int et = 0; et < 4; ++et)
#pragma unroll
        for (int j = 0; j < 4; ++j) gn[et][j] = onorm[64 * eh + 16 * et + 4 * quad + j];
    const size_t rowb = (size_t)b * T;
    const bf16* qbase = p + (rowb + 8 * seg) * LDP + C_GQ + h * 64 + d;
    const bf16* vbase = p + (rowb + (tid >> 3)) * LDP + C_GV + h * 128 + 16 * (tid & 7);
    const bf16* abase = p + (rowb + (tid >> 1)) * LDP + C_GA + 8 * (tid & 1);
    const bf16* gbase = p + (rowb + 16 * it + r) * LDP + C_GG + h * 128 + 64 * eh + 4 * quad;
    bf16 qn[8], kn[8]; v4u vn0, vn1, an = {0u, 0u, 0u, 0u}; v2u ggn[4];
#pragma unroll
    for (int k = 0; k < 8; ++k) { qn[k] = qbase[(size_t)k * LDP]; kn[k] = qbase[(size_t)k * LDP + (C_GK - C_GQ)]; }
    vn0 = *(const GAS v4u*)vbase; vn1 = *(const GAS v4u*)(vbase + 8);
    if (tid < 128) an = *(const GAS v4u*)abase;
#pragma unroll
    for (int et = 0; et < 4; ++et) ggn[et] = *(const GAS v2u*)(gbase + 16 * et);
    if (tid < 128) { LAS float* ap = ALR + (tid >> 1) * 16 + 8 * (tid & 1);
#pragma unroll
        for (int q = 0; q < 4; ++q) { ap[2 * q] = bflo(an[q]); ap[2 * q + 1] = bfhi(an[q]); } }
    __syncthreads();
    for (int ch = 0; ch < T / 64; ++ch) {
        const size_t row0 = rowb + 64 * ch;
        const LAS float* alr = ALR + (ch & 1) * 1024;
        float qv[8], kv[8]; v4u v0 = vn0, v1 = vn1; v2u gg[4];
#pragma unroll
        for (int k = 0; k < 8; ++k) { qv[k] = bf2f(qn[k]) * 0.125f; kv[k] = bf2f(kn[k]); }
#pragma unroll
        for (int et = 0; et < 4; ++et) gg[et] = ggn[et];
        if (ch + 1 < T / 64) { const size_t o = (size_t)(64 * (ch + 1)) * LDP;
#pragma unroll
            for (int k = 0; k < 8; ++k) { qn[k] = qbase[o + (size_t)k * LDP]; kn[k] = qbase[o + (size_t)k * LDP + (C_GK - C_GQ)]; }
            vn0 = *(const GAS v4u*)(vbase + o); vn1 = *(const GAS v4u*)(vbase + o + 8);
            if (tid < 128) an = *(const GAS v4u*)(abase + o);
#pragma unroll
            for (int et = 0; et < 4; ++et) ggn[et] = *(const GAS v2u*)(gbase + o + 16 * et); }
        float bl[8];
        { float run = 0.f;
#pragma unroll
            for (int k = 0; k < 8; ++k) { const LAS f32x4* ar = (const LAS f32x4*)(alr + (8 * seg + k) * 16);
                float z = abd;
#pragma unroll
                for (int q = 0; q < 4; ++q) { const f32x4 a4 = ar[q]; z += (a4.x * aw[4 * q] + a4.y * aw[4 * q + 1]) + (a4.z * aw[4 * q + 2] + a4.w * aw[4 * q + 3]); }
                const float ls = fminf(z, 0.f) - 0.69314718056f * __builtin_amdgcn_logf(1.0f + exp_fast(-fabsf(z)));
                run += ls * (1.0f / 16.0f); bl[k] = run; }
            SEGS[seg * 64 + d] = run; }
#pragma unroll
        for (int et = 0; et < 4; ++et) { v2u wv; wv.x = pk2(Sacc[et][0], Sacc[et][1]); wv.y = pk2(Sacc[et][2], Sacc[et][3]);
            *(LAS v2u*)(ST + (64 * eh + 16 * et + r) * 72 + 16 * dt + 4 * quad) = wv; }
        { const int j = tid >> 3, e0 = 16 * (tid & 7);
#pragma unroll
            for (int q = 0; q < 4; ++q) { VT[(e0 + 2 * q) * 72 + j] = (bf16)(v0[q] & 0xffffu); VT[(e0 + 2 * q + 1) * 72 + j] = (bf16)(v0[q] >> 16);
                VT[(e0 + 8 + 2 * q) * 72 + j] = (bf16)(v1[q] & 0xffffu); VT[(e0 + 8 + 2 * q + 1) * 72 + j] = (bf16)(v1[q] >> 16); } }
        LRU_BAR();
        { float pre = 0.f, tot = 0.f;
#pragma unroll
            for (int s = 0; s < 8; ++s) { const float v = SEGS[s * 64 + d]; tot += v; if (s < seg) pre += v; }
            if (seg == 0) EB[d] = exp_fast(tot);
#pragma unroll
            for (int k = 0; k < 8; ++k) { const int j = 8 * seg + k; const float bb = bl[k] + pre;
                Qt[j * 72 + d] = (bf16)f2bf(qv[k] * exp_fast(bb)); Kt[j * 72 + d] = (bf16)f2bf(kv[k] * exp_fast(-bb)); KhT[d * 72 + j] = (bf16)f2bf(kv[k] * exp_fast(tot - bb)); } }
        LRU_BAR();
        f32x4 Oacc[4];
#pragma unroll
        for (int et = 0; et < 4; ++et) Oacc[et] = (f32x4){0.f, 0.f, 0.f, 0.f};
        { bf16x8 qf[2];
#pragma unroll
            for (int s = 0; s < 2; ++s) qf[s] = *(const LAS bf16x8*)(Qt + (16 * it + r) * 72 + 32 * s + 8 * quad);
#pragma unroll
            for (int et = 0; et < 4; ++et)
#pragma unroll
                for (int s = 0; s < 2; ++s) { const bf16x8 sf = *(const LAS bf16x8*)(ST + (64 * eh + 16 * et + r) * 72 + 32 * s + 8 * quad); Oacc[et] = mfma16(sf, qf[s], Oacc[et]); }
            const int jt = w & 3;
#pragma unroll
            for (int ii = 0; ii < 2; ++ii) { const int itl = 2 * (w >> 2) + ii; f32x4 a = (f32x4){0.f, 0.f, 0.f, 0.f};
#pragma unroll
                for (int s = 0; s < 2; ++s) { const bf16x8 kf = *(const LAS bf16x8*)(Kt + (16 * jt + r) * 72 + 32 * s + 8 * quad); const bf16x8 q2 = *(const LAS bf16x8*)(Qt + (16 * itl + r) * 72 + 32 * s + 8 * quad);
                    a = mfma16(kf, q2, a); }
                const int i = 16 * itl + r, j0 = 16 * jt + 4 * quad;
                v2u wv; wv.x = pk2(j0 <= i ? a[0] : 0.f, j0 + 1 <= i ? a[1] : 0.f); wv.y = pk2(j0 + 2 <= i ? a[2] : 0.f, j0 + 3 <= i ? a[3] : 0.f);
                *(LAS v2u*)(Am + i * 72 + j0) = wv; } }
        LRU_BAR();
        { bf16x8 af[2];
#pragma unroll
            for (int s = 0; s < 2; ++s) af[s] = *(const LAS bf16x8*)(Am + (16 * it + r) * 72 + 32 * s + 8 * quad);
#pragma unroll
            for (int et = 0; et < 4; ++et)
#pragma unroll
                for (int s = 0; s < 2; ++s) { const bf16x8 vf = *(const LAS bf16x8*)(VT + (64 * eh + 16 * et + r) * 72 + 32 * s + 8 * quad); Oacc[et] = mfma16(vf, af[s], Oacc[et]); }
            const f32x4 eb = *(const LAS f32x4*)(EB + 16 * dt + 4 * quad);
            bf16x8 kf[2];
#pragma unroll
            for (int s = 0; s < 2; ++s) kf[s] = *(const LAS bf16x8*)(KhT + (16 * dt + r) * 72 + 32 * s + 8 * quad);
#pragma unroll
            for (int et = 0; et < 4; ++et) { Sacc[et] = Sacc[et] * eb;
#pragma unroll
                for (int s = 0; s < 2; ++s) { const bf16x8 vf = *(const LAS bf16x8*)(VT + (64 * eh + 16 * et + r) * 72 + 32 * s + 8 * quad); Sacc[et] = mfma16(kf[s], vf, Sacc[et]); } } }
        if (tid < 128 && ch + 1 < T / 64) { LAS float* ap = ALR + ((ch + 1) & 1) * 1024 + (tid >> 1) * 16 + 8 * (tid & 1);
#pragma unroll
            for (int q = 0; q < 4; ++q) { ap[2 * q] = bflo(an[q]); ap[2 * q + 1] = bfhi(an[q]); } }
        { float ss = 0.f;
#pragma unroll
            for (int et = 0; et < 4; ++et) ss += (Oacc[et][0] * Oacc[et][0] + Oacc[et][1] * Oacc[et][1]) + (Oacc[et][2] * Oacc[et][2] + Oacc[et][3] * Oacc[et][3]);
            ss += shx<16>(ss, lane); ss += shx<32>(ss, lane);
            if (quad == 0) RS[(16 * it + r) * 2 + eh] = ss; }
        LRU_BAR();
        { const float tot = RS[(16 * it + r) * 2] + RS[(16 * it + r) * 2 + 1];
            const float rn = 1.0f / sqrtf(tot * (1.f / 128.f) + NORM_EPS);
            const size_t row = row0 + 16 * it + r;
#pragma unroll
            for (int et = 0; et < 4; ++et) { const int e = 64 * eh + 16 * et + 4 * quad;
                const float g0 = bflo(gg[et].x), g1 = bfhi(gg[et].x), g2 = bflo(gg[et].y), g3 = bfhi(gg[et].y);
                v2u o; o.x = pk2(Oacc[et][0] * rn * gn[et][0] * g0 * sigmoidf_(g0), Oacc[et][1] * rn * gn[et][1] * g1 * sigmoidf_(g1));
                o.y = pk2(Oacc[et][2] * rn * gn[et][2] * g2 * sigmoidf_(g2), Oacc[et][3] * rn * gn[et][3] * g3 * sigmoidf_(g3));
                *(GAS v2u*)(mix + row * D + MIX_C + h * 128 + e) = o; } }
    }
}
constexpr int AT_SLOT = 32768, AT_IMP = 65536, AT_SELM = 131072, AT_END = AT_SELM + 512;
typedef short v4i16_t __attribute__((ext_vector_type(4)));
__device__ __forceinline__ unsigned off_b(unsigned row, unsigned ch) { return 256u * row + 16u * (ch ^ (((row & 3u) << 2) | ((row >> 2) & 3u))); }
struct TileSrc { const bf16* base; size_t stride; };
__device__ __forceinline__ void glds16(const void* sbase, unsigned voff, unsigned lds_dst) { unsigned keep;
    asm volatile("s_mov_b32 %0, m0\n\ts_mov_b32 m0, %3\n\ts_nop 0\n\tglobal_load_lds_dwordx4 %1, %2\n\ts_mov_b32 m0, %0" : "=&s"(keep) : "v"(voff), "s"(sbase), "s"(lds_dst) : "memory"); }
__device__ __forceinline__ unsigned tile_lane_off(int i, int wave, int lane, unsigned stride) {
    const int seg = 2 * wave + i; const unsigned row = 4u * seg + (lane >> 4), ch = (lane & 15u) ^ (((row & 3u) << 2) | ((row >> 2) & 3u));
    return (row * stride + 8u * ch) * 2u; }
__device__ __forceinline__ void tile_dma(const TileSrc& s, int tl, LAS unsigned char* buf, int wave, unsigned lo0, unsigned lo1) {
    const bf16* tb = s.base + (size_t)(64 * tl) * s.stride;
    glds16(tb, lo0, (unsigned)(size_t)(buf + 1024 * (2 * wave))); glds16(tb, lo1, (unsigned)(size_t)(buf + 1024 * (2 * wave + 1)));
}
#define AT_LDS_BAR() do { asm volatile("s_waitcnt lgkmcnt(0)" ::: "memory"); __builtin_amdgcn_s_barrier(); asm volatile("" ::: "memory"); } while (0)
#define AT_DRAIN_BAR() do { asm volatile("s_waitcnt vmcnt(0) lgkmcnt(0)" ::: "memory"); __builtin_amdgcn_s_barrier(); asm volatile("" ::: "memory"); } while (0)
typedef float f32x2_t __attribute__((ext_vector_type(2))); typedef __bf16 bf16x2_t __attribute__((ext_vector_type(2)));
__device__ __forceinline__ unsigned cvtpk(float lo, float hi) { const f32x2_t v = {lo, hi}; const bf16x2_t b = __builtin_convertvector(v, bf16x2_t); return __builtin_bit_cast(unsigned, b); }
enum { BR_CMP = 0, BR_SEL = 1, BR_WIN = 2 };
constexpr float AT_SC = 0.08838834764831845f * 1.4426950408889634f;
__device__ __forceinline__ void qk_tile(const LAS unsigned char* kb, const bf16x8 (&qf)[8], int lane, f32x16 (&sacc)[2]) {
#pragma unroll
    for (int kt = 0; kt < 2; ++kt) {
        f32x16 a = {0.f, 0.f, 0.f, 0.f, 0.f, 0.f, 0.f, 0.f, 0.f, 0.f, 0.f, 0.f, 0.f, 0.f, 0.f, 0.f};
#pragma unroll
        for (int s = 0; s < 8; ++s) { const bf16x8 kf = *(const LAS bf16x8*)(kb + off_b(32 * kt + (lane & 31), 2 * s + (lane >> 5))); a = mfma32(kf, qf[s], a); }
        sacc[kt] = a;
    }
}
template <int BR> __device__ __forceinline__ bool key_ok(int key, int t, bool selbit) {
    if (BR == BR_CMP) return 16 * key + 31 <= t;
    if (BR == BR_SEL) return selbit && key <= t;
    return key <= t && key + 512 > t;
}
template <int BR, int MODE, int NSLOT>
__device__ __forceinline__ void attn_branch(const Ctx& F, const TileSrc& ks, const TileSrc& vs, int lo, int hi, const bf16x8 (&qf)[8], int t, float gate, float shift, unsigned long long selmask,
                                            float* yb  , bf16* outp  , LAS float* imp_row  ) {
    const int lane = F.lane, hh = lane >> 5, wv = F.wave;
    const float NEG_INF = -__builtin_inff();
    f32x16 obr[4];
#pragma unroll
    for (int c = 0; c < 4; ++c) obr[c] = (f32x16){0.f, 0.f, 0.f, 0.f, 0.f, 0.f, 0.f, 0.f, 0.f, 0.f, 0.f, 0.f, 0.f, 0.f, 0.f, 0.f};
    float imp_carry = 0.f; f32x2_t l2 = {0.f, 0.f};
    asm volatile("s_waitcnt lgkmcnt(0)" ::: "memory"); __builtin_amdgcn_s_barrier(); asm volatile("" ::: "memory");
    const int n = hi - lo;
    const unsigned lo0 = tile_lane_off(0, wv, lane, (unsigned)ks.stride), lo1 = tile_lane_off(1, wv, lane, (unsigned)ks.stride);
    constexpr int NPRE = NSLOT == 4 ? 2 : NSLOT - 1;
#pragma unroll
    for (int j = 0; j < NPRE; ++j) if (j < n) { tile_dma(ks, lo + j, F.lds + j * AT_SLOT, wv, lo0, lo1); tile_dma(vs, lo + j, F.lds + j * AT_SLOT + 16384, wv, lo0, lo1); }
    const unsigned trq = (lane & 15) >> 2, trp = lane & 3, trblk = (lane >> 4) & 1;
    unsigned vof0[4], vof1[4];
    { const unsigned lc = 2u * trblk + (trp >> 1), hq = (unsigned)hh;
#pragma unroll
        for (unsigned c = 0; c < 4; ++c) { vof0[c] = 256u * (4u * hq + trq) + 16u * (((c ^ trq) << 2) | (lc ^ hq)) + 8u * (trp & 1u);
            vof1[c] = 256u * (4u * hq + trq + 8u) + 16u * (((c ^ trq) << 2) | (lc ^ (hq + 2u))) + 8u * (trp & 1u); } }
    for (int i = 0; i < n; ++i) {
        const int tl = lo + i, slot = i & (NSLOT - 1);
        if (NSLOT == 4) {
            if ((i & 1) == 0) {
                asm volatile("s_waitcnt vmcnt(0) lgkmcnt(0)" ::: "memory"); __builtin_amdgcn_s_barrier(); asm volatile("" ::: "memory");
#pragma unroll
                for (int j = 2; j < 4; ++j) if (i + j < n) { const int ns = (i + j) & 3; tile_dma(ks, tl + j, F.lds + ns * AT_SLOT, wv, lo0, lo1); tile_dma(vs, tl + j, F.lds + ns * AT_SLOT + 16384, wv, lo0, lo1); }
            }
        } else {
            asm volatile("s_waitcnt vmcnt(0) lgkmcnt(0)" ::: "memory"); __builtin_amdgcn_s_barrier(); asm volatile("" ::: "memory");
            if (i + 1 < n) { const int ns = (i + 1) & 1; tile_dma(ks, tl + 1, F.lds + ns * AT_SLOT, wv, lo0, lo1); tile_dma(vs, tl + 1, F.lds + ns * AT_SLOT + 16384, wv, lo0, lo1); }
        }
        const LAS unsigned char* kb = F.lds + slot * AT_SLOT; const LAS unsigned char* vb = kb + 16384;
        const bool selbit = (selmask >> tl) & 1ull;
        const float ainit = (BR == BR_SEL && !selbit) ? NEG_INF : -shift;
        const bool masked = BR == BR_CMP || tl == hi - 1 || (BR == BR_WIN && tl + 8 == hi - 1);
        bf16x8 pf[2][2];
#pragma unroll
        for (int kt = 0; kt < 2; ++kt) {
            f32x16 sa = {ainit, ainit, ainit, ainit, ainit, ainit, ainit, ainit, ainit, ainit, ainit, ainit, ainit, ainit, ainit, ainit};
            bf16x8 kfr[8];
#pragma unroll
            for (int s = 0; s < 8; ++s) kfr[s] = *(const LAS bf16x8*)(kb + off_b(32 * kt + (lane & 31), 2 * s + (lane >> 5)));
            __builtin_amdgcn_sched_barrier(0);
#pragma unroll
            for (int s = 0; s < 8; ++s) sa = mfma32(kfr[s], qf[s], sa);
            float pv[16];
            if (masked) {
#pragma unroll
                for (int i2 = 0; i2 < 16; ++i2) { const int key = 64 * tl + 32 * kt + (i2 & 3) + 8 * (i2 >> 2) + 4 * hh;
                    pv[i2] = __builtin_amdgcn_exp2f(key_ok<BR>(key, t, true) ? sa[i2] : NEG_INF); }
            } else {
#pragma unroll
                for (int i2 = 0; i2 < 16; ++i2) pv[i2] = __builtin_amdgcn_exp2f(sa[i2]);
            }
            { f32x2_t t0 = (f32x2_t){pv[0], pv[1]} + (f32x2_t){pv[2], pv[3]}, t1 = (f32x2_t){pv[4], pv[5]} + (f32x2_t){pv[6], pv[7]}, t2 = (f32x2_t){pv[8], pv[9]} + (f32x2_t){pv[10], pv[11]}, t3 = (f32x2_t){pv[12], pv[13]} + (f32x2_t){pv[14], pv[15]};
              l2 += (t0 + t1) + (t2 + t3); }
            if (BR == BR_CMP) {
                float x[4];
#pragma unroll
                for (int gi = 0; gi < 4; ++gi) x[gi] = shx<32>(pv[4 * gi + 3], lane);
#pragma unroll
                for (int gi = 0; gi < 4; ++gi) { const int sb = 16 * tl + 8 * kt + 2 * gi + hh;
                    const float s4 = (pv[4 * gi] + pv[4 * gi + 1]) + (pv[4 * gi + 2] + pv[4 * gi + 3]);
                    const float extra = hh ? x[gi] : (gi == 0 ? imp_carry : x[gi > 0 ? gi - 1 : 0]);
                    imp_row[sb] = s4 + extra; }
                imp_carry = x[3];
            }
            v4u w0, w1;
            w0.x = cvtpk(pv[0], pv[1]); w0.y = cvtpk(pv[2], pv[3]); w0.z = cvtpk(pv[4], pv[5]); w0.w = cvtpk(pv[6], pv[7]);
            w1.x = cvtpk(pv[8], pv[9]); w1.y = cvtpk(pv[10], pv[11]); w1.z = cvtpk(pv[12], pv[13]); w1.w = cvtpk(pv[14], pv[15]);
            pf[kt][0] = __builtin_bit_cast(bf16x8, w0); pf[kt][1] = __builtin_bit_cast(bf16x8, w1);
        }
        s16x4 vr[2][8];
#define AT_VLOAD(B, C) do { _Pragma("unroll") for (int ksx = 0; ksx < 4; ++ksx) { \
            vr[B][2 * ksx] = __builtin_bit_cast(s16x4, __builtin_amdgcn_ds_read_tr16_b64_v4i16((LAS v4i16_t*)(vb + vof0[C] + 4096u * ksx))); \
            vr[B][2 * ksx + 1] = __builtin_bit_cast(s16x4, __builtin_amdgcn_ds_read_tr16_b64_v4i16((LAS v4i16_t*)(vb + vof1[C] + 4096u * ksx))); } } while (0)
        AT_VLOAD(0, 0);
#pragma unroll
        for (int c = 0; c < 4; ++c) {
            if (c + 1 < 4) AT_VLOAD((c + 1) & 1, c + 1);
            __builtin_amdgcn_sched_barrier(0);
#pragma unroll
            for (int ksx = 0; ksx < 4; ++ksx) { const s16x4 v0 = vr[c & 1][2 * ksx], v1 = vr[c & 1][2 * ksx + 1];
                const bf16x8 vf = {v0[0], v0[1], v0[2], v0[3], v1[0], v1[1], v1[2], v1[3]};
                obr[c] = mfma32(vf, pf[ksx >> 1][ksx & 1], obr[c]); }
        }
#undef AT_VLOAD
    }
    float l = l2.x + l2.y; l += shx<32>(l, lane);
    const float inv_l = l > 0.f ? 1.0f / l : 0.f, coef = gate * inv_l;
    f32x4 ybv[4][4];
    if (MODE >= 1) {
#pragma unroll
        for (int c = 0; c < 4; ++c)
#pragma unroll
            for (int gi = 0; gi < 4; ++gi) ybv[c][gi] = *(const GAS f32x4*)(yb + 32 * c + 8 * gi + 4 * hh);
    }
    if (BR == BR_CMP) {
        float iv[32];
#pragma unroll
        for (int G = 0; G < 32; ++G) iv[G] = imp_row[2 * G + hh];
#pragma unroll
        for (int G = 0; G < 32; ++G) imp_row[2 * G + hh] = iv[G] * inv_l;
    }
    __builtin_amdgcn_sched_barrier(0);
#pragma unroll
    for (int c = 0; c < 4; ++c)
#pragma unroll
        for (int gi = 0; gi < 4; ++gi) { const int e = 32 * c + 8 * gi + 4 * hh;
            f32x4 v = (f32x4){obr[c][4 * gi], obr[c][4 * gi + 1], obr[c][4 * gi + 2], obr[c][4 * gi + 3]} * coef;
            if (MODE >= 1) v = v + ybv[c][gi];
            if (MODE <= 1) *(GAS f32x4*)(yb + e) = v;
            else { v2u o; o.x = pk2(v[0], v[1]); o.y = pk2(v[2], v[3]); *(GAS v2u*)(outp + e) = o; } }
}

__device__ __forceinline__ void attn_shifts(const float* qn, const float* kcn, const float* ksn, const float* kwn, float& shc, float& shs, float& shw) {
    const int lane = lane_now();
    float mq = fmaxf(fabsf(qn[lane]), fabsf(qn[lane + 64])), mc = fmaxf(fabsf(kcn[lane]), fabsf(kcn[lane + 64])), ms = fmaxf(fabsf(ksn[lane]), fabsf(ksn[lane + 64])), mw = fmaxf(fabsf(kwn[lane]), fabsf(kwn[lane + 64]));
#define AT_MX(O) do { mq = fmaxf(mq, shx<O>(mq, lane)); mc = fmaxf(mc, shx<O>(mc, lane)); ms = fmaxf(ms, shx<O>(ms, lane)); mw = fmaxf(mw, shx<O>(mw, lane)); } while (0)
    AT_MX(1); AT_MX(2); AT_MX(4); AT_MX(8); AT_MX(16); AT_MX(32);
#undef AT_MX
    const float k0 = 128.0f * AT_SC * 1.02f * mq;
    shc = __builtin_bit_cast(float, __builtin_amdgcn_readfirstlane(__builtin_bit_cast(int, k0 * mc))); shs = __builtin_bit_cast(float, __builtin_amdgcn_readfirstlane(__builtin_bit_cast(int, k0 * ms)));
    shw = __builtin_bit_cast(float, __builtin_amdgcn_readfirstlane(__builtin_bit_cast(int, k0 * mw)));
}

__device__ __forceinline__ void attn_unit(const Ctx& F0, int b, int kv, int qb, const bf16* p, bf16* mix, const bf16* kc, const bf16* vc, const float* gate_b, const float* ctab, const float* stab, float* ybuf, float shc, float shs, float shw) {
    Ctx F = F0; { int w_ = F0.wave; asm volatile("" : "+s"(w_)); F.wave = w_; F.lane = lane_now(); F.tid = 64 * w_ + F.lane; }
    const int tid = F.tid, lane = F.lane, w = F.wave, g = w >> 1, hh = lane >> 5, qq = 32 * (w & 1) + (lane & 31), t = 64 * qb + qq, head = kv * 4 + g;
    const size_t row = (size_t)b * T + t;
    LAS float* IMP = (LAS float*)(F.lds + AT_IMP); LAS unsigned long long* SELM = (LAS unsigned long long*)(F.lds + AT_SELM);
    bf16x8 qc[8];
    { const bf16* qp = p + row * LDP + C_NQ + head * 128 + 8 * hh;
#pragma unroll
        for (int s = 0; s < 8; ++s) qc[s] = __builtin_bit_cast(bf16x8, *(const GAS v4u*)(qp + 16 * s)); }
    float gt[3];
#pragma unroll
    for (int j = 0; j < 3; ++j) gt[j] = sigmoidf_(bf2f(p[row * LDP + C_NGATE + head * 3 + j]) + gate_b[head * 3 + j]);
    LAS float* imp_row = IMP + (g * 64 + qq) * 64;
    if (qb >= 16) {
#pragma unroll
        for (int i = 0; i < 32; ++i) imp_row[32 * hh + i] = 0.f; }
    float* yb = ybuf + row * 1024 + head * 128;
    bf16* outp = mix + row * D + MIX_B + head * 128;
    AT_LDS_BAR();
    { const TileSrc ks{kc + (size_t)(b * 2 + kv) * NCMP_PAD * 128, 128}, vs{vc + (size_t)(b * 2 + kv) * NCMP_PAD * 128, 128};
        const int ncmp = (4 * qb + 2) / 64 + 1;
        attn_branch<BR_CMP, 0, 2>(F, ks, vs, 0, ncmp, qc, t, gt[0], shc, 0ull, yb, outp, imp_row); }
    unsigned long long selmask = 0xFFFFull;
    if (qb >= 16) {
    AT_LDS_BAR();
    { LAS unsigned* KEYS = (LAS unsigned*)(F.lds) + w * 512;
        unsigned mykey[8];
#pragma unroll
        for (int qi = 0; qi < 8; ++qi) { const int q = 8 * w + qi;
            float v = ((IMP[(0 * 64 + q) * 64 + lane] + IMP[(1 * 64 + q) * 64 + lane]) + IMP[(2 * 64 + q) * 64 + lane]) + IMP[(3 * 64 + q) * 64 + lane];
            const bool forced = lane == 0 || lane == qb || lane == qb - 1, valid = lane <= qb;
            v = forced ? 1e30f : (valid ? v : -1e30f);
            const unsigned u = __builtin_bit_cast(unsigned, v), k = (u & 0x80000000u) ? ~u : (u | 0x80000000u);
            mykey[qi] = (k & ~63u) | (unsigned)(63 - lane);
            KEYS[qi * 64 + lane] = mykey[qi]; }
        asm volatile("s_waitcnt lgkmcnt(0)" ::: "memory");
#pragma unroll
        for (int qi = 0; qi < 8; ++qi) { int cnt = 0;
#pragma unroll
            for (int s4 = 0; s4 < 16; ++s4) { if (4 * s4 > qb) break;
                const v4u kk = *(const LAS v4u*)(KEYS + qi * 64 + 4 * s4);
                cnt += (kk.x > mykey[qi] ? 1 : 0) + (kk.y > mykey[qi] ? 1 : 0) + (kk.z > mykey[qi] ? 1 : 0) + (kk.w > mykey[qi] ? 1 : 0); }
            const unsigned long long msk = __ballot(cnt < 16);
            if (lane == 0) SELM[8 * w + qi] = msk; } }
    AT_LDS_BAR();
    selmask = SELM[qq]; }
    bf16x8 qr[8];
#pragma unroll
    for (int s = 2; s < 8; ++s) qr[s] = qc[s];
    { const GAS f32x4* cp = (const GAS f32x4*)(ctab + t * 16 + 8 * hh); const GAS f32x4* sp = (const GAS f32x4*)(stab + t * 16 + 8 * hh);
        const f32x4 c0 = cp[0], c1 = cp[1], s0 = sp[0], s1 = sp[1];
        const float cs[8] = {c0.x, c0.y, c0.z, c0.w, c1.x, c1.y, c1.z, c1.w}, sn[8] = {s0.x, s0.y, s0.z, s0.w, s1.x, s1.y, s1.z, s1.w};
        bf16x8 r0, r1;
#pragma unroll
        for (int j = 0; j < 8; ++j) { const float x1 = bf2f((bf16)qc[0][j]), x2 = bf2f((bf16)qc[1][j]);
            r0[j] = (short)f2bf(x1 * cs[j] - x2 * sn[j]); r1[j] = (short)f2bf(x2 * cs[j] + x1 * sn[j]); }
        qr[0] = r0; qr[1] = r1; }
    { const TileSrc ks{p + (size_t)b * T * LDP + C_NKS + kv * 128, LDP}, vs{p + (size_t)b * T * LDP + C_NVS + kv * 128, LDP};
        attn_branch<BR_SEL, 1, 4>(F, ks, vs, 0, qb + 1, qr, t, gt[1], shs, selmask, yb, outp, imp_row); }
    { const TileSrc ks{p + (size_t)b * T * LDP + C_NKW + kv * 128, LDP}, vs{p + (size_t)b * T * LDP + C_NVW + kv * 128, LDP};
        attn_branch<BR_WIN, 2, 4>(F, ks, vs, qb >= 8 ? qb - 8 : 0, qb + 1, qr, t, gt[2], shw, 0ull, yb, outp, imp_row); }
}
constexpr int PH_PER_LAYER = 12, N_PHASES = 1 + DEPTH * PH_PER_LAYER;
#ifndef MK_ONE_LAUNCH
#define MK_ONE_LAUNCH 1
#endif
struct Args { const float* in[N_IN]; float* out; unsigned char* ws; int ph_lo, ph_hi; };
static_assert(sizeof(Args) == N_IN * 8 + 8 + 8 + 8, "Args has no padding bytes");

__global__ void __launch_bounds__(NWAVES * 64, 2) nsa_fwd(Args args) {
    extern __shared__ __attribute__((aligned(16))) unsigned char lds_raw[];
    Ctx F;
    F.lds = (LAS unsigned char*)lds_raw;
    F.tid = threadIdx.x; F.lane = 0  ; F.wave = __builtin_amdgcn_readfirstlane(F.tid >> 6);
    F.G = gridDim.x; { const int bx = blockIdx.x; F.vcu = (F.G % 8 == 0) ? (bx % 8) * (F.G / 8) + bx / 8 : bx; }
    F.ws = args.ws; F.ctl = (gu32*)(args.ws + WS_CTL);
    volatile LAS unsigned* MISC = (volatile LAS unsigned*)(F.lds + MISC_OFF);
    for (int u = F.tid; u < (LDS_BYTES - LDSCTL_OFF) / 4; u += NWAVES * 64) ((LAS unsigned*)(F.lds + LDSCTL_OFF))[u] = 0u;
    __syncthreads();
    XcdBarrier bar; bar.bar = (unsigned*)(F.ctl + CW_BAR); bar.x = 0; bar.st = nullptr;
    if (MK_ONE_LAUNCH) bar = xcd_barrier_post((unsigned*)(F.ctl + CW_BAR), MISC + 8);
    bar.wave = F.wave;
    F.tid = -1;
    const int lo = args.ph_lo, hi = args.ph_hi;
#ifndef PH_MASK
#define PH_MASK 0xFFFF
#endif
#define EN(j) (((PH_MASK) >> (j)) & 1)
#ifndef PH_DOUBLE
#define PH_DOUBLE 0
#endif
#define NREP(j) ((((PH_DOUBLE) >> (j)) & 1) ? 2 : 1)
#define IN(k) (lo <= (k) && (k) < hi)
#define SEAM(k) do { if (IN(k) && IN((k) + 1)) xcd_barrier(bar); } while (0)

    bf16* const HN = (bf16*)(F.ws + WS_HN); bf16* const HP = (bf16*)(F.ws + WS_HP); bf16* const MIX = (bf16*)(F.ws + WS_MIX);
    bf16* const KC = (bf16*)(F.ws + WS_KC); bf16* const VC = (bf16*)(F.ws + WS_VC);
    const float* const ctab = (const float*)(F.ws + WS_ROPE); const float* const stab = ctab + T * 16;
    bf16* const XB = (bf16*)(F.ws + WS_XB);

    if (EN(0) && IN(0)) for (int rep = 0; rep < NREP(0); ++rep) { if (rep) xcd_barrier(bar); p0_ffn_strips(F, args.in); p0_prologue(F, args.in); }
    SEAM(0);

    for (int l = 0; l < DEPTH; ++l) {
        const int pb = 1 + l * PH_PER_LAYER;
        if (pb + PH_PER_LAYER <= lo || pb >= hi) continue;
        const void* xin = (l == 0) ? (const void*)args.in[I_X] : (const void*)XB; const bool xin_f32 = (l == 0);
        if (EN(1) && IN(pb + 0)) for (int rep = 0; rep < NREP(1); ++rep) { if (rep) xcd_barrier(bar); rmsnorm_q8_phase(F, xin, xin_f32, args.in[I_F1N] + (size_t)l * D, (unsigned char*)HN, (float*)(F.ws + WS_SA), xin_f32 ? XB : nullptr); }
        SEAM(pb + 0);
        if (EN(2) && IN(pb + 1)) for (int rep = 0; rep < NREP(2); ++rep) { if (rep) xcd_barrier(bar); pg8::Gemm g{HN, (const bf16*)(F.ws + WS_WGU + (size_t)(l * 2 + 0) * SZ_WGU8), M, 2 * DFF, D / 2}; pg8::StaticOrder S; S.init(M, 2 * DFF, F.G, (int)blockIdx.x);
            pg8::EpiSwiGLU8 E{HP, DFF, (const float*)(F.ws + WS_SA), (const float*)(F.ctl + CW_CMAX) + (size_t)(l * 2 + 0) * 2 * DFF};
            pg8::gemm_phase<pg8::EpiSwiGLU8, pg8::StaticOrder, true, true>(F.lds, g, S, E, F.wave * 64 + lane_now()); }
        SEAM(pb + 1);
        if (EN(3) && IN(pb + 2)) {
            hidden_q8_phase(F, HP, F.ws + WS_HQ2, (float*)(F.ws + WS_SA2));
            xcd_barrier(bar);
            pg8::Gemm g{(const bf16*)(F.ws + WS_HQ2), (const bf16*)(F.ws + WS_WD + (size_t)(l * 2 + 0) * SZ_WD8), M, D, DFF / 2}; pg8::StaticOrder S; S.init(M, D, F.G, (int)blockIdx.x);
            pg8::EpiResid8 E{XB, XB, D, 0.5f, (const float*)(F.ws + WS_SA2), (const float*)(F.ctl + CW_CMAX2) + (size_t)(l * 2 + 0) * D, false, false};
            pg8::gemm_phase<pg8::EpiResid8, pg8::StaticOrder, true, true>(F.lds, g, S, E, F.wave * 64 + lane_now()); }
        SEAM(pb + 2);
        if (EN(4) && IN(pb + 3)) for (int rep = 0; rep < NREP(4); ++rep) { if (rep) xcd_barrier(bar); rmsnorm_q8_phase(F, XB, false, args.in[I_MIXN] + (size_t)l * D, (unsigned char*)HN, (float*)(F.ws + WS_SA)); }
        SEAM(pb + 3);
        if (EN(5) && IN(pb + 4)) for (int rep = 0; rep < NREP(5); ++rep) { if (rep) xcd_barrier(bar); pg8::Gemm g{HN, (const bf16*)(F.ws + WS_WIN + (size_t)l * SZ_WIN8), M, LDP, D / 2}; pg8::StaticOrder S; S.init(M, LDP, F.G, (int)blockIdx.x);
            pg8::EpiBf16Plain8 E{HP, LDP, (const float*)(F.ws + WS_SA), (const float*)(F.ctl + CW_CMAX3) + (size_t)l * LDP};
            pg8::gemm_phase<pg8::EpiBf16Plain8, pg8::StaticOrder, true, true>(F.lds, g, S, E, F.wave * 64 + lane_now()); }
        SEAM(pb + 4);
        if (EN(6) && IN(pb + 5)) {
            qknorm_rows(F, HP, args.in[I_QN] + l * 128, args.in[I_KSN] + l * 128, args.in[I_KWN] + l * 128, ctab, stab);
            compress_items(F, HP, args.in[I_PEK] + (size_t)l * 4096, args.in[I_PEV] + (size_t)l * 4096, (const bf16*)(F.ws + WS_W1 + (size_t)l * 2 * SZ_W1), (const bf16*)(F.ws + WS_W2 + (size_t)l * 2 * SZ_W2),
                           args.in[I_KCN] + l * 128, KC, VC);
        }
        SEAM(pb + 5);
        if (EN(7) && IN(pb + 6)) for (int rep = 0; rep < NREP(7); ++rep) { if (rep) xcd_barrier(bar);
            const int bid = blockIdx.x;
#ifndef MIX_PARTS
#define MIX_PARTS 7
#endif
#ifndef MIX_REP2
#define MIX_REP2 7
#endif
#define MIXP (rep ? (MIX_REP2) : (MIX_PARTS))
            if ((MIXP & 1) && bid < 64) lru_unit(F, bid >> 3, bid & 7, HP, MIX, args.in[I_CONVW] + (size_t)l * 4 * 512, args.in[I_CONVB] + l * 512, args.in[I_GAW] + (size_t)l * 8 * 4096, args.in[I_GAB] + l * 512,
                                   args.in[I_GXW] + (size_t)l * 8 * 4096, args.in[I_GXB] + l * 512, args.in[I_LAM] + l * 512);
            else if ((MIXP & 2) && bid < 96) gla_unit(F, (bid - 64) >> 2, (bid - 64) & 3, HP, MIX, args.in[I_AW2] + (size_t)l * 16 * 256, args.in[I_AB] + l * 256, args.in[I_GLAN] + l * 128);
            AT_LDS_BAR();
            const unsigned myq = xb_xcc_id() & 7u;
            float shc, shs, shw; attn_shifts(args.in[I_QN] + l * 128, args.in[I_KCN] + l * 128, args.in[I_KSN] + l * 128, args.in[I_KWN] + l * 128, shc, shs, shw);
            for (;;) {
                if (F.wave == 0 && lane_now() == 0) { int got = -1;
                    for (unsigned a = 0; a < 8u && got < 0; ++a) { const unsigned qx = (myq + a) & 7u;
                        const unsigned j = __hip_atomic_fetch_add(F.ctl + CW_QUEUE + 32 * ((l + DEPTH * rep) * 8 + qx), 1u, RLX_AGENT);
                        if (j < 128u) got = (int)(((2u * qx + (j & 1u)) << 8) | (63u - (j >> 1))); }
                    MISC[0] = (unsigned)got; }
                AT_LDS_BAR();
                const int it = (int)MISC[0];
                AT_LDS_BAR();
                if (it < 0) break;
                if (MIXP & 4) attn_unit(F, (it >> 8) >> 1, (it >> 8) & 1, it & 255, HP, MIX, KC, VC, args.in[I_GATEB] + l * 24, ctab, stab, (float*)HN, shc, shs, shw);
            }
        }
        SEAM(pb + 6);
        if (EN(8) && IN(pb + 7)) outnorm_phase(F, MIX, args.in[I_LRUN] + l * 512, args.in[I_NSAN] + l * 1024);
        SEAM(pb + 7);
        if (EN(9) && IN(pb + 8)) for (int rep = 0; rep < NREP(9); ++rep) { if (rep) xcd_barrier(bar); pg8::Gemm g{MIX, (const bf16*)(F.ws + WS_WOUT + (size_t)l * SZ_WOUT), M, D, D}; pg8::StaticOrder S; S.init(M, D, F.G, (int)blockIdx.x);
            pg8::EpiResid E{XB, XB, D, rep ? 0.f : 1.0f};
            pg8::gemm_phase<pg8::EpiResid, pg8::StaticOrder, true, true>(F.lds, g, S, E, F.wave * 64 + lane_now()); }
        SEAM(pb + 8);
        if (EN(10) && IN(pb + 9)) for (int rep = 0; rep < NREP(10); ++rep) { if (rep) xcd_barrier(bar); rmsnorm_q8_phase(F, XB, false, args.in[I_F2N] + (size_t)l * D, (unsigned char*)HN, (float*)(F.ws + WS_SA)); }
        SEAM(pb + 9);
        if (EN(11) && IN(pb + 10)) for (int rep = 0; rep < NREP(11); ++rep) { if (rep) xcd_barrier(bar); pg8::Gemm g{HN, (const bf16*)(F.ws + WS_WGU + (size_t)(l * 2 + 1) * SZ_WGU8), M, 2 * DFF, D / 2}; pg8::StaticOrder S; S.init(M, 2 * DFF, F.G, (int)blockIdx.x);
            pg8::EpiSwiGLU8 E{HP, DFF, (const float*)(F.ws + WS_SA), (const float*)(F.ctl + CW_CMAX) + (size_t)(l * 2 + 1) * 2 * DFF};
            pg8::gemm_phase<pg8::EpiSwiGLU8, pg8::StaticOrder, true, true>(F.lds, g, S, E, F.wave * 64 + lane_now()); }
        SEAM(pb + 10);
        if (EN(12) && IN(pb + 11)) {
            hidden_q8_phase(F, HP, F.ws + WS_HQ2, (float*)(F.ws + WS_SA2));
            xcd_barrier(bar);
            pg8::Gemm g{(const bf16*)(F.ws + WS_HQ2), (const bf16*)(F.ws + WS_WD + (size_t)(l * 2 + 1) * SZ_WD8), M, D, DFF / 2}; pg8::StaticOrder S; S.init(M, D, F.G, (int)blockIdx.x);
            const bool last = (l + 1 == DEPTH);
            pg8::EpiResid8 E{XB, last ? (void*)args.out : (void*)XB, D, 0.5f, (const float*)(F.ws + WS_SA2), (const float*)(F.ctl + CW_CMAX2) + (size_t)(l * 2 + 1) * D, false, last};
            pg8::gemm_phase<pg8::EpiResid8, pg8::StaticOrder, true, true>(F.lds, g, S, E, F.wave * 64 + lane_now()); }
        SEAM(pb + 11);
    }
#undef IN
#undef SEAM
}

extern "C" void kernel_launch(void* const* d_in, const int* in_sizes, int n_in, void* d_out, int out_size, void* d_ws, size_t ws_size, hipStream_t stream) {
    static int grid = 0;
    if (grid == 0) {
        if (n_in != N_IN || in_sizes[0] != M * D || out_size != M * D || ws_size < WS_END) {
            fprintf(stderr, "kernel_launch: built for %d inputs, x/out of %d floats, >= %zu bytes of workspace; got n_in %d, in0 %d, out %d, ws %zu; nothing launched\n", N_IN, M * D, (size_t)WS_END, n_in, n_in > 0 ? in_sizes[0] : -1, out_size, ws_size);
            grid = -1; return; }
        int dev = 0, cus = 0, per_cu = 0;
        if (hipGetDevice(&dev) != hipSuccess || hipDeviceGetAttribute(&cus, hipDeviceAttributeMultiprocessorCount, dev) != hipSuccess) { fprintf(stderr, "kernel_launch: device query failed\n"); grid = -1; return; }
        if (hipFuncSetAttribute((const void*)nsa_fwd, hipFuncAttributeMaxDynamicSharedMemorySize, LDS_BYTES) != hipSuccess) { fprintf(stderr, "kernel_launch: hipFuncSetAttribute failed\n"); grid = -1; return; }
        if (hipOccupancyMaxActiveBlocksPerMultiprocessor(&per_cu, (const void*)nsa_fwd, NWAVES * 64, LDS_BYTES) != hipSuccess || per_cu < 1)
            fprintf(stderr, "kernel_launch: note: occupancy query reports %d workgroups per CU\n", per_cu);
        (void)hipGetLastError();
        grid = cus;
    }
    if (grid < 0) return;
    if (hipMemsetAsync((char*)d_ws + WS_CTL, 0, CTL_ZERO_BYTES, stream) != hipSuccess) { fprintf(stderr, "kernel_launch: memset failed\n"); return; }
    Args a{};
    for (int i = 0; i < N_IN; ++i) a.in[i] = (const float*)d_in[i];
    a.out = (float*)d_out; a.ws = (unsigned char*)d_ws;
#if MK_ONE_LAUNCH
    a.ph_lo = 0; a.ph_hi = N_PHASES;
    hipLaunchKernelGGL(nsa_fwd, dim3(grid), dim3(NWAVES * 64), LDS_BYTES, stream, a);
#else
    for (int ph = 0; ph < N_PHASES; ++ph) { a.ph_lo = ph; a.ph_hi = ph + 1; hipLaunchKernelGGL(nsa_fwd, dim3(grid), dim3(NWAVES * 64), LDS_BYTES, stream, a); }
#endif
    const hipError_t le = hipPeekAtLastError();
    if (le != hipSuccess) fprintf(stderr, "kernel_launch: launch failed: %s\n", hipGetErrorName(le));
}
```

```cpp
#include <hip/hip_runtime.h>
#include <cstdio>
#include <cstdint>
namespace pg8 {
#define PG8_LAS __attribute__((address_space(3)))
typedef unsigned short bf16_t;
typedef short bf16x8 __attribute__((ext_vector_type(8)));
typedef float f32x4 __attribute__((ext_vector_type(4)));
typedef unsigned u32x4 __attribute__((ext_vector_type(4)));
constexpr int BM = 256, BK = 64, HALF = 128, HTB = HALF * BK * 2  , STAGE_BYTES = 8 * HTB, NXCD = 8, WGM = 8;

__host__ __device__ __forceinline__ int lds_byte(int r, int c) { const int st = (r >> 4) * 2 + (c >> 5), rr = r & 15, cc = c & 31, ob = rr * 64 + cc * 2; return st * 1024 + (ob ^ (((ob >> 9) & 1) << 5)); }
__host__ __device__ __forceinline__ void stage_rc(int b, int& R, int& C) { const int st = b / 1024, sb = b % 1024, swz = sb ^ (((sb >> 9) & 1) << 5); R = (st >> 1) * 16 + swz / 64; C = (st & 1) * 32 + (swz % 64) / 2; }
__host__ __device__ __forceinline__ int perm32(int rho) { const int n = rho >> 4, i = rho & 15; return 8 * (i >> 2) + 4 * n + (i & 3); }

struct Unit { int pm, pn; };
struct Gemm { const bf16_t* A; const bf16_t* Bt; int M, N, K; };

struct StaticOrder {
    int nM, nN, nwg, G, c;
    __host__ __device__ void init(int M, int N, int G_, int c_) { nM = M / BM; nN = N / BM; nwg = nM * nN; G = G_; c = c_; }
    __host__ __device__ bool next(int i, Unit& u) const {
        const long L = (long)i * G + c; if (L >= nwg) return false;
        int wgid = (int)L; { const int q = nwg / NXCD, r = nwg % NXCD, xcd = wgid % NXCD, off = wgid / NXCD; wgid = (xcd < r ? xcd * (q + 1) : r * (q + 1) + (xcd - r) * q) + off; }
        const int nig = WGM * nN, gid = wgid / nig, fm = gid * WGM, gsz = (nM - fm) < WGM ? (nM - fm) : WGM;
        u.pm = fm + ((wgid % nig) % gsz); u.pn = (wgid % nig) / gsz; return true;
    }
    __device__ __forceinline__ void a_ready(const Unit&) const {}
    __device__ __forceinline__ void done(const Unit&) const {}
};

typedef float f32x2n __attribute__((ext_vector_type(2))); typedef __bf16 bf16x2n __attribute__((ext_vector_type(2)));
__device__ __forceinline__ unsigned cvt_pk_bf16(float lo, float hi) { const f32x2n v = {lo, hi}; return __builtin_bit_cast(unsigned, __builtin_convertvector(v, bf16x2n)); }
typedef float f32x2 __attribute__((ext_vector_type(2)));
typedef int i32x4 __attribute__((ext_vector_type(4)));
__device__ __forceinline__ f32x4 mma_frag(bf16x8 b, bf16x8 a, f32x4 c) { return __builtin_amdgcn_mfma_f32_16x16x32_bf16(b, a, c, 0, 0, 0); }
__device__ __forceinline__ i32x4 mma_frag(bf16x8 b, bf16x8 a, i32x4 c) { return __builtin_amdgcn_mfma_i32_16x16x64_i8(__builtin_bit_cast(i32x4, b), __builtin_bit_cast(i32x4, a), c, 0, 0, 0); }
#ifdef NOISE_P
#ifndef NOISE_P_COLS
#define NOISE_P_COLS(c) true
#endif
__device__ __forceinline__ float nzp(float v, unsigned row, unsigned col) { unsigned x = row * 5376u + col; x ^= x >> 16; x *= 0x7feb352du; x ^= x >> 15; x *= 0x846ca68bu; x ^= x >> 16;
        return v + ((float)x * 2.3283064e-10f * 2.0f - 1.0f) * (1.7320508f * NOISE_P); }
#endif
struct EpiBf16Plain {
    static constexpr bool PERM = true, AFTER_DRAIN = false; typedef f32x4 acc_t;
    bf16_t* O; int ldc;
    __device__ __forceinline__ void operator()(const f32x4 (&acc)[2][2][4][2], const Unit& u, int wr, int wc, int fr, int fq) const {
        const int row0 = u.pm * BM + wr * 64 + fr, col0 = u.pn * BM + wc * 32 + 8 * fq;
#pragma unroll
        for (int ai = 0; ai < 2; ++ai)
#pragma unroll
            for (int m = 0; m < 4; ++m) { bf16_t* rowp = O + (size_t)(row0 + ai * HALF + m * 16) * ldc + col0;
#pragma unroll
                for (int bj = 0; bj < 2; ++bj) { f32x4 v0 = acc[ai][bj][m][0], v1 = acc[ai][bj][m][1];
#ifdef NOISE_P
                    { const unsigned rr = row0 + ai * HALF + m * 16, cc = col0 + bj * HALF;
                      if (NOISE_P_COLS(cc))
#pragma unroll
                      for (int j = 0; j < 4; ++j) { v0[j] = nzp(v0[j], rr, cc + j); v1[j] = nzp(v1[j], rr, cc + 4 + j); } }
#endif
                    u32x4 w; w.x = cvt_pk_bf16(v0[0], v0[1]); w.y = cvt_pk_bf16(v0[2], v0[3]); w.z = cvt_pk_bf16(v1[0], v1[1]); w.w = cvt_pk_bf16(v1[2], v1[3]);
                    *(u32x4*)(rowp + bj * HALF) = w; } }
    }
};
struct EpiBf16Plain8 {
    static constexpr bool PERM = true, AFTER_DRAIN = false; typedef i32x4 acc_t;
    bf16_t* O; int ldc; const float* sa; const float* sw;
    __device__ __forceinline__ void operator()(const i32x4 (&acc)[2][2][4][2], const Unit& u, int wr, int wc, int fr, int fq) const {
        const int row0 = u.pm * BM + wr * 64 + fr, col0 = u.pn * BM + wc * 32 + 8 * fq;
        f32x4 cw[2][2];
#pragma unroll
        for (int bj = 0; bj < 2; ++bj) { cw[bj][0] = *(const f32x4*)(sw + col0 + bj * HALF); cw[bj][1] = *(const f32x4*)(sw + col0 + bj * HALF + 4); }
        float rav[2][4];
#pragma unroll
        for (int ai = 0; ai < 2; ++ai)
#pragma unroll
            for (int m = 0; m < 4; ++m) rav[ai][m] = sa[row0 + ai * HALF + m * 16];
        __builtin_amdgcn_sched_barrier(0);
#pragma unroll
        for (int ai = 0; ai < 2; ++ai)
#pragma unroll
            for (int m = 0; m < 4; ++m) rav[ai][m] *= (1.0f / 127.0f);
#pragma unroll
        for (int ai = 0; ai < 2; ++ai)
#pragma unroll
            for (int m = 0; m < 4; ++m) { const int row = row0 + ai * HALF + m * 16; bf16_t* rowp = O + (size_t)row * ldc + col0; const float ra = rav[ai][m];
#pragma unroll
                for (int bj = 0; bj < 2; ++bj) { const f32x4 v0 = __builtin_convertvector(acc[ai][bj][m][0], f32x4) * (cw[bj][0] * ra), v1 = __builtin_convertvector(acc[ai][bj][m][1], f32x4) * (cw[bj][1] * ra);
                    u32x4 w; w.x = cvt_pk_bf16(v0[0], v0[1]); w.y = cvt_pk_bf16(v0[2], v0[3]); w.z = cvt_pk_bf16(v1[0], v1[1]); w.w = cvt_pk_bf16(v1[2], v1[3]);
                    *(u32x4*)(rowp + bj * HALF) = w; } }
    }
};
struct EpiSwiGLU {
    static constexpr bool PERM = true, AFTER_DRAIN = false; typedef f32x4 acc_t;
    bf16_t* O; int ldc;
    static __device__ __forceinline__ float sg(float g, float up) { const float e = __builtin_amdgcn_exp2f(g * -1.44269504089f); return g * __builtin_amdgcn_rcpf(1.0f + e) * up; }
#ifdef NOISE_PROBE
    static __device__ __forceinline__ float nz(float v, unsigned row, unsigned col) { unsigned x = row * 5632u + col; x ^= x >> 16; x *= 0x7feb352du; x ^= x >> 15; x *= 0x846ca68bu; x ^= x >> 16;
        return v * (1.0f + ((float)x * 2.3283064e-10f * 2.0f - 1.0f) * (1.7320508f * NOISE_PROBE)); }
#endif
    __device__ __forceinline__ void operator()(const f32x4 (&acc)[2][2][4][2], const Unit& u, int wr, int wc, int fr, int fq) const {
        const int row0 = u.pm * BM + wr * 64 + fr, col0 = u.pn * HALF + wc * 32 + 8 * fq;
#pragma unroll
        for (int ai = 0; ai < 2; ++ai)
#pragma unroll
            for (int m = 0; m < 4; ++m) { bf16_t* rowp = O + (size_t)(row0 + ai * HALF + m * 16) * ldc + col0;
                const f32x4 g0 = acc[ai][0][m][0], g1 = acc[ai][0][m][1], u0 = acc[ai][1][m][0], u1 = acc[ai][1][m][1];
#ifdef NOISE_PROBE
                const unsigned rr = row0 + ai * HALF + m * 16; float hv[8];
#pragma unroll
                for (int j = 0; j < 4; ++j) { hv[j] = nz(sg(g0[j], u0[j]), rr, col0 + j); hv[4 + j] = nz(sg(g1[j], u1[j]), rr, col0 + 4 + j); }
                u32x4 w; w.x = cvt_pk_bf16(hv[0], hv[1]); w.y = cvt_pk_bf16(hv[2], hv[3]); w.z = cvt_pk_bf16(hv[4], hv[5]); w.w = cvt_pk_bf16(hv[6], hv[7]);
#else
                u32x4 w; w.x = cvt_pk_bf16(sg(g0[0], u0[0]), sg(g0[1], u0[1])); w.y = cvt_pk_bf16(sg(g0[2], u0[2]), sg(g0[3], u0[3]));
                w.z = cvt_pk_bf16(sg(g1[0], u1[0]), sg(g1[1], u1[1])); w.w = cvt_pk_bf16(sg(g1[2], u1[2]), sg(g1[3], u1[3]));
#endif
                *(u32x4*)rowp = w; }
    }
};
typedef unsigned u32x2_t __attribute__((ext_vector_type(2)));
__device__ __forceinline__ f32x4 res_load(const void* base, bool f32, size_t idx) {
    if (f32) return *(const f32x4*)((const float*)base + idx);
    const u32x2_t w = *(const u32x2_t*)((const bf16_t*)base + idx);
    return (f32x4){__builtin_bit_cast(float, w.x << 16), __builtin_bit_cast(float, w.x & 0xffff0000u), __builtin_bit_cast(float, w.y << 16), __builtin_bit_cast(float, w.y & 0xffff0000u)}; }
__device__ __forceinline__ void res_store(void* out, bool f32, size_t idx, f32x4 v) {
    if (f32) { *(f32x4*)((float*)out + idx) = v; return; }
    u32x2_t w; w.x = cvt_pk_bf16(v[0], v[1]); w.y = cvt_pk_bf16(v[2], v[3]); *(u32x2_t*)((bf16_t*)out + idx) = w; }
struct EpiSwiGLU8 {
    static constexpr bool PERM = true, AFTER_DRAIN = false; typedef i32x4 acc_t;
    bf16_t* O; int ldc; const float* sa; const float* sw;
    __device__ __forceinline__ void operator()(const i32x4 (&acc)[2][2][4][2], const Unit& u, int wr, int wc, int fr, int fq) const {
        const int row0 = u.pm * BM + wr * 64 + fr, col0 = u.pn * HALF + wc * 32 + 8 * fq, wrow0 = u.pn * BM + wc * 32 + 8 * fq;
        const f32x4 sg0 = *(const f32x4*)(sw + wrow0) * 1.44269504089f, sg1 = *(const f32x4*)(sw + wrow0 + 4) * 1.44269504089f, su0 = *(const f32x4*)(sw + wrow0 + HALF) * 0.69314718056f, su1 = *(const f32x4*)(sw + wrow0 + HALF + 4) * 0.69314718056f;
        float rav[2][4];
#pragma unroll
        for (int ai = 0; ai < 2; ++ai)
#pragma unroll
            for (int m = 0; m < 4; ++m) rav[ai][m] = sa[row0 + ai * HALF + m * 16];
        __builtin_amdgcn_sched_barrier(0);
#pragma unroll
        for (int ai = 0; ai < 2; ++ai)
#pragma unroll
            for (int m = 0; m < 4; ++m) rav[ai][m] *= (1.0f / 127.0f);
#pragma unroll
        for (int ai = 0; ai < 2; ++ai)
#pragma unroll
            for (int m = 0; m < 4; ++m) { const int row = row0 + ai * HALF + m * 16; bf16_t* rowp = O + (size_t)row * ldc + col0; const float ra = rav[ai][m];
                const f32x4 g0 = __builtin_convertvector(acc[ai][0][m][0], f32x4) * (sg0 * ra), g1 = __builtin_convertvector(acc[ai][0][m][1], f32x4) * (sg1 * ra),
                            u0 = __builtin_convertvector(acc[ai][1][m][0], f32x4) * (su0 * ra), u1 = __builtin_convertvector(acc[ai][1][m][1], f32x4) * (su1 * ra);
                u32x4 w; w.x = cvt_pk_bf16(sg2(g0[0], u0[0]), sg2(g0[1], u0[1])); w.y = cvt_pk_bf16(sg2(g0[2], u0[2]), sg2(g0[3], u0[3]));
                w.z = cvt_pk_bf16(sg2(g1[0], u1[0]), sg2(g1[1], u1[1])); w.w = cvt_pk_bf16(sg2(g1[2], u1[2]), sg2(g1[3], u1[3]));
                *(u32x4*)rowp = w; }
    }
    static __device__ __forceinline__ float sg2(float gl, float ul) { return gl * __builtin_amdgcn_rcpf(1.0f + __builtin_amdgcn_exp2f(-gl)) * ul; }
};
struct EpiResid8 {
    static constexpr bool PERM = false, AFTER_DRAIN = false; typedef i32x4 acc_t;
    const void* base; void* out; int ldc; float scale; const float* sa; const float* sw; bool base_f32, out_f32;
    __device__ __forceinline__ void operator()(const i32x4 (&acc)[2][2][4][2], const Unit& u, int wr, int wc, int fr, int fq) const {
        const int row0 = u.pm * BM + wr * 64 + fr, col0 = u.pn * BM + wc * 32 + 4 * fq;
        float sc = scale * (1.0f / 127.0f); asm volatile("" : "+s"(sc));
        f32x4 cw[2][2];
#pragma unroll
        for (int bj = 0; bj < 2; ++bj)
#pragma unroll
            for (int n = 0; n < 2; ++n) cw[bj][n] = *(const f32x4*)(sw + col0 + bj * HALF + n * 16) * sc;
        float rav[2][4];
#pragma unroll
        for (int ai = 0; ai < 2; ++ai)
#pragma unroll
            for (int m = 0; m < 4; ++m) rav[ai][m] = sa[row0 + ai * HALF + m * 16];
        __builtin_amdgcn_sched_barrier(0);
#pragma unroll
        for (int ai = 0; ai < 2; ++ai)
#pragma unroll
            for (int mp = 0; mp < 2; ++mp) {
                f32x4 bs[2][2][2]; float ra[2]; u32x2_t rw[2][2][2];
#pragma unroll
                for (int mm = 0; mm < 2; ++mm) { const int row = row0 + ai * HALF + (2 * mp + mm) * 16; const size_t off = (size_t)row * ldc + col0; ra[mm] = rav[ai][2 * mp + mm];
#pragma unroll
                    for (int bj = 0; bj < 2; ++bj)
#pragma unroll
                        for (int n = 0; n < 2; ++n) rw[mm][bj][n] = *(const u32x2_t*)((const bf16_t*)base + off + bj * HALF + n * 16); }
                __builtin_amdgcn_sched_barrier(0);
#pragma unroll
                for (int mm = 0; mm < 2; ++mm)
#pragma unroll
                    for (int bj = 0; bj < 2; ++bj)
#pragma unroll
                        for (int n = 0; n < 2; ++n) { const u32x2_t w = rw[mm][bj][n];
                            bs[mm][bj][n] = (f32x4){__builtin_bit_cast(float, w.x << 16), __builtin_bit_cast(float, w.x & 0xffff0000u), __builtin_bit_cast(float, w.y << 16), __builtin_bit_cast(float, w.y & 0xffff0000u)}; }
#pragma unroll
                for (int mm = 0; mm < 2; ++mm) { const int m = 2 * mp + mm; const size_t off = (size_t)(row0 + ai * HALF + m * 16) * ldc + col0;
#pragma unroll
                    for (int bj = 0; bj < 2; ++bj)
#pragma unroll
                        for (int n = 0; n < 2; ++n) res_store(out, out_f32, off + bj * HALF + n * 16, bs[mm][bj][n] + __builtin_convertvector(acc[ai][bj][m][n], f32x4) * (cw[bj][n] * ra[mm])); }
                asm volatile("" ::: "memory"); }
    }
};
struct EpiResid {
    static constexpr bool PERM = false, AFTER_DRAIN = false; typedef f32x4 acc_t;
    const void* base; void* out; int ldc; float scale;
    __device__ __forceinline__ void operator()(const f32x4 (&acc)[2][2][4][2], const Unit& u, int wr, int wc, int fr, int fq) const {
        const int row0 = u.pm * BM + wr * 64 + fr, col0 = u.pn * BM + wc * 32 + 4 * fq;
#pragma unroll
        for (int ai = 0; ai < 2; ++ai) {
            f32x4 bs[4][2][2];
#pragma unroll
            for (int m = 0; m < 4; ++m) { const size_t off = (size_t)(row0 + ai * HALF + m * 16) * ldc + col0;
#pragma unroll
                for (int bj = 0; bj < 2; ++bj)
#pragma unroll
                    for (int n = 0; n < 2; ++n) bs[m][bj][n] = res_load(base, false, off + bj * HALF + n * 16); }
#pragma unroll
            for (int m = 0; m < 4; ++m) { const size_t off = (size_t)(row0 + ai * HALF + m * 16) * ldc + col0;
#pragma unroll
                for (int bj = 0; bj < 2; ++bj)
#pragma unroll
                    for (int n = 0; n < 2; ++n) { f32x4 a = acc[ai][bj][m][n];
#ifdef NOISE_WOUT
                        { const unsigned rr = row0 + ai * HALF + m * 16, cc = col0 + bj * HALF + n * 16;
#pragma unroll
                          for (int j = 0; j < 4; ++j) { unsigned x = rr * 2048u + cc + j; x ^= x >> 16; x *= 0x7feb352du; x ^= x >> 15; x *= 0x846ca68bu; x ^= x >> 16; a[j] += ((float)x * 2.3283064e-10f * 2.0f - 1.0f) * (1.7320508f * NOISE_WOUT); } }
#endif
                        res_store(out, false, off + bj * HALF + n * 16, bs[m][bj][n] + a * scale); } }
            asm volatile("" ::: "memory"); }
    }
};
template <class Epi, class Sched, bool ALIGN_EPI = false, bool SP2 = false>
__device__ __forceinline__ void gemm_phase(PG8_LAS unsigned char* lds, const Gemm g, const Sched& S, const Epi& E, int tid_in) {
    int tid_ = tid_in; asm volatile("" : "+v"(tid_));
    const int tid = tid_, wid = __builtin_amdgcn_readfirstlane(tid >> 6), lane = tid & 63, wr = wid >> 2, wc = wid & 3, fr = lane & 15, fq = lane >> 4;
    const int K = g.K, nt = K / BK;
    unsigned voffA[2], voffB[2];
#pragma unroll
    for (int i = 0; i < 2; ++i) { int R, C; stage_rc(tid * 16 + i * 8192, R, C); const int Rb = Epi::PERM ? ((R & ~31) + perm32(R & 31)) : R;
        voffA[i] = (unsigned)(R * K + C) * 2u; voffB[i] = (unsigned)(Rb * K + C) * 2u; }
    const size_t kstep = (size_t)(BK * 2);
    const size_t hstep = (size_t)HALF * K * 2;
    const size_t tstep = 2 * hstep;
    const unsigned ldsw = (unsigned)wid * 1024u;
    const int aoff = lds_byte(wr * 64 + fr, fq * 8), boff = lds_byte(wc * 32 + fr, fq * 8);
#define PG8_SA(b, h) (((b) * 2 + (h)) * HTB)
#define PG8_SB(b, h) ((4 + (b) * 2 + (h)) * HTB)
#define PG8_STAGE(bufoff, gbase, voff) do { _Pragma("unroll") for (int _i = 0; _i < 2; ++_i) \
        __builtin_amdgcn_global_load_lds((const unsigned*)((const char*)(gbase) + (voff)[_i]), (PG8_LAS unsigned*)(lds + (bufoff) + ldsw + _i * 8192), 16, 0, 0); } while (0)
#define PG8_LDA(dst, b, h) do { _Pragma("unroll") for (int m = 0; m < 4; ++m) _Pragma("unroll") for (int k = 0; k < 2; ++k) dst[m][k] = *(const PG8_LAS bf16x8*)(lds + PG8_SA(b, h) + aoff + m * 2048 + k * 1024); } while (0)
#define PG8_LDB(dst, b, h) do { _Pragma("unroll") for (int n = 0; n < 2; ++n) _Pragma("unroll") for (int k = 0; k < 2; ++k) dst[n][k] = *(const PG8_LAS bf16x8*)(lds + PG8_SB(b, h) + boff + n * 2048 + k * 1024); } while (0)
#define PG8_MMA(ai, bj, At, Bt) do { __builtin_amdgcn_s_setprio(1); _Pragma("unroll") for (int m = 0; m < 4; ++m) _Pragma("unroll") for (int n = 0; n < 2; ++n) _Pragma("unroll") for (int k = 0; k < 2; ++k) \
        acc[ai][bj][m][n] = mma_frag(Bt[n][k], At[m][k], acc[ai][bj][m][n]); __builtin_amdgcn_s_setprio(0); } while (0)
#define PG8_WAIT_V(n) asm volatile("s_waitcnt vmcnt(" #n ")" ::: "memory")
#define PG8_WAIT_L(n) asm volatile("s_waitcnt lgkmcnt(" #n ")" ::: "memory")
#define PG8_BAR __builtin_amdgcn_s_barrier()
#define PG8_SCHED __builtin_amdgcn_sched_barrier(0)
    Unit cur, nxt; int ui = 0;
    if (!S.next(0, cur)) return;
    typedef typename Epi::acc_t acc_t;
    acc_t acc[2][2][4][2];
#pragma unroll
    for (int a = 0; a < 2; ++a)
#pragma unroll
        for (int b = 0; b < 2; ++b)
#pragma unroll
            for (int m = 0; m < 4; ++m)
#pragma unroll
                for (int n = 0; n < 2; ++n) acc[a][b][m][n] = acc_t{};
    bf16x8 At[4][2], B0[2][2], B1[2][2];
    const char* cA = (const char*)g.A + (size_t)cur.pm * tstep; const char* cB = (const char*)g.Bt + (size_t)cur.pn * tstep;
    S.a_ready(cur);
    if constexpr (SP2) {
        PG8_STAGE(PG8_SB(0, 0), cB, voffB); PG8_STAGE(PG8_SB(0, 1), cB + hstep, voffB); PG8_STAGE(PG8_SA(0, 0), cA, voffA); PG8_STAGE(PG8_SA(0, 1), cA + hstep, voffA);
        if (wr == 1) PG8_BAR;
        PG8_WAIT_V(2); PG8_BAR;
        PG8_STAGE(PG8_SB(1, 0), cB + kstep, voffB); PG8_STAGE(PG8_SA(1, 0), cA + kstep, voffA); PG8_STAGE(PG8_SB(1, 1), cB + hstep + kstep, voffB);
        PG8_WAIT_V(6); PG8_BAR;
    } else {
        PG8_STAGE(PG8_SB(0, 0), cB, voffB); PG8_STAGE(PG8_SA(0, 0), cA, voffA); PG8_STAGE(PG8_SB(0, 1), cB + hstep, voffB); PG8_STAGE(PG8_SA(0, 1), cA + hstep, voffA);
        if (wr == 1) PG8_BAR;
        PG8_WAIT_V(4); PG8_BAR;
        PG8_STAGE(PG8_SB(1, 0), cB + kstep, voffB); PG8_STAGE(PG8_SA(1, 0), cA + kstep, voffA); PG8_STAGE(PG8_SB(1, 1), cB + hstep + kstep, voffB);
        PG8_WAIT_V(6); PG8_BAR;
    }
    for (;;) {
        const bool has_next = S.next(ui + 1, nxt);
        const char* nA = has_next ? (const char*)g.A + (size_t)nxt.pm * tstep : cA; const char* nB = has_next ? (const char*)g.Bt + (size_t)nxt.pn * tstep : cB;
        for (int t = 0; t < nt; t += 2) {
            const bool last = (t == nt - 2);
            const char* a1 = cA + (size_t)(t + 1) * kstep;
            const char* a2 = last ? nA : cA + (size_t)(t + 2) * kstep; const char* b2 = last ? nB : cB + (size_t)(t + 2) * kstep;
            const char* a3 = a2 + kstep; const char* b3 = b2 + kstep;
            if (last && has_next) S.a_ready(nxt);
            if constexpr (SP2) {
            PG8_LDB(B0, 0, 0); PG8_LDB(B1, 0, 1); PG8_SCHED; PG8_LDA(At, 0, 0); PG8_STAGE(PG8_SA(1, 1), a1 + hstep, voffA);
            PG8_WAIT_V(8); PG8_WAIT_L(0); PG8_BAR; PG8_MMA(0, 0, At, B0); PG8_MMA(0, 1, At, B1); PG8_BAR; PG8_SCHED;
            PG8_LDA(At, 0, 1); PG8_STAGE(PG8_SB(0, 0), b2, voffB); PG8_STAGE(PG8_SB(0, 1), b2 + hstep, voffB); PG8_STAGE(PG8_SA(0, 0), a2, voffA);
            PG8_WAIT_V(8); PG8_WAIT_L(0); PG8_BAR; PG8_MMA(1, 0, At, B0); PG8_MMA(1, 1, At, B1); PG8_BAR; PG8_SCHED;
            PG8_LDB(B0, 1, 0); PG8_LDB(B1, 1, 1); PG8_SCHED; PG8_LDA(At, 1, 0); PG8_STAGE(PG8_SA(0, 1), a2 + hstep, voffA);
            PG8_WAIT_V(8); PG8_WAIT_L(0); PG8_BAR; PG8_MMA(0, 0, At, B0); PG8_MMA(0, 1, At, B1); PG8_BAR; PG8_SCHED;
            PG8_LDA(At, 1, 1); PG8_STAGE(PG8_SB(1, 0), b3, voffB); PG8_STAGE(PG8_SB(1, 1), b3 + hstep, voffB); PG8_STAGE(PG8_SA(1, 0), a3, voffA);
            PG8_WAIT_V(8); PG8_WAIT_L(0); PG8_BAR; PG8_MMA(1, 0, At, B0); PG8_MMA(1, 1, At, B1); PG8_BAR; PG8_SCHED;
            } else {
            PG8_LDB(B0, 0, 0); PG8_SCHED; PG8_LDA(At, 0, 0); PG8_STAGE(PG8_SA(1, 1), a1 + hstep, voffA);
            PG8_WAIT_L(8); PG8_BAR; PG8_WAIT_L(0); PG8_MMA(0, 0, At, B0); PG8_BAR; PG8_SCHED;
            PG8_LDB(B1, 0, 1); PG8_STAGE(PG8_SB(0, 0), b2, voffB);
            PG8_BAR; PG8_WAIT_L(0); PG8_MMA(0, 1, At, B1); PG8_BAR;
            PG8_LDA(At, 0, 1); PG8_STAGE(PG8_SA(0, 0), a2, voffA);
            PG8_BAR; PG8_WAIT_L(0); PG8_MMA(1, 0, At, B0); PG8_BAR; PG8_SCHED;
            PG8_STAGE(PG8_SB(0, 1), b2 + hstep, voffB);
            PG8_WAIT_V(6); PG8_BAR; PG8_MMA(1, 1, At, B1); PG8_BAR;
            PG8_LDB(B0, 1, 0); PG8_SCHED; PG8_LDA(At, 1, 0); PG8_STAGE(PG8_SA(0, 1), a2 + hstep, voffA);
            PG8_WAIT_L(8); PG8_BAR; PG8_WAIT_L(0); PG8_MMA(0, 0, At, B0); PG8_BAR; PG8_SCHED;
            PG8_LDB(B1, 1, 1); PG8_STAGE(PG8_SB(1, 0), b3, voffB);
            PG8_BAR; PG8_WAIT_L(0); PG8_MMA(0, 1, At, B1); PG8_BAR;
            PG8_LDA(At, 1, 1); PG8_STAGE(PG8_SA(1, 0), a3, voffA);
            PG8_BAR; PG8_WAIT_L(0); PG8_MMA(1, 0, At, B0); PG8_BAR; PG8_SCHED;
            PG8_STAGE(PG8_SB(1, 1), b3 + hstep, voffB);
            PG8_WAIT_V(6); PG8_BAR; PG8_MMA(1, 1, At, B1); PG8_BAR;
            }
        }
        if constexpr (ALIGN_EPI) { if (wr == 0) PG8_BAR; }
        if constexpr (!Epi::AFTER_DRAIN) { E(acc, cur, wr, wc, fr, fq); S.done(cur); }
        if (!has_next) break;
#pragma unroll
        for (int a = 0; a < 2; ++a)
#pragma unroll
            for (int b = 0; b < 2; ++b)
#pragma unroll
                for (int m = 0; m < 4; ++m)
#pragma unroll
                    for (int n = 0; n < 2; ++n) acc[a][b][m][n] = acc_t{};
        cur = nxt; cA = nA; cB = nB; ++ui;
        if constexpr (ALIGN_EPI) { if (wr == 1) PG8_BAR; }
    }
    PG8_WAIT_V(0);
    if constexpr (!ALIGN_EPI) { if (wr == 0) PG8_BAR; }
    PG8_BAR;
    if constexpr (Epi::AFTER_DRAIN) { E.fused(acc, cur, wr, wc, fr, fq, lds, wid, lane); S.done(cur); }
#undef PG8_SA
#undef PG8_SB
#undef PG8_STAGE
#undef PG8_LDA
#undef PG8_LDB
#undef PG8_MMA
#undef PG8_WAIT_V
#undef PG8_WAIT_L
#undef PG8_BAR
#undef PG8_SCHED
}
}
constexpr int NWAVES = 8;
constexpr int BATCH = 8, T = 4096, D = 2048, M = BATCH * T, DFF = 5632, DEPTH = 4;
constexpr int DIN = 5160, LDP = 5376;
constexpr float NORM_EPS = 1e-6f;
constexpr int C_LRUX = 0, C_LRUY = 512, C_NQ = 1024, C_NKC = 2048, C_NVC = 2304, C_NKS = 2560, C_NVS = 2816, C_NKW = 3072, C_NVW = 3328,
              C_GQ = 3584, C_GK = 3840, C_GV = 4096, C_GG = 4608, C_NGATE = 5120, C_GA = 5144;
constexpr int MIX_A = 0, MIX_B = 512, MIX_C = 1536;
constexpr int NCMP = 255, NCMP_PAD = 256;
enum { I_X = 0, I_F1N, I_F1G, I_F1U, I_F1D, I_MIXN, I_WIN, I_CONVW, I_CONVB, I_GAW, I_GAB, I_GXW, I_GXB, I_LAM, I_LRUN, I_QN, I_KCN, I_KSN, I_KWN,
       I_PEK, I_W1K, I_W2K, I_PEV, I_W1V, I_W2V, I_GATEB, I_NSAN, I_AW2, I_AB, I_GLAN, I_WOUT, I_F2N, I_F2G, I_F2U, I_F2D, N_IN };

constexpr size_t MiB = 1u << 20;
constexpr size_t WS_CTL = 0, CTL_ZERO_BYTES = 1 * MiB;
constexpr size_t WS_ROPE = 1 * MiB;
constexpr size_t SZ_WGU = (size_t)2 * DFF * D * 2, SZ_WD = (size_t)D * DFF * 2, SZ_WIN = (size_t)LDP * D * 2, SZ_WOUT = (size_t)D * D * 2,
                 SZ_W1 = (size_t)128 * 4096 * 2, SZ_W2 = (size_t)128 * 128 * 2;
constexpr size_t WS_WGU = 2 * MiB;
constexpr size_t WS_WD = WS_WGU + (size_t)DEPTH * 2 * (SZ_WGU / 2);
constexpr size_t WS_WIN = WS_WD + (size_t)DEPTH * 2 * (SZ_WD / 2);
constexpr size_t WS_WOUT = WS_WIN + (size_t)DEPTH * SZ_WIN;
constexpr size_t WS_W1 = WS_WOUT + (size_t)DEPTH * SZ_WOUT;
constexpr size_t WS_W2 = WS_W1 + (size_t)DEPTH * 2 * SZ_W1;
constexpr size_t WS_HN = ((WS_W2 + (size_t)DEPTH * 2 * SZ_W2 + MiB - 1) / MiB) * MiB;
constexpr size_t WS_HP = WS_HN + (size_t)M * D * 2;
constexpr size_t WS_MIX = WS_HP + (size_t)M * DFF * 2;
constexpr size_t WS_KC = WS_MIX + (size_t)M * D * 2;
constexpr size_t WS_VC = WS_KC + (size_t)BATCH * 2 * NCMP_PAD * 128 * 2;
constexpr size_t WS_SA = WS_VC + (size_t)BATCH * 2 * NCMP_PAD * 128 * 2;
constexpr size_t WS_SA2 = WS_SA + (size_t)M * 4;
constexpr size_t WS_HQ2 = ((WS_SA2 + (size_t)M * 4 + MiB - 1) / MiB) * MiB;
constexpr size_t WS_XB = WS_HQ2 + (size_t)M * DFF;
constexpr size_t WS_END = WS_XB + (size_t)M * D * 2;
static_assert((size_t)M * LDP * 2 <= (size_t)M * DFF * 2, "p fits in the hidden buffer");
constexpr int CW_TMO = 0, CW_QUEUE = 64  , CW_BAR = 4096;
constexpr int CW_CMAX = 32768;
constexpr int CW_CMAX2 = CW_CMAX + DEPTH * 2 * 2 * DFF;
constexpr int CW_CMAX3 = CW_CMAX2 + DEPTH * 2 * D;
constexpr size_t SZ_WGU8 = (size_t)2 * DFF * D, SZ_WD8 = (size_t)D * DFF, SZ_WIN8 = (size_t)LDP * D;
static_assert((CW_CMAX3 + DEPTH * LDP) * 4 <= (int)CTL_ZERO_BYTES, "CMAX inside the zeroed region");

constexpr int RING_BYTES = 131072;
constexpr int LDS_BYTES = 147456;
constexpr int LDSCTL_OFF = LDS_BYTES - 512, MISC_OFF = LDSCTL_OFF;

#define GAS __attribute__((address_space(1)))
#define LAS __attribute__((address_space(3)))
typedef unsigned short bf16;
typedef unsigned v4u __attribute__((ext_vector_type(4)));
typedef unsigned v2u __attribute__((ext_vector_type(2)));
typedef float f32x4 __attribute__((ext_vector_type(4)));
typedef float f32x16 __attribute__((ext_vector_type(16)));
typedef short bf16x8 __attribute__((ext_vector_type(8)));
typedef short s16x4 __attribute__((ext_vector_type(4)));
typedef GAS unsigned gu32;
#define RLX_AGENT __ATOMIC_RELAXED, __HIP_MEMORY_SCOPE_AGENT
#define LDS_WAIT() asm volatile("s_waitcnt lgkmcnt(0)" ::: "memory")
#define VM_WAIT() asm volatile("s_waitcnt vmcnt(0)" ::: "memory")
__device__ __forceinline__ unsigned f2bf(float f) { unsigned u = __builtin_bit_cast(unsigned, f); return (u + 0x7fffu + ((u >> 16) & 1u)) >> 16; }
__device__ __forceinline__ unsigned pk2(float lo, float hi) { return f2bf(lo) | (f2bf(hi) << 16); }
__device__ __forceinline__ float bflo(unsigned w) { return __builtin_bit_cast(float, w << 16); }
__device__ __forceinline__ float bfhi(unsigned w) { return __builtin_bit_cast(float, w & 0xffff0000u); }
__device__ __forceinline__ float bf2f(bf16 b) { return __builtin_bit_cast(float, (unsigned)b << 16); }
__device__ __forceinline__ int lane_now() { unsigned ones = ~0u; asm volatile("" : "+s"(ones)); return (int)__builtin_amdgcn_mbcnt_hi(ones, __builtin_amdgcn_mbcnt_lo(ones, 0u)); }
template <int O> __device__ __forceinline__ float shx(float x, int lane) {
    if (O < 32) return __builtin_bit_cast(float, __builtin_amdgcn_ds_swizzle(__builtin_bit_cast(int, x), (O << 10) | 0x1f));
    return __builtin_bit_cast(float, __builtin_amdgcn_ds_bpermute((lane ^ 32) << 2, __builtin_bit_cast(int, x)));
}
__device__ __forceinline__ float wave_sum(float v, int lane) {
    v += shx<1>(v, lane); v += shx<2>(v, lane); v += shx<4>(v, lane); v += shx<8>(v, lane); v += shx<16>(v, lane); v += shx<32>(v, lane);
    return v;
}
__device__ __forceinline__ float sigmoidf_(float z) { return __builtin_amdgcn_rcpf(1.0f + __builtin_amdgcn_exp2f(z * -1.44269504089f)); }
__device__ __forceinline__ float gelu_tanh(float x) {
    const float u2 = 1.5957691216f * (x + 0.044715f * x * x * x);
    return x * sigmoidf_(u2);
}
__device__ __forceinline__ f32x4 mfma16(bf16x8 a, bf16x8 b, f32x4 c) { return __builtin_amdgcn_mfma_f32_16x16x32_bf16(a, b, c, 0, 0, 0); }
__device__ __forceinline__ f32x16 mfma32(bf16x8 a, bf16x8 b, f32x16 c) { return __builtin_amdgcn_mfma_f32_32x32x16_bf16(a, b, c, 0, 0, 0); }
#define XB_TMO      128
#define XB_XCNT(j)  (256  + 64 * (j))
#define XB_XSUB(j)  (1280 + 64 * (j))
#define XB_XGEN(j)  (2304 + 64 * (j))
#define XB_TOP      3328
#define XB_TOPGEN   3392
#define XCD_BAR_WORDS 3456
#define XB_SPIN_CAP (1u << 18)

__device__ __forceinline__ unsigned xb_ld(unsigned* p)              { return __hip_atomic_load(p, __ATOMIC_RELAXED, __HIP_MEMORY_SCOPE_AGENT); }
__device__ __forceinline__ unsigned xb_add(unsigned* p, unsigned v) { return __hip_atomic_fetch_add(p, v, __ATOMIC_RELAXED, __HIP_MEMORY_SCOPE_AGENT); }
__device__ __forceinline__ unsigned xb_xcc_id() { return (unsigned)__builtin_amdgcn_s_getreg((3 << 11) | 20) & 0xFu; }
#define XB_SPIN(cond, bar) do { unsigned _sp = 0; while (cond) { __builtin_amdgcn_s_sleep(1); \
    if ((++_sp & 255u) == 0u) { if (xb_ld(&(bar)[XB_TMO])) break; if (_sp > XB_SPIN_CAP) { atomicAdd(&(bar)[XB_TMO], 1u); break; } } } } while (0)

struct XcdBarrier {
    int wave;
    unsigned* bar; unsigned x;
    volatile LAS unsigned* st;
};

__device__ __forceinline__ XcdBarrier xcd_barrier_post(unsigned* bar, volatile LAS unsigned* st) {
    XcdBarrier b; b.bar = bar; b.x = xb_xcc_id(); b.st = st;
    if (threadIdx.x == 0) (void)xb_add(&bar[XB_XCNT(b.x)], 1u);
    return b;
}
__device__ __forceinline__ void xcd_barrier_complete(unsigned* bar, unsigned x, unsigned& nloc, unsigned& nx) {
    const unsigned G = gridDim.x * gridDim.y * gridDim.z;
    unsigned sum, cnt, mine, sp = 0u;
    for (;;) {
        sum = 0u; cnt = 0u; mine = 0u;
#pragma unroll
        for (unsigned j = 0; j < 16; ++j) { const unsigned c = xb_ld(&bar[XB_XCNT(j)]); sum += c; cnt += (c > 0u) ? 1u : 0u; mine = (j == x) ? c : mine; }
        if (sum == G) break;
        __builtin_amdgcn_s_sleep(1);
        if ((++sp & 255u) == 0u) { if (xb_ld(&bar[XB_TMO])) break; if (sp > XB_SPIN_CAP) { atomicAdd(&bar[XB_TMO], 1u); break; } }
    }
    nloc = mine > 0u ? mine : 1u; nx = cnt > 0u ? cnt : 1u;
}

__device__ __forceinline__ void xcd_barrier(const XcdBarrier& b) {
    asm volatile("s_waitcnt vmcnt(0)" ::: "memory");
    __syncthreads();
    if (b.wave == 0 && lane_now() == 0) {
        unsigned* bar = b.bar;
        __builtin_amdgcn_s_waitcnt(0);
        unsigned nloc = b.st[0], nx = b.st[1];
        if (nloc == 0u) { xcd_barrier_complete(bar, b.x, nloc, nx); b.st[0] = nloc; b.st[1] = nx; }
        const unsigned old = xb_add(&bar[XB_XSUB(b.x)], 1u);
        const unsigned gen = old / nloc;
        if (old + 1u == (gen + 1u) * nloc) {
            __builtin_amdgcn_fence(__ATOMIC_RELEASE, "agent");
            asm volatile("s_waitcnt vmcnt(0)" ::: "memory");
            const unsigned og = xb_add(&bar[XB_TOP], 1u);
            const unsigned tg = og / nx;
            if (og + 1u == (tg + 1u) * nx) xb_add(&bar[XB_TOPGEN], 1u);
            else XB_SPIN(xb_ld(&bar[XB_TOPGEN]) == tg, bar);
            __builtin_amdgcn_fence(__ATOMIC_ACQUIRE, "agent");
            xb_add(&bar[XB_XGEN(b.x)], 1u);
            asm volatile("s_waitcnt vmcnt(0)" ::: "memory");
        } else {
            XB_SPIN(xb_ld(&bar[XB_XGEN(b.x)]) == gen, bar);
            __builtin_amdgcn_fence(__ATOMIC_ACQUIRE, "agent");
            asm volatile("s_waitcnt vmcnt(0)" ::: "memory");
        }
    }
    __syncthreads();
}
struct Ctx {
    LAS unsigned char* lds;
    gu32* ctl;
    unsigned char* ws;
    int tid, lane, wave, vcu, G;
};

struct RowMapRt { int kind; __device__ __forceinline__ int operator()(int n) const {
    if (kind == 1) return ((n >> 7) << 8) + (n & 127);
    if (kind == 2) return ((n >> 7) << 8) + 128 + (n & 127);
    if (kind == 3) return n < 3584 ? n : (n < 3608 ? n + (C_NGATE - 3584) : (n < 5144 ? n - 24 : n));
    return n; } };
__device__ __forceinline__ void transpose_item(const float* W, int K, int N, bf16* WT, RowMapRt rm, LAS float* scr, int item, int lane, const unsigned* cmax  ) {
    const int nblk = (N + 31) >> 5, kb = item / nblk, nb = item - kb * nblk, k0 = 64 * kb, n0 = 32 * nb;
    const int n4 = 4 * (lane & 7), kr = lane >> 3;
    f32x4 v[8];
#pragma unroll
    for (int i = 0; i < 8; ++i) v[i] = (n0 + n4 < N) ? *(const GAS f32x4*)(W + (size_t)(k0 + kr + 8 * i) * N + n0 + n4) : (f32x4){0.f, 0.f, 0.f, 0.f};
#pragma unroll
    for (int i = 0; i < 8; ++i) { LAS float* d = scr + (kr + 8 * i) * 33 + n4; d[0] = v[i].x; d[1] = v[i].y; d[2] = v[i].z; d[3] = v[i].w; }
    LDS_WAIT(); asm volatile("" ::: "memory");
    const int c = lane & 7;
#pragma unroll
    for (int j = 0; j < 4; ++j) { const int nl = (lane >> 3) + 8 * j; const LAS float* s = scr + (8 * c) * 33 + nl;
        if (n0 + nl < N) {
            if (cmax) { const int row = rm(n0 + nl); const float cm = __builtin_bit_cast(float, cmax[row]), inv = cm > 0.f ? 127.0f / cm : 0.f;
                int q[8];
#pragma unroll
                for (int i = 0; i < 8; ++i) q[i] = (int)__builtin_rintf(s[i * 33] * inv) & 0xff;
                v2u o; o.x = (unsigned)(q[0] | (q[1] << 8) | (q[2] << 16) | (q[3] << 24)); o.y = (unsigned)(q[4] | (q[5] << 8) | (q[6] << 16) | (q[7] << 24));
                *(GAS v2u*)((unsigned char*)WT + (size_t)row * K + k0 + 8 * c) = o; }
            else { v4u o; o.x = pk2(s[0 * 33], s[1 * 33]); o.y = pk2(s[2 * 33], s[3 * 33]); o.z = pk2(s[4 * 33], s[5 * 33]); o.w = pk2(s[6 * 33], s[7 * 33]);
                *(GAS v4u*)(WT + (size_t)rm(n0 + nl) * K + k0 + 8 * c) = o; } } }
    LDS_WAIT(); asm volatile("" ::: "memory");
}
constexpr int IT_FF = (D / 64) * (DFF / 32), IT_WIN = (D / 64) * ((DIN + 31) / 32), IT_WOUT = (D / 64) * (D / 32), IT_W1 = (4096 / 64) * (128 / 32), IT_W2 = (128 / 64) * (128 / 32);
constexpr int IT_LAYER = 6 * IT_FF + IT_WIN + IT_WOUT + 2 * IT_W1 + 2 * IT_W2, IT_REST = IT_WOUT + 2 * IT_W1 + 2 * IT_W2;
__device__ __forceinline__ void p0_strip_store(LAS float* scr, const f32x4 (&v)[8], unsigned char* WT, int K, int k0, const int (&row)[4], const float (&inv)[4], int lane) {
    const int n4 = 4 * (lane & 7), kr = lane >> 3, c = lane & 7;
#pragma unroll
    for (int i = 0; i < 8; ++i) { LAS float* d = scr + (kr + 8 * i) * 33 + n4; d[0] = v[i].x; d[1] = v[i].y; d[2] = v[i].z; d[3] = v[i].w; }
    LDS_WAIT(); asm volatile("" ::: "memory");
#pragma unroll
    for (int j = 0; j < 4; ++j) { const int nl = (lane >> 3) + 8 * j; const LAS float* s = scr + (8 * c) * 33 + nl;
        int q[8];
#pragma unroll
        for (int i = 0; i < 8; ++i) q[i] = (int)__builtin_rintf(s[i * 33] * inv[j]) & 0xff;
        v2u o; o.x = (unsigned)(q[0] | (q[1] << 8) | (q[2] << 16) | (q[3] << 24)); o.y = (unsigned)(q[4] | (q[5] << 8) | (q[6] << 16) | (q[7] << 24));
        if (row[j] >= 0) *(GAS v2u*)(WT + (size_t)row[j] * K + k0 + 8 * c) = o; }
    LDS_WAIT(); asm volatile("" ::: "memory");
}
__device__ __forceinline__ void p0_ffn_strips(const Ctx& F0, const float* const* in) {
    Ctx F = F0; { int w_ = F0.wave; asm volatile("" : "+s"(w_)); F.wave = w_; F.lane = lane_now(); F.tid = 64 * w_ + F.lane; }
    const int lane = F.lane, w = F.wave, n4 = 4 * (lane & 7), kr = lane >> 3;
    LAS float* scr = (LAS float*)(F.lds + w * 16384);
    LAS float* cmx = (LAS float*)(F.lds + 131072);
    for (int s = F.vcu; s < DEPTH * 4 * (DFF / 32); s += F.G) {
        const int m4 = s / (DFF / 32), nb = s - m4 * (DFF / 32), l = m4 >> 2, ffn = (m4 >> 1) & 1, which = m4 & 1, n0 = 32 * nb;
        const float* W = in[(ffn ? I_F2G : I_F1G) + which] + (size_t)l * D * DFF;
        unsigned char* WT = F.ws + WS_WGU + (size_t)(l * 2 + ffn) * SZ_WGU8;
        unsigned* cm = (unsigned*)(F.ctl + CW_CMAX) + (size_t)(l * 2 + ffn) * 2 * DFF;
        f32x4 v[4][8];
#pragma unroll
        for (int t = 0; t < 4; ++t)
#pragma unroll
            for (int i = 0; i < 8; ++i) v[t][i] = *(const GAS f32x4*)(W + (size_t)(256 * w + 64 * t + kr + 8 * i) * DFF + n0 + n4);
        float mx[4] = {0.f, 0.f, 0.f, 0.f};
#pragma unroll
        for (int t = 0; t < 4; ++t)
#pragma unroll
            for (int i = 0; i < 8; ++i) { mx[0] = fmaxf(mx[0], fabsf(v[t][i].x)); mx[1] = fmaxf(mx[1], fabsf(v[t][i].y)); mx[2] = fmaxf(mx[2], fabsf(v[t][i].z)); mx[3] = fmaxf(mx[3], fabsf(v[t][i].w)); }
#pragma unroll
        for (int c = 0; c < 4; ++c) { float x = mx[c]; x = fmaxf(x, shx<8>(x, lane)); x = fmaxf(x, shx<16>(x, lane)); x = fmaxf(x, shx<32>(x, lane)); mx[c] = x; }
        if (lane < 8) {
#pragma unroll
            for (int c = 0; c < 4; ++c) cmx[w * 32 + n4 + c] = mx[c]; }
        __syncthreads();
        int row[4]; float inv[4];
#pragma unroll
        for (int j = 0; j < 4; ++j) { const int nl = (lane >> 3) + 8 * j, n = n0 + nl; float m = cmx[nl];
#pragma unroll
            for (int ww = 1; ww < 8; ++ww) m = fmaxf(m, cmx[ww * 32 + nl]);
            row[j] = ((n >> 7) << 8) + (which ? 128 : 0) + (n & 127); inv[j] = m > 0.f ? 127.0f / m : 0.f;
            if (w == 0 && (lane & 7) == 0) cm[row[j]] = __builtin_bit_cast(unsigned, m); }
#pragma unroll
        for (int t = 0; t < 4; ++t) p0_strip_store(scr, v[t], WT, D, 256 * w + 64 * t, row, inv, lane);
        __syncthreads();
    }
    for (int s = F.vcu; s < DEPTH * ((DIN + 31) / 32); s += F.G) {
        const int l = s / ((DIN + 31) / 32), nb = s - l * ((DIN + 31) / 32), n0 = 32 * nb;
        const float* W = in[I_WIN] + (size_t)l * D * DIN;
        unsigned char* WT = F.ws + WS_WIN + (size_t)l * SZ_WIN8;
        unsigned* cm = (unsigned*)(F.ctl + CW_CMAX3) + (size_t)l * LDP;
        const bool inr = n0 + n4 < DIN;
        f32x4 v[4][8];
#pragma unroll
        for (int t = 0; t < 4; ++t)
#pragma unroll
            for (int i = 0; i < 8; ++i) v[t][i] = inr ? *(const GAS f32x4*)(W + (size_t)(256 * w + 64 * t + kr + 8 * i) * DIN + n0 + n4) : (f32x4){0.f, 0.f, 0.f, 0.f};
        float mx[4] = {0.f, 0.f, 0.f, 0.f};
#pragma unroll
        for (int t = 0; t < 4; ++t)
#pragma unroll
            for (int i = 0; i < 8; ++i) { mx[0] = fmaxf(mx[0], fabsf(v[t][i].x)); mx[1] = fmaxf(mx[1], fabsf(v[t][i].y)); mx[2] = fmaxf(mx[2], fabsf(v[t][i].z)); mx[3] = fmaxf(mx[3], fabsf(v[t][i].w)); }
#pragma unroll
        for (int c = 0; c < 4; ++c) { float x = mx[c]; x = fmaxf(x, shx<8>(x, lane)); x = fmaxf(x, shx<16>(x, lane)); x = fmaxf(x, shx<32>(x, lane)); mx[c] = x; }
        if (lane < 8) {
#pragma unroll
            for (int c = 0; c < 4; ++c) cmx[w * 32 + n4 + c] = mx[c]; }
        __syncthreads();
        int row[4]; float inv[4];
#pragma unroll
        for (int j = 0; j < 4; ++j) { const int nl = (lane >> 3) + 8 * j, n = n0 + nl; float m = cmx[nl];
#pragma unroll
            for (int ww = 1; ww < 8; ++ww) m = fmaxf(m, cmx[ww * 32 + nl]);
            row[j] = n < DIN ? RowMapRt{3}(n) : -1; inv[j] = m > 0.f ? 127.0f / m : 0.f;
            if (w == 0 && (lane & 7) == 0 && n < DIN) cm[row[j]] = __builtin_bit_cast(unsigned, m); }
#pragma unroll
        for (int t = 0; t < 4; ++t) p0_strip_store(scr, v[t], WT, D, 256 * w + 64 * t, row, inv, lane);
        __syncthreads();
    }
    for (int s = F.vcu; s < DEPTH * 2 * (D / 32); s += F.G) {
        const int m2 = s / (D / 32), nb = s - m2 * (D / 32), l = m2 >> 1, ffn = m2 & 1, n0 = 32 * nb;
        const float* W = in[ffn ? I_F2D : I_F1D] + (size_t)l * D * DFF;
        unsigned char* WT = F.ws + WS_WD + (size_t)(l * 2 + ffn) * SZ_WD8;
        unsigned* cm = (unsigned*)(F.ctl + CW_CMAX2) + (size_t)(l * 2 + ffn) * D;
        float mx[4] = {0.f, 0.f, 0.f, 0.f};
        for (int kb = w; kb < DFF / 64; kb += 8) {
#pragma unroll
            for (int i = 0; i < 8; ++i) { const f32x4 x = *(const GAS f32x4*)(W + (size_t)(64 * kb + kr + 8 * i) * D + n0 + n4);
                mx[0] = fmaxf(mx[0], fabsf(x.x)); mx[1] = fmaxf(mx[1], fabsf(x.y)); mx[2] = fmaxf(mx[2], fabsf(x.z)); mx[3] = fmaxf(mx[3], fabsf(x.w)); } }
#pragma unroll
        for (int c = 0; c < 4; ++c) { float x = mx[c]; x = fmaxf(x, shx<8>(x, lane)); x = fmaxf(x, shx<16>(x, lane)); x = fmaxf(x, shx<32>(x, lane)); mx[c] = x; }
        if (lane < 8) {
#pragma unroll
            for (int c = 0; c < 4; ++c) cmx[w * 32 + n4 + c] = mx[c]; }
        __syncthreads();
        int row[4]; float inv[4];
#pragma unroll
        for (int j = 0; j < 4; ++j) { const int nl = (lane >> 3) + 8 * j; float m = cmx[nl];
#pragma unroll
            for (int ww = 1; ww < 8; ++ww) m = fmaxf(m, cmx[ww * 32 + nl]);
            row[j] = n0 + nl; inv[j] = m > 0.f ? 127.0f / m : 0.f;
            if (w == 0 && (lane & 7) == 0) cm[row[j]] = __builtin_bit_cast(unsigned, m); }
        for (int kb = w; kb < DFF / 64; kb += 8) { f32x4 x[8];
#pragma unroll
            for (int i = 0; i < 8; ++i) x[i] = *(const GAS f32x4*)(W + (size_t)(64 * kb + kr + 8 * i) * D + n0 + n4);
            p0_strip_store(scr, x, WT, DFF, 64 * kb, row, inv, lane); }
        __syncthreads();
    }
}
__device__ __forceinline__ void p0_prologue(const Ctx& F0, const float* const* in) {
    Ctx F = F0; { int w_ = F0.wave; asm volatile("" : "+s"(w_)); F.wave = w_; F.lane = lane_now(); F.tid = 64 * w_ + F.lane; }
    LAS float* scr = (LAS float*)(F.lds + F.wave * 16384);
    const int gw = F.vcu * NWAVES + F.wave, NGW = F.G * NWAVES;
    for (int it = gw; it < DEPTH * IT_REST; it += NGW) {
        const int l = it / IT_REST; int r = it - l * IT_REST;
        const float* W; bf16* WT; int K, N, kind = 0; const unsigned* cmx = nullptr;
        if (r < IT_WOUT) { W = in[I_WOUT] + (size_t)l * D * D; K = D; N = D; WT = (bf16*)(F.ws + WS_WOUT + (size_t)l * SZ_WOUT); }
        else if ((r -= IT_WOUT) < 2 * IT_W1) { const int kv = r / IT_W1; r -= kv * IT_W1; W = in[kv ? I_W1V : I_W1K] + (size_t)l * 4096 * 128; K = 4096; N = 128; WT = (bf16*)(F.ws + WS_W1 + (size_t)(l * 2 + kv) * SZ_W1); }
        else { r -= 2 * IT_W1; const int kv = r / IT_W2; r -= kv * IT_W2; W = in[kv ? I_W2V : I_W2K] + (size_t)l * 128 * 128; K = 128; N = 128; WT = (bf16*)(F.ws + WS_W2 + (size_t)(l * 2 + kv) * SZ_W2); }
        transpose_item(W, K, N, WT, RowMapRt{kind}, scr, r, F.lane, cmx);
    }
    const int gt = (F.vcu * NWAVES + F.wave) * 64 + F.lane, NGT = NGW * 64;
    constexpr int PADCH = (LDP - DIN) * D / 16;
    for (int i = gt; i < DEPTH * PADCH; i += NGT) { const int l = i / PADCH, c = i - l * PADCH;
        *(GAS v4u*)(F.ws + WS_WIN + (size_t)l * SZ_WIN8 + (size_t)DIN * D + (size_t)c * 16) = (v4u){0u, 0u, 0u, 0u}; }
    float* ctab = (float*)(F.ws + WS_ROPE); float* stab = ctab + T * 16;
    for (int i = gt; i < T * 16; i += NGT) { const int t = i >> 4, k = i & 15;
        const double inv = exp2(-(double)k * (18.931568569324174 / 16.0));
        double rev = (double)t * inv * 0.15915494309189535;
        rev -= floor(rev); const float fr = (float)rev;
        ctab[i] = __builtin_amdgcn_cosf(fr); stab[i] = __builtin_amdgcn_sinf(fr); }
}

__device__ __forceinline__ void load_xrow(const void* x, bool x_f32, int m, int lane, f32x4 (&v)[8]) {
    if (x_f32) { const GAS f32x4* xr = (const GAS f32x4*)((const float*)x + (size_t)m * D) + lane;
#pragma unroll
        for (int j = 0; j < 8; ++j) v[j] = xr[64 * j]; }
    else { const GAS v2u* xr = (const GAS v2u*)((const bf16*)x + (size_t)m * D) + lane;
#pragma unroll
        for (int j = 0; j < 8; ++j) { const v2u w = xr[64 * j]; v[j] = (f32x4){bflo(w.x), bfhi(w.x), bflo(w.y), bfhi(w.y)}; } }
}
__device__ __forceinline__ void rmsnorm_phase(const Ctx& F0, const void* x, bool x_f32, const float* gain, bf16* out) {
    Ctx F = F0; { int w_ = F0.wave; asm volatile("" : "+s"(w_)); F.wave = w_; F.lane = lane_now(); F.tid = 64 * w_ + F.lane; }
    const int gw = F.vcu * NWAVES + F.wave, NGW = F.G * NWAVES;
    f32x4 g[8];
#pragma unroll
    for (int j = 0; j < 8; ++j) g[j] = ((const GAS f32x4*)gain + F.lane)[64 * j];
    for (int m = gw; m < M; m += NGW) {
        f32x4 v[8]; float s = 0.f;
        load_xrow(x, x_f32, m, F.lane, v);
#pragma unroll
        for (int j = 0; j < 8; ++j) s += (v[j].x * v[j].x + v[j].y * v[j].y) + (v[j].z * v[j].z + v[j].w * v[j].w);
        const float r = 1.0f / sqrtf(wave_sum(s, F.lane) * (1.f / D) + NORM_EPS);
        GAS v2u* o8 = (GAS v2u*)(out + (size_t)m * D) + F.lane;
#pragma unroll
        for (int j = 0; j < 8; ++j) { v2u w; w.x = pk2(v[j].x * r * g[j].x, v[j].y * r * g[j].y); w.y = pk2(v[j].z * r * g[j].z, v[j].w * r * g[j].w); o8[64 * j] = w; }
    }
}

__device__ __forceinline__ void rmsnorm_q8_phase(const Ctx& F0, const void* x, bool x_f32, const float* gain, unsigned char* out, float* sa, bf16* xb_copy = nullptr  ) {
    Ctx F = F0; { int w_ = F0.wave; asm volatile("" : "+s"(w_)); F.wave = w_; F.lane = lane_now(); F.tid = 64 * w_ + F.lane; }
    const int gw = F.vcu * NWAVES + F.wave, NGW = F.G * NWAVES, lane = F.lane;
    f32x4 g[8];
#pragma unroll
    for (int j = 0; j < 8; ++j) g[j] = ((const GAS f32x4*)gain + lane)[64 * j];
    for (int mi = gw; mi < M; mi += NGW) { const int m = M - 1 - mi;
        f32x4 v[8]; float s = 0.f;
        load_xrow(x, x_f32, m, lane, v);
        if (xb_copy) { GAS v2u* xo = (GAS v2u*)(xb_copy + (size_t)m * D) + lane;
#pragma unroll
            for (int j = 0; j < 8; ++j) { v2u w; w.x = pk2(v[j].x, v[j].y); w.y = pk2(v[j].z, v[j].w); xo[64 * j] = w; } }
#pragma unroll
        for (int j = 0; j < 8; ++j) s += (v[j].x * v[j].x + v[j].y * v[j].y) + (v[j].z * v[j].z + v[j].w * v[j].w);
        const float r = 1.0f / sqrtf(wave_sum(s, lane) * (1.f / D) + NORM_EPS);
        float am = 0.f;
#pragma unroll
        for (int j = 0; j < 8; ++j) { v[j] = v[j] * g[j] * r; am = fmaxf(am, fmaxf(fmaxf(fabsf(v[j].x), fabsf(v[j].y)), fmaxf(fabsf(v[j].z), fabsf(v[j].w)))); }
        am = fmaxf(am, shx<1>(am, lane)); am = fmaxf(am, shx<2>(am, lane)); am = fmaxf(am, shx<4>(am, lane)); am = fmaxf(am, shx<8>(am, lane)); am = fmaxf(am, shx<16>(am, lane)); am = fmaxf(am, shx<32>(am, lane));
        am = fmaxf(am, 1e-30f);
        const float inv = 127.0f / am;
        if (lane == 0) sa[m] = am * (1.0f / 127.0f);
        GAS unsigned* o4 = (GAS unsigned*)(out + (size_t)m * D) + lane;
#pragma unroll
        for (int j = 0; j < 8; ++j) { const int q0 = (int)__builtin_rintf(v[j].x * inv) & 0xff, q1 = (int)__builtin_rintf(v[j].y * inv) & 0xff, q2 = (int)__builtin_rintf(v[j].z * inv) & 0xff, q3 = (int)__builtin_rintf(v[j].w * inv) & 0xff;
            o4[64 * j] = (unsigned)(q0 | (q1 << 8) | (q2 << 16) | (q3 << 24)); }
    }
}

__device__ __forceinline__ void hidden_q8_phase(const Ctx& F0, const bf16* hid, unsigned char* out, float* sa) {
    Ctx F = F0; { int w_ = F0.wave; asm volatile("" : "+s"(w_)); F.wave = w_; F.lane = lane_now(); F.tid = 64 * w_ + F.lane; }
    const int gw = F.vcu * NWAVES + F.wave, NGW = F.G * NWAVES, lane = F.lane;
    for (int mi = gw; mi < M; mi += NGW) { const int m = M - 1 - mi;
        const GAS v4u* hr = (const GAS v4u*)(hid + (size_t)m * DFF) + lane;
        v4u raw[11]; float am = 0.f;
#pragma unroll
        for (int j = 0; j < 11; ++j) { raw[j] = hr[64 * j];
#pragma unroll
            for (int q = 0; q < 4; ++q) am = fmaxf(am, fmaxf(fabsf(bflo(raw[j][q])), fabsf(bfhi(raw[j][q])))); }
        am = fmaxf(am, shx<1>(am, lane)); am = fmaxf(am, shx<2>(am, lane)); am = fmaxf(am, shx<4>(am, lane)); am = fmaxf(am, shx<8>(am, lane)); am = fmaxf(am, shx<16>(am, lane)); am = fmaxf(am, shx<32>(am, lane));
        am = fmaxf(am, 1e-30f);
        const float inv = 127.0f / am;
        if (lane == 0) sa[m] = am * (1.0f / 127.0f);
        GAS v2u* o8 = (GAS v2u*)(out + (size_t)m * DFF) + lane;
#pragma unroll
        for (int j = 0; j < 11; ++j) { int q[8];
#pragma unroll
            for (int k = 0; k < 4; ++k) { q[2 * k] = (int)__builtin_rintf(bflo(raw[j][k]) * inv) & 0xff; q[2 * k + 1] = (int)__builtin_rintf(bfhi(raw[j][k]) * inv) & 0xff; }
            v2u o; o.x = (unsigned)(q[0] | (q[1] << 8) | (q[2] << 16) | (q[3] << 24)); o.y = (unsigned)(q[4] | (q[5] << 8) | (q[6] << 16) | (q[7] << 24)); o8[64 * j] = o; }
    }
}

__device__ __forceinline__ void outnorm_phase(const Ctx& F0, bf16* mix, const float* gain_a, const float* gain_b) {
    Ctx F = F0; { int w_ = F0.wave; asm volatile("" : "+s"(w_)); F.wave = w_; F.lane = lane_now(); F.tid = 64 * w_ + F.lane; }
    const int gw = F.vcu * NWAVES + F.wave, NGW = F.G * NWAVES, lane = F.lane;
    for (int mi = gw; mi < M; mi += NGW) { const int m = M - 1 - mi;
        GAS v4u* row = (GAS v4u*)(mix + (size_t)m * D);
        const v4u a = row[lane], b0 = row[64 + lane], b1 = row[128 + lane];
        float sa = 0.f, sb = 0.f;
#pragma unroll
        for (int j = 0; j < 4; ++j) { const float l0 = bflo(a[j]), h0 = bfhi(a[j]); sa += l0 * l0 + h0 * h0;
            const float l1 = bflo(b0[j]), h1 = bfhi(b0[j]), l2 = bflo(b1[j]), h2 = bfhi(b1[j]); sb += (l1 * l1 + h1 * h1) + (l2 * l2 + h2 * h2); }
        const float ra = 1.0f / sqrtf(wave_sum(sa, lane) * (1.f / 512.f) + NORM_EPS), rb = 1.0f / sqrtf(wave_sum(sb, lane) * (1.f / 1024.f) + NORM_EPS);
        const GAS f32x4* ga = (const GAS f32x4*)gain_a + 2 * lane; const GAS f32x4* gb0 = (const GAS f32x4*)gain_b + 2 * lane; const GAS f32x4* gb1 = gb0 + 128;
        v4u oa, ob0, ob1; const f32x4 g0 = ga[0], g1 = ga[1], h0 = gb0[0], h1 = gb0[1], k0 = gb1[0], k1 = gb1[1];
        oa.x = pk2(bflo(a.x) * ra * g0.x, bfhi(a.x) * ra * g0.y); oa.y = pk2(bflo(a.y) * ra * g0.z, bfhi(a.y) * ra * g0.w);
        oa.z = pk2(bflo(a.z) * ra * g1.x, bfhi(a.z) * ra * g1.y); oa.w = pk2(bflo(a.w) * ra * g1.z, bfhi(a.w) * ra * g1.w);
        ob0.x = pk2(bflo(b0.x) * rb * h0.x, bfhi(b0.x) * rb * h0.y); ob0.y = pk2(bflo(b0.y) * rb * h0.z, bfhi(b0.y) * rb * h0.w);
        ob0.z = pk2(bflo(b0.z) * rb * h1.x, bfhi(b0.z) * rb * h1.y); ob0.w = pk2(bflo(b0.w) * rb * h1.z, bfhi(b0.w) * rb * h1.w);
        ob1.x = pk2(bflo(b1.x) * rb * k0.x, bfhi(b1.x) * rb * k0.y); ob1.y = pk2(bflo(b1.y) * rb * k0.z, bfhi(b1.y) * rb * k0.w);
        ob1.z = pk2(bflo(b1.z) * rb * k1.x, bfhi(b1.z) * rb * k1.y); ob1.w = pk2(bflo(b1.w) * rb * k1.z, bfhi(b1.w) * rb * k1.w);
        row[lane] = oa; row[64 + lane] = ob0; row[128 + lane] = ob1;
    }
}
constexpr float QSCALE = 0.08838834764831845f * 1.4426950408889634f;
__device__ __forceinline__ void qknorm_rows(const Ctx& F0, bf16* p, const float* qn, const float* ksn, const float* kwn, const float* ctab, const float* stab) {
    Ctx F = F0; { int w_ = F0.wave; asm volatile("" : "+s"(w_)); F.wave = w_; F.lane = lane_now(); F.tid = 64 * w_ + F.lane; }
    const int gw = F.vcu * NWAVES + F.wave, NGW = F.G * NWAVES, lane = F.lane, l16 = lane & 15, grp = lane >> 4;
    int col[3]; float gg[3][8];
#pragma unroll
    for (int rnd = 0; rnd < 3; ++rnd) { const int hv = rnd * 4 + grp;
        col[rnd] = (hv < 8 ? C_NQ + hv * 128 : (hv < 10 ? C_NKS + (hv - 8) * 128 : C_NKW + (hv - 10) * 128)) + 8 * l16;
        const float* gp = hv < 8 ? qn : (hv < 10 ? ksn : kwn);
        const f32x4 g0 = *(const GAS f32x4*)(gp + 8 * l16), g1 = *(const GAS f32x4*)(gp + 8 * l16 + 4);
        gg[rnd][0] = g0.x; gg[rnd][1] = g0.y; gg[rnd][2] = g0.z; gg[rnd][3] = g0.w; gg[rnd][4] = g1.x; gg[rnd][5] = g1.y; gg[rnd][6] = g1.z; gg[rnd][7] = g1.w; }
    v4u cur[3], nxt[3];
    if (gw < M) {
#pragma unroll
        for (int rnd = 0; rnd < 3; ++rnd) cur[rnd] = *(const GAS v4u*)(p + (size_t)(M - 1 - gw) * LDP + col[rnd]); }
    for (int mi = gw; mi < M; mi += NGW) {
        const int m = M - 1 - mi, t = m & (T - 1);
        if (mi + NGW < M) {
#pragma unroll
            for (int rnd = 0; rnd < 3; ++rnd) nxt[rnd] = *(const GAS v4u*)(p + (size_t)(m - NGW) * LDP + col[rnd]); }
        f32x4 c0 = {0.f, 0.f, 0.f, 0.f}, c1 = c0, s0 = c0, s1 = c0;
        if (l16 < 4) { const GAS f32x4* cp = (const GAS f32x4*)(ctab + t * 16 + (l16 & 1) * 8); const GAS f32x4* sp = (const GAS f32x4*)(stab + t * 16 + (l16 & 1) * 8);
            c0 = cp[0]; c1 = cp[1]; s0 = sp[0]; s1 = sp[1]; }
#pragma unroll
        for (int rnd = 0; rnd < 3; ++rnd) {
            const v4u raw = cur[rnd];
            float v[8];
#pragma unroll
            for (int j = 0; j < 4; ++j) { v[2 * j] = bflo(raw[j]); v[2 * j + 1] = bfhi(raw[j]); }
            float ss = 0.f;
#pragma unroll
            for (int j = 0; j < 8; ++j) ss += v[j] * v[j];
            ss += shx<1>(ss, lane); ss += shx<2>(ss, lane); ss += shx<4>(ss, lane); ss += shx<8>(ss, lane);
            const float r = 1.0f / sqrtf(ss * (1.f / 128.f) + NORM_EPS);
            const float rs = rnd < 2 ? r * QSCALE : r;
#pragma unroll
            for (int j = 0; j < 8; ++j) v[j] *= rs * gg[rnd][j];
            float part[8];
#pragma unroll
            for (int j = 0; j < 8; ++j) part[j] = shx<2>(v[j], lane);
            if (rnd == 2 && l16 < 4) {
                const float cs[8] = {c0.x, c0.y, c0.z, c0.w, c1.x, c1.y, c1.z, c1.w}, sn[8] = {s0.x, s0.y, s0.z, s0.w, s1.x, s1.y, s1.z, s1.w};
#pragma unroll
                for (int j = 0; j < 8; ++j) v[j] = (l16 < 2) ? (v[j] * cs[j] - part[j] * sn[j]) : (v[j] * cs[j] + part[j] * sn[j]);
            }
            v4u o; o.x = pk2(v[0], v[1]); o.y = pk2(v[2], v[3]); o.z = pk2(v[4], v[5]); o.w = pk2(v[6], v[7]);
            *(GAS v4u*)(p + (size_t)m * LDP + col[rnd]) = o;
        }
#pragma unroll
        for (int rnd = 0; rnd < 3; ++rnd) cur[rnd] = nxt[rnd];
    }
}
__device__ __forceinline__ void compress_items(const Ctx& F0, const bf16* p, const float* pe_k, const float* pe_v, const bf16* w1t  , const bf16* w2t  ,
                                               const float* kcn, bf16* kc, bf16* vc) {
    Ctx F = F0; { int w_ = F0.wave; asm volatile("" : "+s"(w_)); F.wave = w_; F.lane = lane_now(); F.tid = 64 * w_ + F.lane; }
    const int lane = F.lane, r = lane & 15, quad = lane >> 4, w = F.wave;
    LAS f32x4* red = (LAS f32x4*)F.lds;
    for (int item = F.vcu; item < 256; item += F.G) {
        const int which = (item >> 7) & 1, b = (item >> 4) & 7, kv = (item >> 3) & 1, rt2 = item & 7;
        const bf16* src[2];
#pragma unroll
        for (int t2 = 0; t2 < 2; ++t2) { const int n = 32 * rt2 + 16 * t2 + r, nc = n < NCMP ? n : NCMP - 1;
            src[t2] = p + (size_t)(b * T + 16 * nc) * LDP + (which ? C_NVC : C_NKC) + kv * 128; }
        const float* pe = which ? pe_v : pe_k;
        const bf16* w1 = w1t + (size_t)which * 128 * 4096;
        f32x4 acc[2][8];
#pragma unroll
        for (int t2 = 0; t2 < 2; ++t2)
#pragma unroll
            for (int i = 0; i < 8; ++i) acc[t2][i] = (f32x4){0.f, 0.f, 0.f, 0.f};
        for (int s2 = 0; s2 < 8; ++s2) {
            v4u raw[2][2]; f32x4 pp[2][2]; v4u yb[2][8];
#pragma unroll
            for (int h = 0; h < 2; ++h) { const int k = 32 * (16 * w + 2 * s2 + h) + 8 * quad, j = k >> 7, d = k & 127;
                raw[h][0] = *(const GAS v4u*)(src[0] + (size_t)j * LDP + d); raw[h][1] = *(const GAS v4u*)(src[1] + (size_t)j * LDP + d);
                pp[h][0] = *(const GAS f32x4*)(pe + j * 128 + d); pp[h][1] = *(const GAS f32x4*)(pe + j * 128 + d + 4);
#pragma unroll
                for (int tl = 0; tl < 8; ++tl) yb[h][tl] = *(const GAS v4u*)(w1 + (size_t)(16 * tl + r) * 4096 + k); }
#pragma unroll
            for (int h = 0; h < 2; ++h)
#pragma unroll
                for (int t2 = 0; t2 < 2; ++t2) { const v4u rw = raw[h][t2];
                    v4u xa; xa.x = pk2(bflo(rw.x) + pp[h][0].x, bfhi(rw.x) + pp[h][0].y); xa.y = pk2(bflo(rw.y) + pp[h][0].z, bfhi(rw.y) + pp[h][0].w);
                    xa.z = pk2(bflo(rw.z) + pp[h][1].x, bfhi(rw.z) + pp[h][1].y); xa.w = pk2(bflo(rw.w) + pp[h][1].z, bfhi(rw.w) + pp[h][1].w);
                    const bf16x8 xf = __builtin_bit_cast(bf16x8, xa);
#pragma unroll
                    for (int tl = 0; tl < 8; ++tl) acc[t2][tl] = mfma16(xf, __builtin_bit_cast(bf16x8, yb[h][tl]), acc[t2][tl]); }
        }
#pragma unroll
        for (int t2 = 0; t2 < 2; ++t2)
#pragma unroll
            for (int tl = 0; tl < 8; ++tl) red[((w * 2 + t2) * 8 + tl) * 64 + lane] = acc[t2][tl];
        __syncthreads();
        LAS bf16* hsw = (LAS bf16*)(F.lds + 131072 + (w >> 2) * 4352);
#pragma unroll
        for (int c2 = 0; c2 < 2; ++c2) { const int tl = 2 * (w & 3) + c2, t2 = w >> 2;
            f32x4 a = red[((0 * 2 + t2) * 8 + tl) * 64 + lane];
#pragma unroll
            for (int ww = 1; ww < 8; ++ww) a += red[((ww * 2 + t2) * 8 + tl) * 64 + lane];
#pragma unroll
            for (int j = 0; j < 4; ++j) hsw[(4 * quad + j) * 136 + 16 * tl + r] = (bf16)f2bf(gelu_tanh(a[j])); }
        __syncthreads();
        if (w < 2) {
            const int t2 = w; const LAS bf16* hs = (const LAS bf16*)(F.lds + 131072 + t2 * 4352);
            v4u w2f[4][8];
            { const bf16* w2p = w2t + (size_t)which * 128 * 128;
#pragma unroll
                for (int s = 0; s < 4; ++s)
#pragma unroll
                    for (int tl = 0; tl < 8; ++tl) w2f[s][tl] = *(const GAS v4u*)(w2p + (size_t)(16 * tl + r) * 128 + 32 * s + 8 * quad); }
            __builtin_amdgcn_sched_barrier(0);
            f32x4 a2[8];
#pragma unroll
            for (int i = 0; i < 8; ++i) a2[i] = (f32x4){0.f, 0.f, 0.f, 0.f};
#pragma unroll
            for (int s = 0; s < 4; ++s) {
                const bf16x8 xf = *(const LAS bf16x8*)(hs + r * 136 + 32 * s + 8 * quad);
#pragma unroll
                for (int tl = 0; tl < 8; ++tl) a2[tl] = mfma16(xf, __builtin_bit_cast(bf16x8, w2f[s][tl]), a2[tl]);
            }
            float sc[4] = {1.f, 1.f, 1.f, 1.f};
            if (which == 0) {
#pragma unroll
                for (int j = 0; j < 4; ++j) { float ss = 0.f;
#pragma unroll
                    for (int tl = 0; tl < 8; ++tl) ss += a2[tl][j] * a2[tl][j];
                    ss += shx<1>(ss, lane); ss += shx<2>(ss, lane); ss += shx<4>(ss, lane); ss += shx<8>(ss, lane);
                    sc[j] = 1.0f / sqrtf(ss * (1.f / 128.f) + NORM_EPS); }
            }
            bf16* dst = (which ? vc : kc) + (size_t)((b * 2 + kv) * NCMP_PAD) * 128;
#pragma unroll
            for (int tl = 0; tl < 8; ++tl) { const float g = which ? 1.f : kcn[16 * tl + r];
#pragma unroll
                for (int j = 0; j < 4; ++j) { const int row = 32 * rt2 + 16 * t2 + 4 * quad + j; dst[(size_t)row * 128 + 16 * tl + r] = row < NCMP ? (bf16)f2bf(a2[tl][j] * sc[j] * g) : (bf16)0; } }
        }
        __syncthreads();
    }
}
constexpr int LRU_WA = 0, LRU_WX = 9216, LRU_XC = 18432, LRU_XCF = 27648, LRU_A = LRU_XCF + 16640, LRU_MU = LRU_A + 16640, LRU_IX = LRU_MU + 16640,
              LRU_SEG = LRU_IX + 16640, LRU_H = LRU_SEG + 4096, LRU_CONST = LRU_H + 512, LRU_END = LRU_CONST + 8 * 256;
#define LRU_BAR() do { asm volatile("s_waitcnt lgkmcnt(0)" ::: "memory"); __builtin_amdgcn_s_barrier(); asm volatile("" ::: "memory"); } while (0)
__device__ __forceinline__ void lru_unit(const Ctx& F, int b, int nb, const bf16* p, bf16* mix, const float* conv_w, const float* conv_b, const float* ga_w, const float* ga_b,
                                         const float* gx_w, const float* gx_b, const float* lam) {
    LAS unsigned char* L = F.lds;
    LAS bf16* WaT = (LAS bf16*)(L + LRU_WA); LAS bf16* WxT = (LAS bf16*)(L + LRU_WX); LAS bf16* Xc = (LAS bf16*)(L + LRU_XC);
    LAS float* XcF = (LAS float*)(L + LRU_XCF); LAS float* Aa = (LAS float*)(L + LRU_A); LAS float* Mu = (LAS float*)(L + LRU_MU); LAS float* IX = (LAS float*)(L + LRU_IX);
    LAS float* SEG = (LAS float*)(L + LRU_SEG); LAS float* H = (LAS float*)(L + LRU_H); LAS float* CST = (LAS float*)(L + LRU_CONST);
    int w = F.wave; asm volatile("" : "+s"(w));
    const int tid = 64 * w + lane_now();
    const int lane = tid & 63, c = tid & 63, seg = tid >> 6, r = lane & 15, quad = lane >> 4;
    const int c0 = 64 * nb;
    for (int e = tid; e < 4096; e += 512) { const int i = e >> 6, o = e & 63; WaT[o * 72 + i] = (bf16)f2bf(ga_w[(size_t)nb * 4096 + e]); WxT[o * 72 + i] = (bf16)f2bf(gx_w[(size_t)nb * 4096 + e]); }
    if (tid < 64) { CST[0 * 64 + tid] = conv_w[0 * 512 + c0 + tid]; CST[1 * 64 + tid] = conv_w[1 * 512 + c0 + tid]; CST[2 * 64 + tid] = conv_w[2 * 512 + c0 + tid]; CST[3 * 64 + tid] = conv_w[3 * 512 + c0 + tid];
        CST[4 * 64 + tid] = conv_b[c0 + tid]; CST[5 * 64 + tid] = ga_b[c0 + tid]; CST[6 * 64 + tid] = gx_b[c0 + tid];
        const float nl = -lam[c0 + tid]; CST[7 * 64 + tid] = fmaxf(nl, 0.f) + log1pf(expf(-fabsf(nl)));
        H[tid] = 0.f; H[64 + tid] = 0.f; }
    __syncthreads();
    const float cw0 = CST[c], cw1 = CST[64 + c], cw2 = CST[128 + c], cw3 = CST[192 + c], cb = CST[256 + c];
    const bf16* ubase = p + (long)(b * T + 8 * seg - 3) * LDP + C_LRUX + c0 + c;
    const bf16* ybase = p + (size_t)(b * T + 8 * seg) * LDP + C_LRUY + c0 + c;
    bf16 un[11], yn[8];
#pragma unroll
    for (int k = 0; k < 11; ++k) un[k] = (8 * seg - 3 + k >= 0) ? ubase[(long)k * LDP] : (bf16)0;
#pragma unroll
    for (int k = 0; k < 8; ++k) yn[k] = ybase[(size_t)k * LDP];
    for (int tt = 0; tt < T / 64; ++tt) {
        const int t0 = 64 * tt, cur = tt & 1;
        float u[11], yv[8];
#pragma unroll
        for (int k = 0; k < 11; ++k) u[k] = bf2f(un[k]);
#pragma unroll
        for (int k = 0; k < 8; ++k) yv[k] = bf2f(yn[k]);
        if (tt + 1 < T / 64) {
#pragma unroll
            for (int k = 0; k < 11; ++k) un[k] = ubase[(long)(t0 + 64 + k) * LDP];
#pragma unroll
            for (int k = 0; k < 8; ++k) yn[k] = ybase[(size_t)(t0 + 64 + k) * LDP];
        }
#pragma unroll
        for (int k = 0; k < 8; ++k) { const float xc = u[k] * cw0 + u[k + 1] * cw1 + u[k + 2] * cw2 + u[k + 3] * cw3 + cb;
            XcF[(8 * seg + k) * 65 + c] = xc; Xc[(8 * seg + k) * 72 + c] = (bf16)f2bf(xc); }
        LRU_BAR();
        { const int tm = w & 3, ch = w >> 2;
            f32x4 aa[2], ax[2];
#pragma unroll
            for (int c2 = 0; c2 < 2; ++c2) { aa[c2] = (f32x4){0.f, 0.f, 0.f, 0.f}; ax[c2] = (f32x4){0.f, 0.f, 0.f, 0.f}; }
#pragma unroll
            for (int s = 0; s < 2; ++s) { const bf16x8 xf = *(const LAS bf16x8*)(Xc + (16 * tm + r) * 72 + 32 * s + 8 * quad);
#pragma unroll
                for (int c2 = 0; c2 < 2; ++c2) { const int ct = 2 * ch + c2;
                    const bf16x8 ya = *(const LAS bf16x8*)(WaT + (16 * ct + r) * 72 + 32 * s + 8 * quad), yx = *(const LAS bf16x8*)(WxT + (16 * ct + r) * 72 + 32 * s + 8 * quad);
                    aa[c2] = mfma16(xf, ya, aa[c2]); ax[c2] = mfma16(xf, yx, ax[c2]); } }
#pragma unroll
            for (int c2 = 0; c2 < 2; ++c2) { const int o = 16 * (2 * ch + c2) + r; const float ba = CST[5 * 64 + o], bx = CST[6 * 64 + o], sp = CST[7 * 64 + o];
#pragma unroll
                for (int j = 0; j < 4; ++j) { const int t = 16 * tm + 4 * quad + j;
                    const float rg = sigmoidf_(aa[c2][j] + ba); const float a = __builtin_amdgcn_exp2f(-8.0f * 1.44269504089f * rg * sp);
                    Aa[t * 65 + o] = a; Mu[t * 65 + o] = __builtin_amdgcn_sqrtf(fmaxf(1.0f - a * a, 0.f));
                    const float ig = sigmoidf_(ax[c2][j] + bx); IX[t * 65 + o] = ig * XcF[t * 65 + o]; } } }
        LRU_BAR();
        float hl[8], pc[8];
        { float h = 0.f, P = 1.f;
#pragma unroll
            for (int k = 0; k < 8; ++k) { const int t = 8 * seg + k; const float a = Aa[t * 65 + c]; h = a * h + Mu[t * 65 + c] * IX[t * 65 + c]; P *= a; hl[k] = h; pc[k] = P; }
            SEG[(seg * 64 + c) * 2] = P; SEG[(seg * 64 + c) * 2 + 1] = h; }
        LRU_BAR();
        { float carry = H[cur * 64 + c];
            float sp_[7], sh_[7];
#pragma unroll
            for (int s = 0; s < 7; ++s) { sp_[s] = SEG[(s * 64 + c) * 2]; sh_[s] = SEG[(s * 64 + c) * 2 + 1]; }
#pragma unroll
            for (int s = 0; s < 7; ++s) if (s < w) carry = sp_[s] * carry + sh_[s];
            bf16* op = mix + (size_t)(b * T + t0 + 8 * seg) * D + MIX_A + c0 + c;
            float hf = 0.f;
#pragma unroll
            for (int k = 0; k < 8; ++k) { hf = hl[k] + pc[k] * carry; op[(size_t)k * D] = (bf16)f2bf(hf * gelu_tanh(yv[k])); }
            if (seg == 7) H[(cur ^ 1) * 64 + c] = hf; }
        LRU_BAR();
    }
}
constexpr int GL_QT = 0, GL_KT = 9216, GL_KHT = 18432, GL_AM = 27648, GL_VT = 36864, GL_ST = GL_VT + 18432, GL_ALR = GL_ST + 18432, GL_EB = GL_ALR + 2 * 4096, GL_SEGS = GL_EB + 256,
              GL_RS = GL_SEGS + 2048, GL_END = GL_RS + 512;
__device__ __forceinline__ float exp_fast(float x) { return __builtin_amdgcn_exp2f(x * 1.44269504089f); }
__device__ __forceinline__ void gla_unit(const Ctx& F, int b, int h, const bf16* p, bf16* mix, const float* a_w2, const float* a_b, const float* onorm) {
    LAS unsigned char* L = F.lds;
    LAS bf16* Qt = (LAS bf16*)(L + GL_QT); LAS bf16* Kt = (LAS bf16*)(L + GL_KT); LAS bf16* KhT = (LAS bf16*)(L + GL_KHT); LAS bf16* Am = (LAS bf16*)(L + GL_AM);
    LAS bf16* VT = (LAS bf16*)(L + GL_VT); LAS bf16* ST = (LAS bf16*)(L + GL_ST); LAS float* ALR = (LAS float*)(L + GL_ALR); LAS float* EB = (LAS float*)(L + GL_EB); LAS float* SEGS = (LAS float*)(L + GL_SEGS);
    LAS float* RS = (LAS float*)(L + GL_RS);
    int w = F.wave; asm volatile("" : "+s"(w));
    const int tid = 64 * w + lane_now();
    const int lane = tid & 63, d = tid & 63, seg = tid >> 6, r = lane & 15, quad = lane >> 4;
    float aw[16];
#pragma unroll
    for (int rr = 0; rr < 16; ++rr) aw[rr] = a_w2[rr * 256 + h * 64 + d];
    const float abd = a_b[h * 64 + d];
    const int dt = w & 3, eh = w >> 2, it = w & 3;
    f32x4 Sacc[4];
#pragma unroll
    for (int et = 0; et < 4; ++et) Sacc[et] = (f32x4){0.f, 0.f, 0.f, 0.f};
    float gn[4][4];
#pragma unroll
    for (int et = 0; et < 4; ++et)
#pragma unroll
        for (int j = 0; j < 4; ++j) gn[et][j] = onorm[64 * eh + 16 * et + 4 * quad + j];
    const size_t rowb = (size_t)b * T;
    const bf16* qbase = p + (rowb + 8 * seg) * LDP + C_GQ + h * 64 + d;
    const bf16* vbase = p + (rowb + (tid >> 3)) * LDP + C_GV + h * 128 + 16 * (tid & 7);
    const bf16* abase = p + (rowb + (tid >> 1)) * LDP + C_GA + 8 * (tid & 1);
    const bf16* gbase = p + (rowb + 16 * it + r) * LDP + C_GG + h * 128 + 64 * eh + 4 * quad;
    bf16 qn[8], kn[8]; v4u vn0, vn1, an = {0u, 0u, 0u, 0u}; v2u ggn[4];
#pragma unroll
    for (int k = 0; k < 8; ++k) { qn[k] = qbase[(size_t)k * LDP]; kn[k] = qbase[(size_t)k * LDP + (C_GK - C_GQ)]; }
    vn0 = *(const GAS v4u*)vbase; vn1 = *(const GAS v4u*)(vbase + 8);
    if (tid < 128) an = *(const GAS v4u*)abase;
#pragma unroll
    for (int et = 0; et < 4; ++et) ggn[et] = *(const GAS v2u*)(gbase + 16 * et);
    if (tid < 128) { LAS float* ap = ALR + (tid >> 1) * 16 + 8 * (tid & 1);
#pragma unroll
        for (int q = 0; q < 4; ++q) { ap[2 * q] = bflo(an[q]); ap[2 * q + 1] = bfhi(an[q]); } }
    __syncthreads();
    for (int ch = 0; ch < T / 64; ++ch) {
        const size_t row0 = rowb + 64 * ch;
        const LAS float* alr = ALR + (ch & 1) * 1024;
        float qv[8], kv[8]; v4u v0 = vn0, v1 = vn1; v2u gg[4];
#pragma unroll
        for (int k = 0; k < 8; ++k) { qv[k] = bf2f(qn[k]) * 0.125f; kv[k] = bf2f(kn[k]); }
#pragma unroll
        for (int et = 0; et < 4; ++et) gg[et] = ggn[et];
        if (ch + 1 < T / 64) { const size_t o = (size_t)(64 * (ch + 1)) * LDP;
#pragma unroll
            for (int k = 0; k < 8; ++k) { qn[k] = qbase[o + (size_t)k * LDP]; kn[k] = qbase[o + (size_t)k * LDP + (C_GK - C_GQ)]; }
            vn0 = *(const GAS v4u*)(vbase + o); vn1 = *(const GAS v4u*)(vbase + o + 8);
            if (tid < 128) an = *(const GAS v4u*)(abase + o);
#pragma unroll
            for (int et = 0; et < 4; ++et) ggn[et] = *(const GAS v2u*)(gbase + o + 16 * et); }
        float bl[8];
        { float run = 0.f;
#pragma unroll
            for (int k = 0; k < 8; ++k) { const LAS f32x4* ar = (const LAS f32x4*)(alr + (8 * seg + k) * 16);
                float z = abd;
#pragma unroll
                for (int q = 0; q < 4; ++q) { const f32x4 a4 = ar[q]; z += (a4.x * aw[4 * q] + a4.y * aw[4 * q + 1]) + (a4.z * aw[4 * q + 2] + a4.w * aw[4 * q + 3]); }
                const float ls = fminf(z, 0.f) - 0.69314718056f * __builtin_amdgcn_logf(1.0f + exp_fast(-fabsf(z)));
                run += ls * (1.0f / 16.0f); bl[k] = run; }
            SEGS[seg * 64 + d] = run; }
#pragma unroll
        for (int et = 0; et < 4; ++et) { v2u wv; wv.x = pk2(Sacc[et][0], Sacc[et][1]); wv.y = pk2(Sacc[et][2], Sacc[et][3]);
            *(LAS v2u*)(ST + (64 * eh + 16 * et + r) * 72 + 16 * dt + 4 * quad) = wv; }
        { const int j = tid >> 3, e0 = 16 * (tid & 7);
#pragma unroll
            for (int q = 0; q < 4; ++q) { VT[(e0 + 2 * q) * 72 + j] = (bf16)(v0[q] & 0xffffu); VT[(e0 + 2 * q + 1) * 72 + j] = (bf16)(v0[q] >> 16);
                VT[(e0 + 8 + 2 * q) * 72 + j] = (bf16)(v1[q] & 0xffffu); VT[(e0 + 8 + 2 * q + 1) * 72 + j] = (bf16)(v1[q] >> 16); } }
        LRU_BAR();
        { float pre = 0.f, tot = 0.f;
#pragma unroll
            for (int s = 0; s < 8; ++s) { const float v = SEGS[s * 64 + d]; tot += v; if (s < seg) pre += v; }
            if (seg == 0) EB[d] = exp_fast(tot);
#pragma unroll
            for (int k = 0; k < 8; ++k) { const int j = 8 * seg + k; const float bb = bl[k] + pre;
                Qt[j * 72 + d] = (bf16)f2bf(qv[k] * exp_fast(bb)); Kt[j * 72 + d] = (bf16)f2bf(kv[k] * exp_fast(-bb)); KhT[d * 72 + j] = (bf16)f2bf(kv[k] * exp_fast(tot - bb)); } }
        LRU_BAR();
        f32x4 Oacc[4];
#pragma unroll
        for (int et = 0; et < 4; ++et) Oacc[et] = (f32x4){0.f, 0.f, 0.f, 0.f};
        { bf16x8 qf[2];
#pragma unroll
            for (int s = 0; s < 2; ++s) qf[s] = *(const LAS bf16x8*)(Qt + (16 * it + r) * 72 + 32 * s + 8 * quad);
#pragma unroll
            for (int et = 0; et < 4; ++et)
#pragma unroll
                for (int s = 0; s < 2; ++s) { const bf16x8 sf = *(const LAS bf16x8*)(ST + (64 * eh + 16 * et + r) * 72 + 32 * s + 8 * quad); Oacc[et] = mfma16(sf, qf[s], Oacc[et]); }
            const int jt = w & 3;
#pragma unroll
            for (int ii = 0; ii < 2; ++ii) { const int itl = 2 * (w >> 2) + ii; f32x4 a = (f32x4){0.f, 0.f, 0.f, 0.f};
#pragma unroll
                for (int s = 0; s < 2; ++s) { const bf16x8 kf = *(const LAS bf16x8*)(Kt + (16 * jt + r) * 72 + 32 * s + 8 * quad); const bf16x8 q2 = *(const LAS bf16x8*)(Qt + (16 * itl + r) * 72 + 32 * s + 8 * quad);
                    a = mfma16(kf, q2, a); }
                const int i = 16 * itl + r, j0 = 16 * jt + 4 * quad;
                v2u wv; wv.x = pk2(j0 <= i ? a[0] : 0.f, j0 + 1 <= i ? a[1] : 0.f); wv.y = pk2(j0 + 2 <= i ? a[2] : 0.f, j0 + 3 <= i ? a[3] : 0.f);
                *(LAS v2u*)(Am + i * 72 + j0) = wv; } }
        LRU_BAR();
        { bf16x8 af[2];
#pragma unroll
            for (int s = 0; s < 2; ++s) af[s] = *(const LAS bf16x8*)(Am + (16 * it + r) * 72 + 32 * s + 8 * quad);
#pragma unroll
            for (int et = 0; et < 4; ++et)
#pragma unroll
                for (int s = 0; s < 2; ++s) { const bf16x8 vf = *(const LAS bf16x8*)(VT + (64 * eh + 16 * et + r) * 72 + 32 * s + 8 * quad); Oacc[et] = mfma16(vf, af[s], Oacc[et]); }
            const f32x4 eb = *(const LAS f32x4*)(EB + 16 * dt + 4 * quad);
            bf16x8 kf[2];
#pragma unroll
            for (int s = 0; s < 2; ++s) kf[s] = *(const LAS bf16x8*)(KhT + (16 * dt + r) * 72 + 32 * s + 8 * quad);
#pragma unroll
            for (int et = 0; et < 4; ++et) { Sacc[et] = Sacc[et] * eb;
#pragma unroll
                for (int s = 0; s < 2; ++s) { const bf16x8 vf = *(const LAS bf16x8*)(VT + (64 * eh + 16 * et + r) * 72 + 32 * s + 8 * quad); Sacc[et] = mfma16(kf[s], vf, Sacc[et]); } } }
        if (tid < 128 && ch + 1 < T / 64) { LAS float* ap = ALR + ((ch + 1) & 1) * 1024 + (tid >> 1) * 16 + 8 * (tid & 1);
#pragma unroll
            for (int q = 0; q < 4; ++q) { ap[2 * q] = bflo(an[q]); ap[2 * q + 1] = bfhi(an[q]); } }
        { float ss = 0.f;
#pragma unroll
            for (int et = 0; et < 4; ++et) ss += (Oacc[et][0] * Oacc[et][0] + Oacc[et][1] * Oacc[et][1]) + (Oacc[et][2] * Oacc[et][2] + Oacc[et][3] * Oacc[et][3]);
            ss += shx<16>(ss, lane); ss += shx<32>(ss, lane);
            if (quad == 0) RS[(16 * it + r) * 2 + eh] = ss; }
        LRU_BAR();
        { const float tot = RS[(16 * it + r) * 2] + RS[(16 * it + r) * 2 + 1];
            const float rn = 1.0f / sqrtf(tot * (1.f / 128.f) + NORM_EPS);
            const size_t row = row0 + 16 * it + r;
#pragma unroll
            for (int et = 0; et < 4; ++et) { const int e = 64 * eh + 16 * et + 4 * quad;
                const float g0 = bflo(gg[et].x), g1 = bfhi(gg[et].x), g2 = bflo(gg[et].y), g3 = bfhi(gg[et].y);
                v2u o; o.x = pk2(Oacc[et][0] * rn * gn[et][0] * g0 * sigmoidf_(g0), Oacc[et][1] * rn * gn[et][1] * g1 * sigmoidf_(g1));
                o.y = pk2(Oacc[et][2] * rn * gn[et][2] * g2 * sigmoidf_(g2), Oacc[et][3] * rn * gn[et][3] * g3 * sigmoidf_(g3));
                *(GAS v2u*)(mix + row * D + MIX_C + h * 128 + e) = o; } }
    }
}
constexpr int AT_SLOT = 32768, AT_IMP = 65536, AT_SELM = 131072, AT_END = AT_SELM + 512;
typedef short v4i16_t __attribute__((ext_vector_type(4)));
__device__ __forceinline__ unsigned off_b(unsigned row, unsigned ch) { return 256u * row + 16u * (ch ^ (((row & 3u) << 2) | ((row >> 2) & 3u))); }
struct TileSrc { const bf16* base; size_t stride; };
__device__ __forceinline__ void glds16(const void* sbase, unsigned voff, unsigned lds_dst) { unsigned keep;
    asm volatile("s_mov_b32 %0, m0\n\ts_mov_b32 m0, %3\n\ts_nop 0\n\tglobal_load_lds_dwordx4 %1, %2\n\ts_mov_b32 m0, %0" : "=&s"(keep) : "v"(voff), "s"(sbase), "s"(lds_dst) : "memory"); }
__device__ __forceinline__ unsigned tile_lane_off(int i, int wave, int lane, unsigned stride) {
    const int seg = 2 * wave + i; const unsigned row = 4u * seg + (lane >> 4), ch = (lane & 15u) ^ (((row & 3u) << 2) | ((row >> 2) & 3u));
    return (row * stride + 8u * ch) * 2u; }
__device__ __forceinline__ void tile_dma(const TileSrc& s, int tl, LAS unsigned char* buf, int wave, unsigned lo0, unsigned lo1) {
    const bf16* tb = s.base + (size_t)(64 * tl) * s.stride;
    glds16(tb, lo0, (unsigned)(size_t)(buf + 1024 * (2 * wave))); glds16(tb, lo1, (unsigned)(size_t)(buf + 1024 * (2 * wave + 1)));
}
#define AT_LDS_BAR() do { asm volatile("s_waitcnt lgkmcnt(0)" ::: "memory"); __builtin_amdgcn_s_barrier(); asm volatile("" ::: "memory"); } while (0)
#define AT_DRAIN_BAR() do { asm volatile("s_waitcnt vmcnt(0) lgkmcnt(0)" ::: "memory"); __builtin_amdgcn_s_barrier(); asm volatile("" ::: "memory"); } while (0)
typedef float f32x2_t __attribute__((ext_vector_type(2))); typedef __bf16 bf16x2_t __attribute__((ext_vector_type(2)));
__device__ __forceinline__ unsigned cvtpk(float lo, float hi) { const f32x2_t v = {lo, hi}; const bf16x2_t b = __builtin_convertvector(v, bf16x2_t); return __builtin_bit_cast(unsigned, b); }
enum { BR_CMP = 0, BR_SEL = 1, BR_WIN = 2 };
constexpr float AT_SC = 0.08838834764831845f * 1.4426950408889634f;
__device__ __forceinline__ void qk_tile(const LAS unsigned char* kb, const bf16x8 (&qf)[8], int lane, f32x16 (&sacc)[2]) {
#pragma unroll
    for (int kt = 0; kt < 2; ++kt) {
        f32x16 a = {0.f, 0.f, 0.f, 0.f, 0.f, 0.f, 0.f, 0.f, 0.f, 0.f, 0.f, 0.f, 0.f, 0.f, 0.f, 0.f};
#pragma unroll
        for (int s = 0; s < 8; ++s) { const bf16x8 kf = *(const LAS bf16x8*)(kb + off_b(32 * kt + (lane & 31), 2 * s + (lane >> 5))); a = mfma32(kf, qf[s], a); }
        sacc[kt] = a;
    }
}
template <int BR> __device__ __forceinline__ bool key_ok(int key, int t, bool selbit) {
    if (BR == BR_CMP) return 16 * key + 31 <= t;
    if (BR == BR_SEL) return selbit && key <= t;
    return key <= t && key + 512 > t;
}
template <int BR, int MODE, int NSLOT>
__device__ __forceinline__ void attn_branch(const Ctx& F, const TileSrc& ks, const TileSrc& vs, int lo, int hi, const bf16x8 (&qf)[8], int t, float gate, float shift, unsigned long long selmask,
                                            float* yb  , bf16* outp  , LAS float* imp_row  ) {
    const int lane = F.lane, hh = lane >> 5, wv = F.wave;
    const float NEG_INF = -__builtin_inff();
    f32x16 obr[4];
#pragma unroll
    for (int c = 0; c < 4; ++c) obr[c] = (f32x16){0.f, 0.f, 0.f, 0.f, 0.f, 0.f, 0.f, 0.f, 0.f, 0.f, 0.f, 0.f, 0.f, 0.f, 0.f, 0.f};
    float imp_carry = 0.f; f32x2_t l2 = {0.f, 0.f};
    asm volatile("s_waitcnt lgkmcnt(0)" ::: "memory"); __builtin_amdgcn_s_barrier(); asm volatile("" ::: "memory");
    const int n = hi - lo;
    const unsigned lo0 = tile_lane_off(0, wv, lane, (unsigned)ks.stride), lo1 = tile_lane_off(1, wv, lane, (unsigned)ks.stride);
    constexpr int NPRE = NSLOT == 4 ? 2 : NSLOT - 1;
#pragma unroll
    for (int j = 0; j < NPRE; ++j) if (j < n) { tile_dma(ks, lo + j, F.lds + j * AT_SLOT, wv, lo0, lo1); tile_dma(vs, lo + j, F.lds + j * AT_SLOT + 16384, wv, lo0, lo1); }
    const unsigned trq = (lane & 15) >> 2, trp = lane & 3, trblk = (lane >> 4) & 1;
    unsigned vof0[4], vof1[4];
    { const unsigned lc = 2u * trblk + (trp >> 1), hq = (unsigned)hh;
#pragma unroll
        for (unsigned c = 0; c < 4; ++c) { vof0[c] = 256u * (4u * hq + trq) + 16u * (((c ^ trq) << 2) | (lc ^ hq)) + 8u * (trp & 1u);
            vof1[c] = 256u * (4u * hq + trq + 8u) + 16u * (((c ^ trq) << 2) | (lc ^ (hq + 2u))) + 8u * (trp & 1u); } }
    for (int i = 0; i < n; ++i) {
        const int tl = lo + i, slot = i & (NSLOT - 1);
        if (NSLOT == 4) {
            if ((i & 1) == 0) {
                asm volatile("s_waitcnt vmcnt(0) lgkmcnt(0)" ::: "memory"); __builtin_amdgcn_s_barrier(); asm volatile("" ::: "memory");
#pragma unroll
                for (int j = 2; j < 4; ++j) if (i + j < n) { const int ns = (i + j) & 3; tile_dma(ks, tl + j, F.lds + ns * AT_SLOT, wv, lo0, lo1); tile_dma(vs, tl + j, F.lds + ns * AT_SLOT + 16384, wv, lo0, lo1); }
            }
        } else {
            asm volatile("s_waitcnt vmcnt(0) lgkmcnt(0)" ::: "memory"); __builtin_amdgcn_s_barrier(); asm volatile("" ::: "memory");
            if (i + 1 < n) { const int ns = (i + 1) & 1; tile_dma(ks, tl + 1, F.lds + ns * AT_SLOT, wv, lo0, lo1); tile_dma(vs, tl + 1, F.lds + ns * AT_SLOT + 16384, wv, lo0, lo1); }
        }
        const LAS unsigned char* kb = F.lds + slot * AT_SLOT; const LAS unsigned char* vb = kb + 16384;
        const bool selbit = (selmask >> tl) & 1ull;
        const float ainit = (BR == BR_SEL && !selbit) ? NEG_INF : -shift;
        const bool masked = BR == BR_CMP || tl == hi - 1 || (BR == BR_WIN && tl + 8 == hi - 1);
        bf16x8 pf[2][2];
#pragma unroll
        for (int kt = 0; kt < 2; ++kt) {
            f32x16 sa = {ainit, ainit, ainit, ainit, ainit, ainit, ainit, ainit, ainit, ainit, ainit, ainit, ainit, ainit, ainit, ainit};
            bf16x8 kfr[8];
#pragma unroll
            for (int s = 0; s < 8; ++s) kfr[s] = *(const LAS bf16x8*)(kb + off_b(32 * kt + (lane & 31), 2 * s + (lane >> 5)));
            __builtin_amdgcn_sched_barrier(0);
#pragma unroll
            for (int s = 0; s < 8; ++s) sa = mfma32(kfr[s], qf[s], sa);
            float pv[16];
            if (masked) {
#pragma unroll
                for (int i2 = 0; i2 < 16; ++i2) { const int key = 64 * tl + 32 * kt + (i2 & 3) + 8 * (i2 >> 2) + 4 * hh;
                    pv[i2] = __builtin_amdgcn_exp2f(key_ok<BR>(key, t, true) ? sa[i2] : NEG_INF); }
            } else {
#pragma unroll
                for (int i2 = 0; i2 < 16; ++i2) pv[i2] = __builtin_amdgcn_exp2f(sa[i2]);
            }
            { f32x2_t t0 = (f32x2_t){pv[0], pv[1]} + (f32x2_t){pv[2], pv[3]}, t1 = (f32x2_t){pv[4], pv[5]} + (f32x2_t){pv[6], pv[7]}, t2 = (f32x2_t){pv[8], pv[9]} + (f32x2_t){pv[10], pv[11]}, t3 = (f32x2_t){pv[12], pv[13]} + (f32x2_t){pv[14], pv[15]};
              l2 += (t0 + t1) + (t2 + t3); }
            if (BR == BR_CMP) {
                float x[4];
#pragma unroll
                for (int gi = 0; gi < 4; ++gi) x[gi] = shx<32>(pv[4 * gi + 3], lane);
#pragma unroll
                for (int gi = 0; gi < 4; ++gi) { const int sb = 16 * tl + 8 * kt + 2 * gi + hh;
                    const float s4 = (pv[4 * gi] + pv[4 * gi + 1]) + (pv[4 * gi + 2] + pv[4 * gi + 3]);
                    const float extra = hh ? x[gi] : (gi == 0 ? imp_carry : x[gi > 0 ? gi - 1 : 0]);
                    imp_row[sb] = s4 + extra; }
                imp_carry = x[3];
            }
            v4u w0, w1;
            w0.x = cvtpk(pv[0], pv[1]); w0.y = cvtpk(pv[2], pv[3]); w0.z = cvtpk(pv[4], pv[5]); w0.w = cvtpk(pv[6], pv[7]);
            w1.x = cvtpk(pv[8], pv[9]); w1.y = cvtpk(pv[10], pv[11]); w1.z = cvtpk(pv[12], pv[13]); w1.w = cvtpk(pv[14], pv[15]);
            pf[kt][0] = __builtin_bit_cast(bf16x8, w0); pf[kt][1] = __builtin_bit_cast(bf16x8, w1);
        }
#pragma unroll
        for (int c = 0; c < 4; ++c)
#pragma unroll
            for (int ksx = 0; ksx < 4; ++ksx) {
                const s16x4 v0 = __builtin_bit_cast(s16x4, __builtin_amdgcn_ds_read_tr16_b64_v4i16((LAS v4i16_t*)(vb + vof0[c] + 4096u * ksx)));
                const s16x4 v1 = __builtin_bit_cast(s16x4, __builtin_amdgcn_ds_read_tr16_b64_v4i16((LAS v4i16_t*)(vb + vof1[c] + 4096u * ksx)));
                const bf16x8 vf = {v0[0], v0[1], v0[2], v0[3], v1[0], v1[1], v1[2], v1[3]};
                obr[c] = mfma32(vf, pf[ksx >> 1][ksx & 1], obr[c]);
            }
    }
    float l = l2.x + l2.y; l += shx<32>(l, lane);
    const float inv_l = l > 0.f ? 1.0f / l : 0.f, coef = gate * inv_l;
    f32x4 ybv[4][4];
    if (MODE >= 1) {
#pragma unroll
        for (int c = 0; c < 4; ++c)
#pragma unroll
            for (int gi = 0; gi < 4; ++gi) ybv[c][gi] = *(const GAS f32x4*)(yb + 32 * c + 8 * gi + 4 * hh);
    }
    if (BR == BR_CMP) {
        float iv[32];
#pragma unroll
        for (int G = 0; G < 32; ++G) iv[G] = imp_row[2 * G + hh];
#pragma unroll
        for (int G = 0; G < 32; ++G) imp_row[2 * G + hh] = iv[G] * inv_l;
    }
    __builtin_amdgcn_sched_barrier(0);
#pragma unroll
    for (int c = 0; c < 4; ++c)
#pragma unroll
        for (int gi = 0; gi < 4; ++gi) { const int e = 32 * c + 8 * gi + 4 * hh;
            f32x4 v = (f32x4){obr[c][4 * gi], obr[c][4 * gi + 1], obr[c][4 * gi + 2], obr[c][4 * gi + 3]} * coef;
            if (MODE >= 1) v = v + ybv[c][gi];
            if (MODE <= 1) *(GAS f32x4*)(yb + e) = v;
            else { v2u o; o.x = pk2(v[0], v[1]); o.y = pk2(v[2], v[3]); *(GAS v2u*)(outp + e) = o; } }
}

__device__ __forceinline__ void attn_shifts(const float* qn, const float* kcn, const float* ksn, const float* kwn, float& shc, float& shs, float& shw) {
    const int lane = lane_now();
    float mq = fmaxf(fabsf(qn[lane]), fabsf(qn[lane + 64])), mc = fmaxf(fabsf(kcn[lane]), fabsf(kcn[lane + 64])), ms = fmaxf(fabsf(ksn[lane]), fabsf(ksn[lane + 64])), mw = fmaxf(fabsf(kwn[lane]), fabsf(kwn[lane + 64]));
#define AT_MX(O) do { mq = fmaxf(mq, shx<O>(mq, lane)); mc = fmaxf(mc, shx<O>(mc, lane)); ms = fmaxf(ms, shx<O>(ms, lane)); mw = fmaxf(mw, shx<O>(mw, lane)); } while (0)
    AT_MX(1); AT_MX(2); AT_MX(4); AT_MX(8); AT_MX(16); AT_MX(32);
#undef AT_MX
    const float k0 = 128.0f * AT_SC * 1.02f * mq;
    shc = __builtin_bit_cast(float, __builtin_amdgcn_readfirstlane(__builtin_bit_cast(int, k0 * mc))); shs = __builtin_bit_cast(float, __builtin_amdgcn_readfirstlane(__builtin_bit_cast(int, k0 * ms)));
    shw = __builtin_bit_cast(float, __builtin_amdgcn_readfirstlane(__builtin_bit_cast(int, k0 * mw)));
}

__device__ __forceinline__ void attn_unit(const Ctx& F0, int b, int kv, int qb, const bf16* p, bf16* mix, const bf16* kc, const bf16* vc, const float* gate_b, const float* ctab, const float* stab, float* ybuf, float shc, float shs, float shw) {
    Ctx F = F0; { int w_ = F0.wave; asm volatile("" : "+s"(w_)); F.wave = w_; F.lane = lane_now(); F.tid = 64 * w_ + F.lane; }
    const int tid = F.tid, lane = F.lane, w = F.wave, g = w >> 1, hh = lane >> 5, qq = 32 * (w & 1) + (lane & 31), t = 64 * qb + qq, head = kv * 4 + g;
    const size_t row = (size_t)b * T + t;
    LAS float* IMP = (LAS float*)(F.lds + AT_IMP); LAS unsigned long long* SELM = (LAS unsigned long long*)(F.lds + AT_SELM);
    bf16x8 qc[8];
    { const bf16* qp = p + row * LDP + C_NQ + head * 128 + 8 * hh;
#pragma unroll
        for (int s = 0; s < 8; ++s) qc[s] = __builtin_bit_cast(bf16x8, *(const GAS v4u*)(qp + 16 * s)); }
    float gt[3];
#pragma unroll
    for (int j = 0; j < 3; ++j) gt[j] = sigmoidf_(bf2f(p[row * LDP + C_NGATE + head * 3 + j]) + gate_b[head * 3 + j]);
    LAS float* imp_row = IMP + (g * 64 + qq) * 64;
    if (qb >= 16) {
#pragma unroll
        for (int i = 0; i < 32; ++i) imp_row[32 * hh + i] = 0.f; }
    float* yb = ybuf + row * 1024 + head * 128;
    bf16* outp = mix + row * D + MIX_B + head * 128;
    AT_LDS_BAR();
    { const TileSrc ks{kc + (size_t)(b * 2 + kv) * NCMP_PAD * 128, 128}, vs{vc + (size_t)(b * 2 + kv) * NCMP_PAD * 128, 128};
        const int ncmp = (4 * qb + 2) / 64 + 1;
        attn_branch<BR_CMP, 0, 2>(F, ks, vs, 0, ncmp, qc, t, gt[0], shc, 0ull, yb, outp, imp_row); }
    unsigned long long selmask = 0xFFFFull;
    if (qb >= 16) {
    AT_LDS_BAR();
    { LAS unsigned* KEYS = (LAS unsigned*)(F.lds) + w * 512;
        unsigned mykey[8];
#pragma unroll
        for (int qi = 0; qi < 8; ++qi) { const int q = 8 * w + qi;
            float v = ((IMP[(0 * 64 + q) * 64 + lane] + IMP[(1 * 64 + q) * 64 + lane]) + IMP[(2 * 64 + q) * 64 + lane]) + IMP[(3 * 64 + q) * 64 + lane];
            const bool forced = lane == 0 || lane == qb || lane == qb - 1, valid = lane <= qb;
            v = forced ? 1e30f : (valid ? v : -1e30f);
            const unsigned u = __builtin_bit_cast(unsigned, v), k = (u & 0x80000000u) ? ~u : (u | 0x80000000u);
            mykey[qi] = (k & ~63u) | (unsigned)(63 - lane);
            KEYS[qi * 64 + lane] = mykey[qi]; }
        asm volatile("s_waitcnt lgkmcnt(0)" ::: "memory");
#pragma unroll
        for (int qi = 0; qi < 8; ++qi) { int cnt = 0;
#pragma unroll
            for (int g4 = 0; g4 < 4; ++g4) { if (16 * g4 > qb) break;
                v4u kk[4];
#pragma unroll
                for (int i = 0; i < 4; ++i) kk[i] = *(const LAS v4u*)(KEYS + qi * 64 + 16 * g4 + 4 * i);
                __builtin_amdgcn_sched_barrier(0);
#pragma unroll
                for (int i = 0; i < 4; ++i) cnt += (kk[i].x > mykey[qi] ? 1 : 0) + (kk[i].y > mykey[qi] ? 1 : 0) + (kk[i].z > mykey[qi] ? 1 : 0) + (kk[i].w > mykey[qi] ? 1 : 0); }
            const unsigned long long msk = __ballot(cnt < 16);
            if (lane == 0) SELM[8 * w + qi] = msk; } }
    AT_LDS_BAR();
    selmask = SELM[qq]; }
    bf16x8 qr[8];
#pragma unroll
    for (int s = 2; s < 8; ++s) qr[s] = qc[s];
    { const GAS f32x4* cp = (const GAS f32x4*)(ctab + t * 16 + 8 * hh); const GAS f32x4* sp = (const GAS f32x4*)(stab + t * 16 + 8 * hh);
        const f32x4 c0 = cp[0], c1 = cp[1], s0 = sp[0], s1 = sp[1];
        const float cs[8] = {c0.x, c0.y, c0.z, c0.w, c1.x, c1.y, c1.z, c1.w}, sn[8] = {s0.x, s0.y, s0.z, s0.w, s1.x, s1.y, s1.z, s1.w};
        bf16x8 r0, r1;
#pragma unroll
        for (int j = 0; j < 8; ++j) { const float x1 = bf2f((bf16)qc[0][j]), x2 = bf2f((bf16)qc[1][j]);
            r0[j] = (short)f2bf(x1 * cs[j] - x2 * sn[j]); r1[j] = (short)f2bf(x2 * cs[j] + x1 * sn[j]); }
        qr[0] = r0; qr[1] = r1; }
    { const TileSrc ks{p + (size_t)b * T * LDP + C_NKS + kv * 128, LDP}, vs{p + (size_t)b * T * LDP + C_NVS + kv * 128, LDP};
        attn_branch<BR_SEL, 1, 4>(F, ks, vs, 0, qb + 1, qr, t, gt[1], shs, selmask, yb, outp, imp_row); }
    { const TileSrc ks{p + (size_t)b * T * LDP + C_NKW + kv * 128, LDP}, vs{p + (size_t)b * T * LDP + C_NVW + kv * 128, LDP};
        attn_branch<BR_WIN, 2, 4>(F, ks, vs, qb >= 8 ? qb - 8 : 0, qb + 1, qr, t, gt[2], shw, 0ull, yb, outp, imp_row); }
}
constexpr int PH_PER_LAYER = 12, N_PHASES = 1 + DEPTH * PH_PER_LAYER;
#ifndef MK_ONE_LAUNCH
#define MK_ONE_LAUNCH 1
#endif
struct Args { const float* in[N_IN]; float* out; unsigned char* ws; int ph_lo, ph_hi; };
static_assert(sizeof(Args) == N_IN * 8 + 8 + 8 + 8, "Args has no padding bytes");

__global__ void __launch_bounds__(NWAVES * 64, 2) nsa_fwd(Args args) {
    extern __shared__ __attribute__((aligned(16))) unsigned char lds_raw[];
    Ctx F;
    F.lds = (LAS unsigned char*)lds_raw;
    F.tid = threadIdx.x; F.lane = 0  ; F.wave = __builtin_amdgcn_readfirstlane(F.tid >> 6);
    F.G = gridDim.x; { const int bx = blockIdx.x; F.vcu = (F.G % 8 == 0) ? (bx % 8) * (F.G / 8) + bx / 8 : bx; }
    F.ws = args.ws; F.ctl = (gu32*)(args.ws + WS_CTL);
    volatile LAS unsigned* MISC = (volatile LAS unsigned*)(F.lds + MISC_OFF);
    for (int u = F.tid; u < (LDS_BYTES - LDSCTL_OFF) / 4; u += NWAVES * 64) ((LAS unsigned*)(F.lds + LDSCTL_OFF))[u] = 0u;
    __syncthreads();
    XcdBarrier bar; bar.bar = (unsigned*)(F.ctl + CW_BAR); bar.x = 0; bar.st = nullptr;
    if (MK_ONE_LAUNCH) bar = xcd_barrier_post((unsigned*)(F.ctl + CW_BAR), MISC + 8);
    bar.wave = F.wave;
    F.tid = -1;
    const int lo = args.ph_lo, hi = args.ph_hi;
#ifndef PH_MASK
#define PH_MASK 0xFFFF
#endif
#define EN(j) (((PH_MASK) >> (j)) & 1)
#ifndef PH_DOUBLE
#define PH_DOUBLE 0
#endif
#define NREP(j) ((((PH_DOUBLE) >> (j)) & 1) ? 2 : 1)
#define IN(k) (lo <= (k) && (k) < hi)
#define SEAM(k) do { if (IN(k) && IN((k) + 1)) xcd_barrier(bar); } while (0)

    bf16* const HN = (bf16*)(F.ws + WS_HN); bf16* const HP = (bf16*)(F.ws + WS_HP); bf16* const MIX = (bf16*)(F.ws + WS_MIX);
    bf16* const KC = (bf16*)(F.ws + WS_KC); bf16* const VC = (bf16*)(F.ws + WS_VC);
    const float* const ctab = (const float*)(F.ws + WS_ROPE); const float* const stab = ctab + T * 16;
    bf16* const XB = (bf16*)(F.ws + WS_XB);

    if (EN(0) && IN(0)) for (int rep = 0; rep < NREP(0); ++rep) { if (rep) xcd_barrier(bar); p0_ffn_strips(F, args.in); p0_prologue(F, args.in); }
    SEAM(0);

    for (int l = 0; l < DEPTH; ++l) {
        const int pb = 1 + l * PH_PER_LAYER;
        if (pb + PH_PER_LAYER <= lo || pb >= hi) continue;
        const void* xin = (l == 0) ? (const void*)args.in[I_X] : (const void*)XB; const bool xin_f32 = (l == 0);
        if (EN(1) && IN(pb + 0)) for (int rep = 0; rep < NREP(1); ++rep) { if (rep) xcd_barrier(bar); rmsnorm_q8_phase(F, xin, xin_f32, args.in[I_F1N] + (size_t)l * D, (unsigned char*)HN, (float*)(F.ws + WS_SA), xin_f32 ? XB : nullptr); }
        SEAM(pb + 0);
        if (EN(2) && IN(pb + 1)) for (int rep = 0; rep < NREP(2); ++rep) { if (rep) xcd_barrier(bar); pg8::Gemm g{HN, (const bf16*)(F.ws + WS_WGU + (size_t)(l * 2 + 0) * SZ_WGU8), M, 2 * DFF, D / 2}; pg8::StaticOrder S; S.init(M, 2 * DFF, F.G, (int)blockIdx.x);
            pg8::EpiSwiGLU8 E{HP, DFF, (const float*)(F.ws + WS_SA), (const float*)(F.ctl + CW_CMAX) + (size_t)(l * 2 + 0) * 2 * DFF};
            pg8::gemm_phase<pg8::EpiSwiGLU8, pg8::StaticOrder, true, true>(F.lds, g, S, E, F.wave * 64 + lane_now()); }
        SEAM(pb + 1);
        if (EN(3) && IN(pb + 2)) {
            hidden_q8_phase(F, HP, F.ws + WS_HQ2, (float*)(F.ws + WS_SA2));
            xcd_barrier(bar);
            pg8::Gemm g{(const bf16*)(F.ws + WS_HQ2), (const bf16*)(F.ws + WS_WD + (size_t)(l * 2 + 0) * SZ_WD8), M, D, DFF / 2}; pg8::StaticOrder S; S.init(M, D, F.G, (int)blockIdx.x);
            pg8::EpiResid8 E{XB, XB, D, 0.5f, (const float*)(F.ws + WS_SA2), (const float*)(F.ctl + CW_CMAX2) + (size_t)(l * 2 + 0) * D, false, false};
            pg8::gemm_phase<pg8::EpiResid8, pg8::StaticOrder, true, true>(F.lds, g, S, E, F.wave * 64 + lane_now()); }
        SEAM(pb + 2);
        if (EN(4) && IN(pb + 3)) for (int rep = 0; rep < NREP(4); ++rep) { if (rep) xcd_barrier(bar); rmsnorm_q8_phase(F, XB, false, args.in[I_MIXN] + (size_t)l * D, (unsigned char*)HN, (float*)(F.ws + WS_SA)); }
        SEAM(pb + 3);
        if (EN(5) && IN(pb + 4)) for (int rep = 0; rep < NREP(5); ++rep) { if (rep) xcd_barrier(bar); pg8::Gemm g{HN, (const bf16*)(F.ws + WS_WIN + (size_t)l * SZ_WIN8), M, LDP, D / 2}; pg8::StaticOrder S; S.init(M, LDP, F.G, (int)blockIdx.x);
            pg8::EpiBf16Plain8 E{HP, LDP, (const float*)(F.ws + WS_SA), (const float*)(F.ctl + CW_CMAX3) + (size_t)l * LDP};
            pg8::gemm_phase<pg8::EpiBf16Plain8, pg8::StaticOrder, true, true>(F.lds, g, S, E, F.wave * 64 + lane_now()); }
        SEAM(pb + 4);
        if (EN(6) && IN(pb + 5)) {
            qknorm_rows(F, HP, args.in[I_QN] + l * 128, args.in[I_KSN] + l * 128, args.in[I_KWN] + l * 128, ctab, stab);
            compress_items(F, HP, args.in[I_PEK] + (size_t)l * 4096, args.in[I_PEV] + (size_t)l * 4096, (const bf16*)(F.ws + WS_W1 + (size_t)l * 2 * SZ_W1), (const bf16*)(F.ws + WS_W2 + (size_t)l * 2 * SZ_W2),
                           args.in[I_KCN] + l * 128, KC, VC);
        }
        SEAM(pb + 5);
        if (EN(7) && IN(pb + 6)) for (int rep = 0; rep < NREP(7); ++rep) { if (rep) xcd_barrier(bar);
            const int bid = blockIdx.x;
#ifndef MIX_PARTS
#define MIX_PARTS 7
#endif
#ifndef MIX_REP2
#define MIX_REP2 7
#endif
#define MIXP (rep ? (MIX_REP2) : (MIX_PARTS))
            if ((MIXP & 1) && bid < 64) lru_unit(F, bid >> 3, bid & 7, HP, MIX, args.in[I_CONVW] + (size_t)l * 4 * 512, args.in[I_CONVB] + l * 512, args.in[I_GAW] + (size_t)l * 8 * 4096, args.in[I_GAB] + l * 512,
                                   args.in[I_GXW] + (size_t)l * 8 * 4096, args.in[I_GXB] + l * 512, args.in[I_LAM] + l * 512);
            else if ((MIXP & 2) && bid < 96) gla_unit(F, (bid - 64) >> 2, (bid - 64) & 3, HP, MIX, args.in[I_AW2] + (size_t)l * 16 * 256, args.in[I_AB] + l * 256, args.in[I_GLAN] + l * 128);
            AT_LDS_BAR();
            const unsigned myq = xb_xcc_id() & 7u;
            float shc, shs, shw; attn_shifts(args.in[I_QN] + l * 128, args.in[I_KCN] + l * 128, args.in[I_KSN] + l * 128, args.in[I_KWN] + l * 128, shc, shs, shw);
            for (;;) {
                if (F.wave == 0 && lane_now() == 0) { int got = -1;
                    for (unsigned a = 0; a < 8u && got < 0; ++a) { const unsigned qx = (myq + a) & 7u;
                        const unsigned j = __hip_atomic_fetch_add(F.ctl + CW_QUEUE + 32 * ((l + DEPTH * rep) * 8 + qx), 1u, RLX_AGENT);
                        if (j < 128u) got = (int)(((2u * qx + (j & 1u)) << 8) | (63u - (j >> 1))); }
                    MISC[0] = (unsigned)got; }
                AT_LDS_BAR();
                const int it = (int)MISC[0];
                AT_LDS_BAR();
                if (it < 0) break;
                if (MIXP & 4) attn_unit(F, (it >> 8) >> 1, (it >> 8) & 1, it & 255, HP, MIX, KC, VC, args.in[I_GATEB] + l * 24, ctab, stab, (float*)HN, shc, shs, shw);
            }
        }
        SEAM(pb + 6);
        if (EN(8) && IN(pb + 7)) outnorm_phase(F, MIX, args.in[I_LRUN] + l * 512, args.in[I_NSAN] + l * 1024);
        SEAM(pb + 7);
        if (EN(9) && IN(pb + 8)) for (int rep = 0; rep < NREP(9); ++rep) { if (rep) xcd_barrier(bar); pg8::Gemm g{MIX, (const bf16*)(F.ws + WS_WOUT + (size_t)l * SZ_WOUT), M, D, D}; pg8::StaticOrder S; S.init(M, D, F.G, (int)blockIdx.x);
            pg8::EpiResid E{XB, XB, D, rep ? 0.f : 1.0f};
            pg8::gemm_phase<pg8::EpiResid, pg8::StaticOrder, true, true>(F.lds, g, S, E, F.wave * 64 + lane_now()); }
        SEAM(pb + 8);
        if (EN(10) && IN(pb + 9)) for (int rep = 0; rep < NREP(10); ++rep) { if (rep) xcd_barrier(bar); rmsnorm_q8_phase(F, XB, false, args.in[I_F2N] + (size_t)l * D, (unsigned char*)HN, (float*)(F.ws + WS_SA)); }
        SEAM(pb + 9);
        if (EN(11) && IN(pb + 10)) for (int rep = 0; rep < NREP(11); ++rep) { if (rep) xcd_barrier(bar); pg8::Gemm g{HN, (const bf16*)(F.ws + WS_WGU + (size_t)(l * 2 + 1) * SZ_WGU8), M, 2 * DFF, D / 2}; pg8::StaticOrder S; S.init(M, 2 * DFF, F.G, (int)blockIdx.x);
            pg8::EpiSwiGLU8 E{HP, DFF, (const float*)(F.ws + WS_SA), (const float*)(F.ctl + CW_CMAX) + (size_t)(l * 2 + 1) * 2 * DFF};
            pg8::gemm_phase<pg8::EpiSwiGLU8, pg8::StaticOrder, true, true>(F.lds, g, S, E, F.wave * 64 + lane_now()); }
        SEAM(pb + 10);
        if (EN(12) && IN(pb + 11)) {
            hidden_q8_phase(F, HP, F.ws + WS_HQ2, (float*)(F.ws + WS_SA2));
            xcd_barrier(bar);
            pg8::Gemm g{(const bf16*)(F.ws + WS_HQ2), (const bf16*)(F.ws + WS_WD + (size_t)(l * 2 + 1) * SZ_WD8), M, D, DFF / 2}; pg8::StaticOrder S; S.init(M, D, F.G, (int)blockIdx.x);
            const bool last = (l + 1 == DEPTH);
            pg8::EpiResid8 E{XB, last ? (void*)args.out : (void*)XB, D, 0.5f, (const float*)(F.ws + WS_SA2), (const float*)(F.ctl + CW_CMAX2) + (size_t)(l * 2 + 1) * D, false, last};
            pg8::gemm_phase<pg8::EpiResid8, pg8::StaticOrder, true, true>(F.lds, g, S, E, F.wave * 64 + lane_now()); }
        SEAM(pb + 11);
    }
#undef IN
#undef SEAM
}

extern "C" void kernel_launch(void* const* d_in, const int* in_sizes, int n_in, void* d_out, int out_size, void* d_ws, size_t ws_size, hipStream_t stream) {
    static int grid = 0;
    if (grid == 0) {
        if (n_in != N_IN || in_sizes[0] != M * D || out_size != M * D || ws_size < WS_END) {
            fprintf(stderr, "kernel_launch: built for %d inputs, x/out of %d floats, >= %zu bytes of workspace; got n_in %d, in0 %d, out %d, ws %zu; nothing launched\n", N_IN, M * D, (size_t)WS_END, n_in, n_in > 0 ? in_sizes[0] : -1, out_size, ws_size);
            grid = -1; return; }
        int dev = 0, cus = 0, per_cu = 0;
        if (hipGetDevice(&dev) != hipSuccess || hipDeviceGetAttribute(&cus, hipDeviceAttributeMultiprocessorCount, dev) != hipSuccess) { fprintf(stderr, "kernel_launch: device query failed\n"); grid = -1; return; }
        if (hipFuncSetAttribute((const void*)nsa_fwd, hipFuncAttributeMaxDynamicSharedMemorySize, LDS_BYTES) != hipSuccess) { fprintf(stderr, "kernel_launch: hipFuncSetAttribute failed\n"); grid = -1; return; }
        if (hipOccupancyMaxActiveBlocksPerMultiprocessor(&per_cu, (const void*)nsa_fwd, NWAVES * 64, LDS_BYTES) != hipSuccess || per_cu < 1)
            fprintf(stderr, "kernel_launch: note: occupancy query reports %d workgroups per CU\n", per_cu);
        (void)hipGetLastError();
        grid = cus;
    }
    if (grid < 0) return;
    if (hipMemsetAsync((char*)d_ws + WS_CTL, 0, CTL_ZERO_BYTES, stream) != hipSuccess) { fprintf(stderr, "kernel_launch: memset failed\n"); return; }
    Args a{};
    for (int i = 0; i < N_IN; ++i) a.in[i] = (const float*)d_in[i];
    a.out = (float*)d_out; a.ws = (unsigned char*)d_ws;
#if MK_ONE_LAUNCH
    a.ph_lo = 0; a.ph_hi = N_PHASES;
    hipLaunchKernelGGL(nsa_fwd, dim3(grid), dim3(NWAVES * 64), LDS_BYTES, stream, a);
#else
    for (int ph = 0; ph < N_PHASES; ++ph) { a.ph_lo = ph; a.ph_hi = ph + 1; hipLaunchKernelGGL(nsa_fwd, dim3(grid), dim3(NWAVES * 64), LDS_BYTES, stream, a); }
#endif
    const hipError_t le = hipPeekAtLastError();
    if (le != hipSuccess) fprintf(stderr, "kernel_launch: launch failed: %s\n", hipGetErrorName(le));
}
```

```cpp
#include <hip/hip_runtime.h>
#include <cstdio>
#include <cstdint>
namespace pg8 {
#define PG8_LAS __attribute__((address_space(3)))
typedef unsigned short bf16_t;
typedef short bf16x8 __attribute__((ext_vector_type(8)));
typedef float f32x4 __attribute__((ext_vector_type(4)));
typedef unsigned u32x4 __attribute__((ext_vector_type(4)));
constexpr int BM = 256, BK = 64, HALF = 128, HTB = HALF * BK * 2  , STAGE_BYTES = 8 * HTB, NXCD = 8, WGM = 8;

__host__ __device__ __forceinline__ int lds_byte(int r, int c) { const int st = (r >> 4) * 2 + (c >> 5), rr = r & 15, cc = c & 31, ob = rr * 64 + cc * 2; return st * 1024 + (ob ^ (((ob >> 9) & 1) << 5)); }
__host__ __device__ __forceinline__ void stage_rc(int b, int& R, int& C) { const int st = b / 1024, sb = b % 1024, swz = sb ^ (((sb >> 9) & 1) << 5); R = (st >> 1) * 16 + swz / 64; C = (st & 1) * 32 + (swz % 64) / 2; }
__host__ __device__ __forceinline__ int perm32(int rho) { const int n = rho >> 4, i = rho & 15; return 8 * (i >> 2) + 4 * n + (i & 3); }

struct Unit { int pm, pn; };
struct Gemm { const bf16_t* A; const bf16_t* Bt; int M, N, K; };

struct StaticOrder {
    int nM, nN, nwg, G, c;
    __host__ __device__ void init(int M, int N, int G_, int c_) { nM = M / BM; nN = N / BM; nwg = nM * nN; G = G_; c = c_; }
    __host__ __device__ bool next(int i, Unit& u) const {
        const long L = (long)i * G + c; if (L >= nwg) return false;
        int wgid = (int)L; { const int q = nwg / NXCD, r = nwg % NXCD, xcd = wgid % NXCD, off = wgid / NXCD; wgid = (xcd < r ? xcd * (q + 1) : r * (q + 1) + (xcd - r) * q) + off; }
        const int nig = WGM * nN, gid = wgid / nig, fm = gid * WGM, gsz = (nM - fm) < WGM ? (nM - fm) : WGM;
        u.pm = fm + ((wgid % nig) % gsz); u.pn = (wgid % nig) / gsz; return true;
    }
    __device__ __forceinline__ void a_ready(const Unit&) const {}
    __device__ __forceinline__ void done(const Unit&) const {}
};

typedef float f32x2n __attribute__((ext_vector_type(2))); typedef __bf16 bf16x2n __attribute__((ext_vector_type(2)));
__device__ __forceinline__ unsigned cvt_pk_bf16(float lo, float hi) { const f32x2n v = {lo, hi}; return __builtin_bit_cast(unsigned, __builtin_convertvector(v, bf16x2n)); }
typedef float f32x2 __attribute__((ext_vector_type(2)));
typedef int i32x4 __attribute__((ext_vector_type(4)));
__device__ __forceinline__ f32x4 mma_frag(bf16x8 b, bf16x8 a, f32x4 c) { return __builtin_amdgcn_mfma_f32_16x16x32_bf16(b, a, c, 0, 0, 0); }
__device__ __forceinline__ i32x4 mma_frag(bf16x8 b, bf16x8 a, i32x4 c) { return __builtin_amdgcn_mfma_i32_16x16x64_i8(__builtin_bit_cast(i32x4, b), __builtin_bit_cast(i32x4, a), c, 0, 0, 0); }
#ifdef NOISE_P
#ifndef NOISE_P_COLS
#define NOISE_P_COLS(c) true
#endif
__device__ __forceinline__ float nzp(float v, unsigned row, unsigned col) { unsigned x = row * 5376u + col; x ^= x >> 16; x *= 0x7feb352du; x ^= x >> 15; x *= 0x846ca68bu; x ^= x >> 16;
        return v + ((float)x * 2.3283064e-10f * 2.0f - 1.0f) * (1.7320508f * NOISE_P); }
#endif
struct EpiBf16Plain {
    static constexpr bool PERM = true, AFTER_DRAIN = false; typedef f32x4 acc_t;
    bf16_t* O; int ldc;
    __device__ __forceinline__ void operator()(const f32x4 (&acc)[2][2][4][2], const Unit& u, int wr, int wc, int fr, int fq) const {
        const int row0 = u.pm * BM + wr * 64 + fr, col0 = u.pn * BM + wc * 32 + 8 * fq;
#pragma unroll
        for (int ai = 0; ai < 2; ++ai)
#pragma unroll
            for (int m = 0; m < 4; ++m) { bf16_t* rowp = O + (size_t)(row0 + ai * HALF + m * 16) * ldc + col0;
#pragma unroll
                for (int bj = 0; bj < 2; ++bj) { f32x4 v0 = acc[ai][bj][m][0], v1 = acc[ai][bj][m][1];
#ifdef NOISE_P
                    { const unsigned rr = row0 + ai * HALF + m * 16, cc = col0 + bj * HALF;
                      if (NOISE_P_COLS(cc))
#pragma unroll
                      for (int j = 0; j < 4; ++j) { v0[j] = nzp(v0[j], rr, cc + j); v1[j] = nzp(v1[j], rr, cc + 4 + j); } }
#endif
                    u32x4 w; w.x = cvt_pk_bf16(v0[0], v0[1]); w.y = cvt_pk_bf16(v0[2], v0[3]); w.z = cvt_pk_bf16(v1[0], v1[1]); w.w = cvt_pk_bf16(v1[2], v1[3]);
                    *(u32x4*)(rowp + bj * HALF) = w; } }
    }
};
struct EpiBf16Plain8 {
    static constexpr bool PERM = true, AFTER_DRAIN = false; typedef i32x4 acc_t;
    bf16_t* O; int ldc; const float* sa; const float* sw;
    __device__ __forceinline__ void operator()(const i32x4 (&acc)[2][2][4][2], const Unit& u, int wr, int wc, int fr, int fq) const {
        const int row0 = u.pm * BM + wr * 64 + fr, col0 = u.pn * BM + wc * 32 + 8 * fq;
        f32x4 cw[2][2];
#pragma unroll
        for (int bj = 0; bj < 2; ++bj) { cw[bj][0] = *(const f32x4*)(sw + col0 + bj * HALF); cw[bj][1] = *(const f32x4*)(sw + col0 + bj * HALF + 4); }
        float rav[2][4];
#pragma unroll
        for (int ai = 0; ai < 2; ++ai)
#pragma unroll
            for (int m = 0; m < 4; ++m) rav[ai][m] = sa[row0 + ai * HALF + m * 16];
        __builtin_amdgcn_sched_barrier(0);
#pragma unroll
        for (int ai = 0; ai < 2; ++ai)
#pragma unroll
            for (int m = 0; m < 4; ++m) rav[ai][m] *= (1.0f / 127.0f);
#pragma unroll
        for (int ai = 0; ai < 2; ++ai)
#pragma unroll
            for (int m = 0; m < 4; ++m) { const int row = row0 + ai * HALF + m * 16; bf16_t* rowp = O + (size_t)row * ldc + col0; const float ra = rav[ai][m];
#pragma unroll
                for (int bj = 0; bj < 2; ++bj) { const f32x4 v0 = __builtin_convertvector(acc[ai][bj][m][0], f32x4) * (cw[bj][0] * ra), v1 = __builtin_convertvector(acc[ai][bj][m][1], f32x4) * (cw[bj][1] * ra);
                    u32x4 w; w.x = cvt_pk_bf16(v0[0], v0[1]); w.y = cvt_pk_bf16(v0[2], v0[3]); w.z = cvt_pk_bf16(v1[0], v1[1]); w.w = cvt_pk_bf16(v1[2], v1[3]);
                    *(u32x4*)(rowp + bj * HALF) = w; } }
    }
};
struct EpiSwiGLU {
    static constexpr bool PERM = true, AFTER_DRAIN = false; typedef f32x4 acc_t;
    bf16_t* O; int ldc;
    static __device__ __forceinline__ float sg(float g, float up) { const float e = __builtin_amdgcn_exp2f(g * -1.44269504089f); return g * __builtin_amdgcn_rcpf(1.0f + e) * up; }
#ifdef NOISE_PROBE
    static __device__ __forceinline__ float nz(float v, unsigned row, unsigned col) { unsigned x = row * 5632u + col; x ^= x >> 16; x *= 0x7feb352du; x ^= x >> 15; x *= 0x846ca68bu; x ^= x >> 16;
        return v * (1.0f + ((float)x * 2.3283064e-10f * 2.0f - 1.0f) * (1.7320508f * NOISE_PROBE)); }
#endif
    __device__ __forceinline__ void operator()(const f32x4 (&acc)[2][2][4][2], const Unit& u, int wr, int wc, int fr, int fq) const {
        const int row0 = u.pm * BM + wr * 64 + fr, col0 = u.pn * HALF + wc * 32 + 8 * fq;
#pragma unroll
        for (int ai = 0; ai < 2; ++ai)
#pragma unroll
            for (int m = 0; m < 4; ++m) { bf16_t* rowp = O + (size_t)(row0 + ai * HALF + m * 16) * ldc + col0;
                const f32x4 g0 = acc[ai][0][m][0], g1 = acc[ai][0][m][1], u0 = acc[ai][1][m][0], u1 = acc[ai][1][m][1];
#ifdef NOISE_PROBE
                const unsigned rr = row0 + ai * HALF + m * 16; float hv[8];
#pragma unroll
                for (int j = 0; j < 4; ++j) { hv[j] = nz(sg(g0[j], u0[j]), rr, col0 + j); hv[4 + j] = nz(sg(g1[j], u1[j]), rr, col0 + 4 + j); }
                u32x4 w; w.x = cvt_pk_bf16(hv[0], hv[1]); w.y = cvt_pk_bf16(hv[2], hv[3]); w.z = cvt_pk_bf16(hv[4], hv[5]); w.w = cvt_pk_bf16(hv[6], hv[7]);
#else
                u32x4 w; w.x = cvt_pk_bf16(sg(g0[0], u0[0]), sg(g0[1], u0[1])); w.y = cvt_pk_bf16(sg(g0[2], u0[2]), sg(g0[3], u0[3]));
                w.z = cvt_pk_bf16(sg(g1[0], u1[0]), sg(g1[1], u1[1])); w.w = cvt_pk_bf16(sg(g1[2], u1[2]), sg(g1[3], u1[3]));
#endif
                *(u32x4*)rowp = w; }
    }
};
typedef unsigned u32x2_t __attribute__((ext_vector_type(2)));
__device__ __forceinline__ f32x4 res_load(const void* base, bool f32, size_t idx) {
    if (f32) return *(const f32x4*)((const float*)base + idx);
    const u32x2_t w = *(const u32x2_t*)((const bf16_t*)base + idx);
    return (f32x4){__builtin_bit_cast(float, w.x << 16), __builtin_bit_cast(float, w.x & 0xffff0000u), __builtin_bit_cast(float, w.y << 16), __builtin_bit_cast(float, w.y & 0xffff0000u)}; }
__device__ __forceinline__ void res_store(void* out, bool f32, size_t idx, f32x4 v) {
    if (f32) { *(f32x4*)((float*)out + idx) = v; return; }
    u32x2_t w; w.x = cvt_pk_bf16(v[0], v[1]); w.y = cvt_pk_bf16(v[2], v[3]); *(u32x2_t*)((bf16_t*)out + idx) = w; }
struct EpiSwiGLU8 {
    static constexpr bool PERM = true, AFTER_DRAIN = false; typedef i32x4 acc_t;
    bf16_t* O; int ldc; const float* sa; const float* sw;
    __device__ __forceinline__ void operator()(const i32x4 (&acc)[2][2][4][2], const Unit& u, int wr, int wc, int fr, int fq) const {
        const int row0 = u.pm * BM + wr * 64 + fr, col0 = u.pn * HALF + wc * 32 + 8 * fq, wrow0 = u.pn * BM + wc * 32 + 8 * fq;
        f32x4 sg0 = *(const f32x4*)(sw + wrow0), sg1 = *(const f32x4*)(sw + wrow0 + 4), su0 = *(const f32x4*)(sw + wrow0 + HALF), su1 = *(const f32x4*)(sw + wrow0 + HALF + 4);
        float rav[2][4];
#pragma unroll
        for (int ai = 0; ai < 2; ++ai)
#pragma unroll
            for (int m = 0; m < 4; ++m) rav[ai][m] = sa[row0 + ai * HALF + m * 16];
        __builtin_amdgcn_sched_barrier(0);
        f32x4 af[2][2][4][2];
#pragma unroll
        for (int ai = 0; ai < 2; ++ai)
#pragma unroll
            for (int bj = 0; bj < 2; ++bj)
#pragma unroll
                for (int m = 0; m < 4; ++m)
#pragma unroll
                    for (int n = 0; n < 2; ++n) af[ai][bj][m][n] = __builtin_convertvector(acc[ai][bj][m][n], f32x4);
        __builtin_amdgcn_sched_barrier(0);
        sg0 *= 1.44269504089f; sg1 *= 1.44269504089f; su0 *= 0.69314718056f; su1 *= 0.69314718056f;
#pragma unroll
        for (int ai = 0; ai < 2; ++ai)
#pragma unroll
            for (int m = 0; m < 4; ++m) rav[ai][m] *= (1.0f / 127.0f);
#pragma unroll
        for (int ai = 0; ai < 2; ++ai)
#pragma unroll
            for (int m = 0; m < 4; ++m) { const int row = row0 + ai * HALF + m * 16; bf16_t* rowp = O + (size_t)row * ldc + col0; const float ra = rav[ai][m];
                const f32x4 g0 = af[ai][0][m][0] * (sg0 * ra), g1 = af[ai][0][m][1] * (sg1 * ra), u0 = af[ai][1][m][0] * (su0 * ra), u1 = af[ai][1][m][1] * (su1 * ra);
                u32x4 w; w.x = cvt_pk_bf16(sg2(g0[0], u0[0]), sg2(g0[1], u0[1])); w.y = cvt_pk_bf16(sg2(g0[2], u0[2]), sg2(g0[3], u0[3]));
                w.z = cvt_pk_bf16(sg2(g1[0], u1[0]), sg2(g1[1], u1[1])); w.w = cvt_pk_bf16(sg2(g1[2], u1[2]), sg2(g1[3], u1[3]));
                *(u32x4*)rowp = w; }
    }
    static __device__ __forceinline__ float sg2(float gl, float ul) { return gl * __builtin_amdgcn_rcpf(1.0f + __builtin_amdgcn_exp2f(-gl)) * ul; }
};
struct EpiResid8 {
    static constexpr bool PERM = false, AFTER_DRAIN = false; typedef i32x4 acc_t;
    const void* base; void* out; int ldc; float scale; const float* sa; const float* sw; bool base_f32, out_f32;
    __device__ __forceinline__ void operator()(const i32x4 (&acc)[2][2][4][2], const Unit& u, int wr, int wc, int fr, int fq) const {
        const int row0 = u.pm * BM + wr * 64 + fr, col0 = u.pn * BM + wc * 32 + 4 * fq;
        float sc = scale * (1.0f / 127.0f); asm volatile("" : "+s"(sc));
        f32x4 cw[2][2];
#pragma unroll
        for (int bj = 0; bj < 2; ++bj)
#pragma unroll
            for (int n = 0; n < 2; ++n) cw[bj][n] = *(const f32x4*)(sw + col0 + bj * HALF + n * 16) * sc;
        float rav[2][4];
#pragma unroll
        for (int ai = 0; ai < 2; ++ai)
#pragma unroll
            for (int m = 0; m < 4; ++m) rav[ai][m] = sa[row0 + ai * HALF + m * 16];
        __builtin_amdgcn_sched_barrier(0);
#pragma unroll
        for (int ai = 0; ai < 2; ++ai)
#pragma unroll
            for (int mp = 0; mp < 2; ++mp) {
                f32x4 bs[2][2][2]; float ra[2]; u32x2_t rw[2][2][2];
#pragma unroll
                for (int mm = 0; mm < 2; ++mm) { const int row = row0 + ai * HALF + (2 * mp + mm) * 16; const size_t off = (size_t)row * ldc + col0; ra[mm] = rav[ai][2 * mp + mm];
#pragma unroll
                    for (int bj = 0; bj < 2; ++bj)
#pragma unroll
                        for (int n = 0; n < 2; ++n) rw[mm][bj][n] = *(const u32x2_t*)((const bf16_t*)base + off + bj * HALF + n * 16); }
                __builtin_amdgcn_sched_barrier(0);
#pragma unroll
                for (int mm = 0; mm < 2; ++mm)
#pragma unroll
                    for (int bj = 0; bj < 2; ++bj)
#pragma unroll
                        for (int n = 0; n < 2; ++n) { const u32x2_t w = rw[mm][bj][n];
                            bs[mm][bj][n] = (f32x4){__builtin_bit_cast(float, w.x << 16), __builtin_bit_cast(float, w.x & 0xffff0000u), __builtin_bit_cast(float, w.y << 16), __builtin_bit_cast(float, w.y & 0xffff0000u)}; }
#pragma unroll
                for (int mm = 0; mm < 2; ++mm) { const int m = 2 * mp + mm; const size_t off = (size_t)(row0 + ai * HALF + m * 16) * ldc + col0;
#pragma unroll
                    for (int bj = 0; bj < 2; ++bj)
#pragma unroll
                        for (int n = 0; n < 2; ++n) res_store(out, out_f32, off + bj * HALF + n * 16, bs[mm][bj][n] + __builtin_convertvector(acc[ai][bj][m][n], f32x4) * (cw[bj][n] * ra[mm])); }
                asm volatile("" ::: "memory"); }
    }
};
struct EpiResid {
    static constexpr bool PERM = false, AFTER_DRAIN = false; typedef f32x4 acc_t;
    const void* base; void* out; int ldc; float scale;
    __device__ __forceinline__ void operator()(const f32x4 (&acc)[2][2][4][2], const Unit& u, int wr, int wc, int fr, int fq) const {
        const int row0 = u.pm * BM + wr * 64 + fr, col0 = u.pn * BM + wc * 32 + 4 * fq;
#pragma unroll
        for (int ai = 0; ai < 2; ++ai) {
            f32x4 bs[4][2][2];
#pragma unroll
            for (int m = 0; m < 4; ++m) { const size_t off = (size_t)(row0 + ai * HALF + m * 16) * ldc + col0;
#pragma unroll
                for (int bj = 0; bj < 2; ++bj)
#pragma unroll
                    for (int n = 0; n < 2; ++n) bs[m][bj][n] = res_load(base, false, off + bj * HALF + n * 16); }
#pragma unroll
            for (int m = 0; m < 4; ++m) { const size_t off = (size_t)(row0 + ai * HALF + m * 16) * ldc + col0;
#pragma unroll
                for (int bj = 0; bj < 2; ++bj)
#pragma unroll
                    for (int n = 0; n < 2; ++n) { f32x4 a = acc[ai][bj][m][n];
#ifdef NOISE_WOUT
                        { const unsigned rr = row0 + ai * HALF + m * 16, cc = col0 + bj * HALF + n * 16;
#pragma unroll
                          for (int j = 0; j < 4; ++j) { unsigned x = rr * 2048u + cc + j; x ^= x >> 16; x *= 0x7feb352du; x ^= x >> 15; x *= 0x846ca68bu; x ^= x >> 16; a[j] += ((float)x * 2.3283064e-10f * 2.0f - 1.0f) * (1.7320508f * NOISE_WOUT); } }
#endif
                        res_store(out, false, off + bj * HALF + n * 16, bs[m][bj][n] + a * scale); } }
            asm volatile("" ::: "memory"); }
    }
};
template <class Epi, class Sched, bool ALIGN_EPI = false, bool SP2 = false>
__device__ __forceinline__ void gemm_phase(PG8_LAS unsigned char* lds, const Gemm g, const Sched& S, const Epi& E, int tid_in) {
    int tid_ = tid_in; asm volatile("" : "+v"(tid_));
    const int tid = tid_, wid = __builtin_amdgcn_readfirstlane(tid >> 6), lane = tid & 63, wr = wid >> 2, wc = wid & 3, fr = lane & 15, fq = lane >> 4;
    const int K = g.K, nt = K / BK;
    unsigned voffA[2], voffB[2];
#pragma unroll
    for (int i = 0; i < 2; ++i) { int R, C; stage_rc(tid * 16 + i * 8192, R, C); const int Rb = Epi::PERM ? ((R & ~31) + perm32(R & 31)) : R;
        voffA[i] = (unsigned)(R * K + C) * 2u; voffB[i] = (unsigned)(Rb * K + C) * 2u; }
    const size_t kstep = (size_t)(BK * 2);
    const size_t hstep = (size_t)HALF * K * 2;
    const size_t tstep = 2 * hstep;
    const unsigned ldsw = (unsigned)wid * 1024u;
    const int aoff = lds_byte(wr * 64 + fr, fq * 8), boff = lds_byte(wc * 32 + fr, fq * 8);
#define PG8_SA(b, h) (((b) * 2 + (h)) * HTB)
#define PG8_SB(b, h) ((4 + (b) * 2 + (h)) * HTB)
#define PG8_STAGE(bufoff, gbase, voff) do { _Pragma("unroll") for (int _i = 0; _i < 2; ++_i) \
        __builtin_amdgcn_global_load_lds((const unsigned*)((const char*)(gbase) + (voff)[_i]), (PG8_LAS unsigned*)(lds + (bufoff) + ldsw + _i * 8192), 16, 0, 0); } while (0)
#define PG8_LDA(dst, b, h) do { _Pragma("unroll") for (int m = 0; m < 4; ++m) _Pragma("unroll") for (int k = 0; k < 2; ++k) dst[m][k] = *(const PG8_LAS bf16x8*)(lds + PG8_SA(b, h) + aoff + m * 2048 + k * 1024); } while (0)
#define PG8_LDB(dst, b, h) do { _Pragma("unroll") for (int n = 0; n < 2; ++n) _Pragma("unroll") for (int k = 0; k < 2; ++k) dst[n][k] = *(const PG8_LAS bf16x8*)(lds + PG8_SB(b, h) + boff + n * 2048 + k * 1024); } while (0)
#define PG8_MMA(ai, bj, At, Bt) do { __builtin_amdgcn_s_setprio(1); _Pragma("unroll") for (int m = 0; m < 4; ++m) _Pragma("unroll") for (int n = 0; n < 2; ++n) _Pragma("unroll") for (int k = 0; k < 2; ++k) \
        acc[ai][bj][m][n] = mma_frag(Bt[n][k], At[m][k], acc[ai][bj][m][n]); __builtin_amdgcn_s_setprio(0); } while (0)
#define PG8_WAIT_V(n) asm volatile("s_waitcnt vmcnt(" #n ")" ::: "memory")
#define PG8_WAIT_L(n) asm volatile("s_waitcnt lgkmcnt(" #n ")" ::: "memory")
#define PG8_BAR __builtin_amdgcn_s_barrier()
#define PG8_SCHED __builtin_amdgcn_sched_barrier(0)
    Unit cur, nxt; int ui = 0;
    if (!S.next(0, cur)) return;
    typedef typename Epi::acc_t acc_t;
    acc_t acc[2][2][4][2];
#pragma unroll
    for (int a = 0; a < 2; ++a)
#pragma unroll
        for (int b = 0; b < 2; ++b)
#pragma unroll
            for (int m = 0; m < 4; ++m)
#pragma unroll
                for (int n = 0; n < 2; ++n) acc[a][b][m][n] = acc_t{};
    bf16x8 At[4][2], B0[2][2], B1[2][2];
    const char* cA = (const char*)g.A + (size_t)cur.pm * tstep; const char* cB = (const char*)g.Bt + (size_t)cur.pn * tstep;
    S.a_ready(cur);
    if constexpr (SP2) {
        PG8_STAGE(PG8_SB(0, 0), cB, voffB); PG8_STAGE(PG8_SB(0, 1), cB + hstep, voffB); PG8_STAGE(PG8_SA(0, 0), cA, voffA); PG8_STAGE(PG8_SA(0, 1), cA + hstep, voffA);
        if (wr == 1) PG8_BAR;
        PG8_WAIT_V(2); PG8_BAR;
        PG8_STAGE(PG8_SB(1, 0), cB + kstep, voffB); PG8_STAGE(PG8_SA(1, 0), cA + kstep, voffA); PG8_STAGE(PG8_SB(1, 1), cB + hstep + kstep, voffB);
        PG8_WAIT_V(6); PG8_BAR;
    } else {
        PG8_STAGE(PG8_SB(0, 0), cB, voffB); PG8_STAGE(PG8_SA(0, 0), cA, voffA); PG8_STAGE(PG8_SB(0, 1), cB + hstep, voffB); PG8_STAGE(PG8_SA(0, 1), cA + hstep, voffA);
        if (wr == 1) PG8_BAR;
        PG8_WAIT_V(4); PG8_BAR;
        PG8_STAGE(PG8_SB(1, 0), cB + kstep, voffB); PG8_STAGE(PG8_SA(1, 0), cA + kstep, voffA); PG8_STAGE(PG8_SB(1, 1), cB + hstep + kstep, voffB);
        PG8_WAIT_V(6); PG8_BAR;
    }
    for (;;) {
        const bool has_next = S.next(ui + 1, nxt);
        const char* nA = has_next ? (const char*)g.A + (size_t)nxt.pm * tstep : cA; const char* nB = has_next ? (const char*)g.Bt + (size_t)nxt.pn * tstep : cB;
        for (int t = 0; t < nt; t += 2) {
            const bool last = (t == nt - 2);
            const char* a1 = cA + (size_t)(t + 1) * kstep;
            const char* a2 = last ? nA : cA + (size_t)(t + 2) * kstep; const char* b2 = last ? nB : cB + (size_t)(t + 2) * kstep;
            const char* a3 = a2 + kstep; const char* b3 = b2 + kstep;
            if (last && has_next) S.a_ready(nxt);
            if constexpr (SP2) {
            PG8_LDB(B0, 0, 0); PG8_LDB(B1, 0, 1); PG8_SCHED; PG8_LDA(At, 0, 0); PG8_STAGE(PG8_SA(1, 1), a1 + hstep, voffA);
            PG8_WAIT_V(8); PG8_WAIT_L(0); PG8_BAR; PG8_MMA(0, 0, At, B0); PG8_MMA(0, 1, At, B1); PG8_BAR; PG8_SCHED;
            PG8_LDA(At, 0, 1); PG8_STAGE(PG8_SB(0, 0), b2, voffB); PG8_STAGE(PG8_SB(0, 1), b2 + hstep, voffB); PG8_STAGE(PG8_SA(0, 0), a2, voffA);
            PG8_WAIT_V(8); PG8_WAIT_L(0); PG8_BAR; PG8_MMA(1, 0, At, B0); PG8_MMA(1, 1, At, B1); PG8_BAR; PG8_SCHED;
            PG8_LDB(B0, 1, 0); PG8_LDB(B1, 1, 1); PG8_SCHED; PG8_LDA(At, 1, 0); PG8_STAGE(PG8_SA(0, 1), a2 + hstep, voffA);
            PG8_WAIT_V(8); PG8_WAIT_L(0); PG8_BAR; PG8_MMA(0, 0, At, B0); PG8_MMA(0, 1, At, B1); PG8_BAR; PG8_SCHED;
            PG8_LDA(At, 1, 1); PG8_STAGE(PG8_SB(1, 0), b3, voffB); PG8_STAGE(PG8_SB(1, 1), b3 + hstep, voffB); PG8_STAGE(PG8_SA(1, 0), a3, voffA);
            PG8_WAIT_V(8); PG8_WAIT_L(0); PG8_BAR; PG8_MMA(1, 0, At, B0); PG8_MMA(1, 1, At, B1); PG8_BAR; PG8_SCHED;
            } else {
            PG8_LDB(B0, 0, 0); PG8_SCHED; PG8_LDA(At, 0, 0); PG8_STAGE(PG8_SA(1, 1), a1 + hstep, voffA);
            PG8_WAIT_L(8); PG8_BAR; PG8_WAIT_L(0); PG8_MMA(0, 0, At, B0); PG8_BAR; PG8_SCHED;
            PG8_LDB(B1, 0, 1); PG8_STAGE(PG8_SB(0, 0), b2, voffB);
            PG8_BAR; PG8_WAIT_L(0); PG8_MMA(0, 1, At, B1); PG8_BAR;
            PG8_LDA(At, 0, 1); PG8_STAGE(PG8_SA(0, 0), a2, voffA);
            PG8_BAR; PG8_WAIT_L(0); PG8_MMA(1, 0, At, B0); PG8_BAR; PG8_SCHED;
            PG8_STAGE(PG8_SB(0, 1), b2 + hstep, voffB);
            PG8_WAIT_V(6); PG8_BAR; PG8_MMA(1, 1, At, B1); PG8_BAR;
            PG8_LDB(B0, 1, 0); PG8_SCHED; PG8_LDA(At, 1, 0); PG8_STAGE(PG8_SA(0, 1), a2 + hstep, voffA);
            PG8_WAIT_L(8); PG8_BAR; PG8_WAIT_L(0); PG8_MMA(0, 0, At, B0); PG8_BAR; PG8_SCHED;
            PG8_LDB(B1, 1, 1); PG8_STAGE(PG8_SB(1, 0), b3, voffB);
            PG8_BAR; PG8_WAIT_L(0); PG8_MMA(0, 1, At, B1); PG8_BAR;
            PG8_LDA(At, 1, 1); PG8_STAGE(PG8_SA(1, 0), a3, voffA);
            PG8_BAR; PG8_WAIT_L(0); PG8_MMA(1, 0, At, B0); PG8_BAR; PG8_SCHED;
            PG8_STAGE(PG8_SB(1, 1), b3 + hstep, voffB);
            PG8_WAIT_V(6); PG8_BAR; PG8_MMA(1, 1, At, B1); PG8_BAR;
            }
        }
        if constexpr (ALIGN_EPI) { if (wr == 0) PG8_BAR; }
        if constexpr (!Epi::AFTER_DRAIN) { E(acc, cur, wr, wc, fr, fq); S.done(cur); }
        if (!has_next) break;
#pragma unroll
        for (int a = 0; a < 2; ++a)
#pragma unroll
            for (int b = 0; b < 2; ++b)
#pragma unroll
                for (int m = 0; m < 4; ++m)
#pragma unroll
                    for (int n = 0; n < 2; ++n) acc[a][b][m][n] = acc_t{};
        cur = nxt; cA = nA; cB = nB; ++ui;
        if constexpr (ALIGN_EPI) { if (wr == 1) PG8_BAR; }
    }
    PG8_WAIT_V(0);
    if constexpr (!ALIGN_EPI) { if (wr == 0) PG8_BAR; }
    PG8_BAR;
    if constexpr (Epi::AFTER_DRAIN) { E.fused(acc, cur, wr, wc, fr, fq, lds, wid, lane); S.done(cur); }
#undef PG8_SA
#undef PG8_SB
#undef PG8_STAGE
#undef PG8_LDA
#undef PG8_LDB
#undef PG8_MMA
#undef PG8_WAIT_V
#undef PG8_WAIT_L
#undef PG8_BAR
#undef PG8_SCHED
}
}
constexpr int NWAVES = 8;
constexpr int BATCH = 8, T = 4096, D = 2048, M = BATCH * T, DFF = 5632, DEPTH = 4;
constexpr int DIN = 5160, LDP = 5376;
constexpr float NORM_EPS = 1e-6f;
constexpr int C_LRUX = 0, C_LRUY = 512, C_NQ = 1024, C_NKC = 2048, C_NVC = 2304, C_NKS = 2560, C_NVS = 2816, C_NKW = 3072, C_NVW = 3328,
              C_GQ = 3584, C_GK = 3840, C_GV = 4096, C_GG = 4608, C_NGATE = 5120, C_GA = 5144;
constexpr int MIX_A = 0, MIX_B = 512, MIX_C = 1536;
constexpr int NCMP = 255, NCMP_PAD = 256;
enum { I_X = 0, I_F1N, I_F1G, I_F1U, I_F1D, I_MIXN, I_WIN, I_CONVW, I_CONVB, I_GAW, I_GAB, I_GXW, I_GXB, I_LAM, I_LRUN, I_QN, I_KCN, I_KSN, I_KWN,
       I_PEK, I_W1K, I_W2K, I_PEV, I_W1V, I_W2V, I_GATEB, I_NSAN, I_AW2, I_AB, I_GLAN, I_WOUT, I_F2N, I_F2G, I_F2U, I_F2D, N_IN };

constexpr size_t MiB = 1u << 20;
constexpr size_t WS_CTL = 0, CTL_ZERO_BYTES = 1 * MiB;
constexpr size_t WS_ROPE = 1 * MiB;
constexpr size_t SZ_WGU = (size_t)2 * DFF * D * 2, SZ_WD = (size_t)D * DFF * 2, SZ_WIN = (size_t)LDP * D * 2, SZ_WOUT = (size_t)D * D * 2,
                 SZ_W1 = (size_t)128 * 4096 * 2, SZ_W2 = (size_t)128 * 128 * 2;
constexpr size_t WS_WGU = 2 * MiB;
constexpr size_t WS_WD = WS_WGU + (size_t)DEPTH * 2 * (SZ_WGU / 2);
constexpr size_t WS_WIN = WS_WD + (size_t)DEPTH * 2 * (SZ_WD / 2);
constexpr size_t WS_WOUT = WS_WIN + (size_t)DEPTH * SZ_WIN;
constexpr size_t WS_W1 = WS_WOUT + (size_t)DEPTH * SZ_WOUT;
constexpr size_t WS_W2 = WS_W1 + (size_t)DEPTH * 2 * SZ_W1;
constexpr size_t WS_HN = ((WS_W2 + (size_t)DEPTH * 2 * SZ_W2 + MiB - 1) / MiB) * MiB;
constexpr size_t WS_HP = WS_HN + (size_t)M * D * 2;
constexpr size_t WS_MIX = WS_HP + (size_t)M * DFF * 2;
constexpr size_t WS_KC = WS_MIX + (size_t)M * D * 2;
constexpr size_t WS_VC = WS_KC + (size_t)BATCH * 2 * NCMP_PAD * 128 * 2;
constexpr size_t WS_SA = WS_VC + (size_t)BATCH * 2 * NCMP_PAD * 128 * 2;
constexpr size_t WS_SA2 = WS_SA + (size_t)M * 4;
constexpr size_t WS_HQ2 = ((WS_SA2 + (size_t)M * 4 + MiB - 1) / MiB) * MiB;
constexpr size_t WS_XB = WS_HQ2 + (size_t)M * DFF;
constexpr size_t WS_END = WS_XB + (size_t)M * D * 2;
static_assert((size_t)M * LDP * 2 <= (size_t)M * DFF * 2, "p fits in the hidden buffer");
constexpr int CW_TMO = 0, CW_QUEUE = 64  , CW_BAR = 4096;
constexpr int CW_CMAX = 32768;
constexpr int CW_CMAX2 = CW_CMAX + DEPTH * 2 * 2 * DFF;
constexpr int CW_CMAX3 = CW_CMAX2 + DEPTH * 2 * D;
constexpr size_t SZ_WGU8 = (size_t)2 * DFF * D, SZ_WD8 = (size_t)D * DFF, SZ_WIN8 = (size_t)LDP * D;
static_assert((CW_CMAX3 + DEPTH * LDP) * 4 <= (int)CTL_ZERO_BYTES, "CMAX inside the zeroed region");

constexpr int RING_BYTES = 131072;
constexpr int LDS_BYTES = 147456;
constexpr int LDSCTL_OFF = LDS_BYTES - 512, MISC_OFF = LDSCTL_OFF;

#define GAS __attribute__((address_space(1)))
#define LAS __attribute__((address_space(3)))
typedef unsigned short bf16;
typedef unsigned v4u __attribute__((ext_vector_type(4)));
typedef unsigned v2u __attribute__((ext_vector_type(2)));
typedef float f32x4 __attribute__((ext_vector_type(4)));
typedef float f32x16 __attribute__((ext_vector_type(16)));
typedef short bf16x8 __attribute__((ext_vector_type(8)));
typedef short s16x4 __attribute__((ext_vector_type(4)));
typedef GAS unsigned gu32;
#define RLX_AGENT __ATOMIC_RELAXED, __HIP_MEMORY_SCOPE_AGENT
#define LDS_WAIT() asm volatile("s_waitcnt lgkmcnt(0)" ::: "memory")
#define VM_WAIT() asm volatile("s_waitcnt vmcnt(0)" ::: "memory")
__device__ __forceinline__ unsigned f2bf(float f) { unsigned u = __builtin_bit_cast(unsigned, f); return (u + 0x7fffu + ((u >> 16) & 1u)) >> 16; }
__device__ __forceinline__ unsigned pk2(float lo, float hi) { return f2bf(lo) | (f2bf(hi) << 16); }
__device__ __forceinline__ float bflo(unsigned w) { return __builtin_bit_cast(float, w << 16); }
__device__ __forceinline__ float bfhi(unsigned w) { return __builtin_bit_cast(float, w & 0xffff0000u); }
__device__ __forceinline__ float bf2f(bf16 b) { return __builtin_bit_cast(float, (unsigned)b << 16); }
__device__ __forceinline__ int lane_now() { unsigned ones = ~0u; asm volatile("" : "+s"(ones)); return (int)__builtin_amdgcn_mbcnt_hi(ones, __builtin_amdgcn_mbcnt_lo(ones, 0u)); }
template <int O> __device__ __forceinline__ float shx(float x, int lane) {
    if (O < 32) return __builtin_bit_cast(float, __builtin_amdgcn_ds_swizzle(__builtin_bit_cast(int, x), (O << 10) | 0x1f));
    return __builtin_bit_cast(float, __builtin_amdgcn_ds_bpermute((lane ^ 32) << 2, __builtin_bit_cast(int, x)));
}
__device__ __forceinline__ float wave_sum(float v, int lane) {
    v += shx<1>(v, lane); v += shx<2>(v, lane); v += shx<4>(v, lane); v += shx<8>(v, lane); v += shx<16>(v, lane); v += shx<32>(v, lane);
    return v;
}
__device__ __forceinline__ float sigmoidf_(float z) { return __builtin_amdgcn_rcpf(1.0f + __builtin_amdgcn_exp2f(z * -1.44269504089f)); }
__device__ __forceinline__ float gelu_tanh(float x) {
    const float u2 = 1.5957691216f * (x + 0.044715f * x * x * x);
    return x * sigmoidf_(u2);
}
__device__ __forceinline__ f32x4 mfma16(bf16x8 a, bf16x8 b, f32x4 c) { return __builtin_amdgcn_mfma_f32_16x16x32_bf16(a, b, c, 0, 0, 0); }
__device__ __forceinline__ f32x16 mfma32(bf16x8 a, bf16x8 b, f32x16 c) { return __builtin_amdgcn_mfma_f32_32x32x16_bf16(a, b, c, 0, 0, 0); }
#define XB_TMO      128
#define XB_XCNT(j)  (256  + 64 * (j))
#define XB_XSUB(j)  (1280 + 64 * (j))
#define XB_XGEN(j)  (2304 + 64 * (j))
#define XB_TOP      3328
#define XB_TOPGEN   3392
#define XCD_BAR_WORDS 3456
#define XB_SPIN_CAP (1u << 18)

__device__ __forceinline__ unsigned xb_ld(unsigned* p)              { return __hip_atomic_load(p, __ATOMIC_RELAXED, __HIP_MEMORY_SCOPE_AGENT); }
__device__ __forceinline__ unsigned xb_add(unsigned* p, unsigned v) { return __hip_atomic_fetch_add(p, v, __ATOMIC_RELAXED, __HIP_MEMORY_SCOPE_AGENT); }
__device__ __forceinline__ unsigned xb_xcc_id() { return (unsigned)__builtin_amdgcn_s_getreg((3 << 11) | 20) & 0xFu; }
#define XB_SPIN(cond, bar) do { unsigned _sp = 0; while (cond) { __builtin_amdgcn_s_sleep(1); \
    if ((++_sp & 255u) == 0u) { if (xb_ld(&(bar)[XB_TMO])) break; if (_sp > XB_SPIN_CAP) { atomicAdd(&(bar)[XB_TMO], 1u); break; } } } } while (0)

struct XcdBarrier {
    int wave;
    unsigned* bar; unsigned x;
    volatile LAS unsigned* st;
};

__device__ __forceinline__ XcdBarrier xcd_barrier_post(unsigned* bar, volatile LAS unsigned* st) {
    XcdBarrier b; b.bar = bar; b.x = xb_xcc_id(); b.st = st;
    if (threadIdx.x == 0) (void)xb_add(&bar[XB_XCNT(b.x)], 1u);
    return b;
}
__device__ __forceinline__ void xcd_barrier_complete(unsigned* bar, unsigned x, unsigned& nloc, unsigned& nx) {
    const unsigned G = gridDim.x * gridDim.y * gridDim.z;
    unsigned sum, cnt, mine, sp = 0u;
    for (;;) {
        sum = 0u; cnt = 0u; mine = 0u;
#pragma unroll
        for (unsigned j = 0; j < 16; ++j) { const unsigned c = xb_ld(&bar[XB_XCNT(j)]); sum += c; cnt += (c > 0u) ? 1u : 0u; mine = (j == x) ? c : mine; }
        if (sum == G) break;
        __builtin_amdgcn_s_sleep(1);
        if ((++sp & 255u) == 0u) { if (xb_ld(&bar[XB_TMO])) break; if (sp > XB_SPIN_CAP) { atomicAdd(&bar[XB_TMO], 1u); break; } }
    }
    nloc = mine > 0u ? mine : 1u; nx = cnt > 0u ? cnt : 1u;
}

__device__ __forceinline__ void xcd_barrier(const XcdBarrier& b) {
    asm volatile("s_waitcnt vmcnt(0)" ::: "memory");
    __syncthreads();
    if (b.wave == 0 && lane_now() == 0) {
        unsigned* bar = b.bar;
        __builtin_amdgcn_s_waitcnt(0);
        unsigned nloc = b.st[0], nx = b.st[1];
        if (nloc == 0u) { xcd_barrier_complete(bar, b.x, nloc, nx); b.st[0] = nloc; b.st[1] = nx; }
        const unsigned old = xb_add(&bar[XB_XSUB(b.x)], 1u);
        const unsigned gen = old / nloc;
        if (old + 1u == (gen + 1u) * nloc) {
            __builtin_amdgcn_fence(__ATOMIC_RELEASE, "agent");
            asm volatile("s_waitcnt vmcnt(0)" ::: "memory");
            const unsigned og = xb_add(&bar[XB_TOP], 1u);
            const unsigned tg = og / nx;
            if (og + 1u == (tg + 1u) * nx) xb_add(&bar[XB_TOPGEN], 1u);
            else XB_SPIN(xb_ld(&bar[XB_TOPGEN]) == tg, bar);
            __builtin_amdgcn_fence(__ATOMIC_ACQUIRE, "agent");
            xb_add(&bar[XB_XGEN(b.x)], 1u);
            asm volatile("s_waitcnt vmcnt(0)" ::: "memory");
        } else {
            XB_SPIN(xb_ld(&bar[XB_XGEN(b.x)]) == gen, bar);
            __builtin_amdgcn_fence(__ATOMIC_ACQUIRE, "agent");
            asm volatile("s_waitcnt vmcnt(0)" ::: "memory");
        }
    }
    __syncthreads();
}
struct Ctx {
    LAS unsigned char* lds;
    gu32* ctl;
    unsigned char* ws;
    int tid, lane, wave, vcu, G;
};

struct RowMapRt { int kind; __device__ __forceinline__ int operator()(int n) const {
    if (kind == 1) return ((n >> 7) << 8) + (n & 127);
    if (kind == 2) return ((n >> 7) << 8) + 128 + (n & 127);
    if (kind == 3) return n < 3584 ? n : (n < 3608 ? n + (C_NGATE - 3584) : (n < 5144 ? n - 24 : n));
    return n; } };
__device__ __forceinline__ void transpose_item(const float* W, int K, int N, bf16* WT, RowMapRt rm, LAS float* scr, int item, int lane, const unsigned* cmax  ) {
    const int nblk = (N + 31) >> 5, kb = item / nblk, nb = item - kb * nblk, k0 = 64 * kb, n0 = 32 * nb;
    const int n4 = 4 * (lane & 7), kr = lane >> 3;
    f32x4 v[8];
#pragma unroll
    for (int i = 0; i < 8; ++i) v[i] = (n0 + n4 < N) ? *(const GAS f32x4*)(W + (size_t)(k0 + kr + 8 * i) * N + n0 + n4) : (f32x4){0.f, 0.f, 0.f, 0.f};
#pragma unroll
    for (int i = 0; i < 8; ++i) { LAS float* d = scr + (kr + 8 * i) * 33 + n4; d[0] = v[i].x; d[1] = v[i].y; d[2] = v[i].z; d[3] = v[i].w; }
    LDS_WAIT(); asm volatile("" ::: "memory");
    const int c = lane & 7;
#pragma unroll
    for (int j = 0; j < 4; ++j) { const int nl = (lane >> 3) + 8 * j; const LAS float* s = scr + (8 * c) * 33 + nl;
        if (n0 + nl < N) {
            if (cmax) { const int row = rm(n0 + nl); const float cm = __builtin_bit_cast(float, cmax[row]), inv = cm > 0.f ? 127.0f / cm : 0.f;
                int q[8];
#pragma unroll
                for (int i = 0; i < 8; ++i) q[i] = (int)__builtin_rintf(s[i * 33] * inv) & 0xff;
                v2u o; o.x = (unsigned)(q[0] | (q[1] << 8) | (q[2] << 16) | (q[3] << 24)); o.y = (unsigned)(q[4] | (q[5] << 8) | (q[6] << 16) | (q[7] << 24));
                *(GAS v2u*)((unsigned char*)WT + (size_t)row * K + k0 + 8 * c) = o; }
            else { v4u o; o.x = pk2(s[0 * 33], s[1 * 33]); o.y = pk2(s[2 * 33], s[3 * 33]); o.z = pk2(s[4 * 33], s[5 * 33]); o.w = pk2(s[6 * 33], s[7 * 33]);
                *(GAS v4u*)(WT + (size_t)rm(n0 + nl) * K + k0 + 8 * c) = o; } } }
    LDS_WAIT(); asm volatile("" ::: "memory");
}
constexpr int IT_FF = (D / 64) * (DFF / 32), IT_WIN = (D / 64) * ((DIN + 31) / 32), IT_WOUT = (D / 64) * (D / 32), IT_W1 = (4096 / 64) * (128 / 32), IT_W2 = (128 / 64) * (128 / 32);
constexpr int IT_LAYER = 6 * IT_FF + IT_WIN + IT_WOUT + 2 * IT_W1 + 2 * IT_W2, IT_REST = IT_WOUT + 2 * IT_W1 + 2 * IT_W2;
__device__ __forceinline__ void p0_strip_store(LAS float* scr, const f32x4 (&v)[8], unsigned char* WT, int K, int k0, const int (&row)[4], const float (&inv)[4], int lane) {
    const int n4 = 4 * (lane & 7), kr = lane >> 3, c = lane & 7;
#pragma unroll
    for (int i = 0; i < 8; ++i) { LAS float* d = scr + (kr + 8 * i) * 33 + n4; d[0] = v[i].x; d[1] = v[i].y; d[2] = v[i].z; d[3] = v[i].w; }
    LDS_WAIT(); asm volatile("" ::: "memory");
#pragma unroll
    for (int j = 0; j < 4; ++j) { const int nl = (lane >> 3) + 8 * j; const LAS float* s = scr + (8 * c) * 33 + nl;
        int q[8];
#pragma unroll
        for (int i = 0; i < 8; ++i) q[i] = (int)__builtin_rintf(s[i * 33] * inv[j]) & 0xff;
        v2u o; o.x = (unsigned)(q[0] | (q[1] << 8) | (q[2] << 16) | (q[3] << 24)); o.y = (unsigned)(q[4] | (q[5] << 8) | (q[6] << 16) | (q[7] << 24));
        if (row[j] >= 0) *(GAS v2u*)(WT + (size_t)row[j] * K + k0 + 8 * c) = o; }
    LDS_WAIT(); asm volatile("" ::: "memory");
}
__device__ __forceinline__ void p0_ffn_strips(const Ctx& F0, const float* const* in) {
    Ctx F = F0; { int w_ = F0.wave; asm volatile("" : "+s"(w_)); F.wave = w_; F.lane = lane_now(); F.tid = 64 * w_ + F.lane; }
    const int lane = F.lane, w = F.wave, n4 = 4 * (lane & 7), kr = lane >> 3;
    LAS float* scr = (LAS float*)(F.lds + w * 16384);
    LAS float* cmx = (LAS float*)(F.lds + 131072);
    for (int s = F.vcu; s < DEPTH * 4 * (DFF / 32); s += F.G) {
        const int m4 = s / (DFF / 32), nb = s - m4 * (DFF / 32), l = m4 >> 2, ffn = (m4 >> 1) & 1, which = m4 & 1, n0 = 32 * nb;
        const float* W = in[(ffn ? I_F2G : I_F1G) + which] + (size_t)l * D * DFF;
        unsigned char* WT = F.ws + WS_WGU + (size_t)(l * 2 + ffn) * SZ_WGU8;
        unsigned* cm = (unsigned*)(F.ctl + CW_CMAX) + (size_t)(l * 2 + ffn) * 2 * DFF;
        f32x4 v[4][8];
#pragma unroll
        for (int t = 0; t < 4; ++t)
#pragma unroll
            for (int i = 0; i < 8; ++i) v[t][i] = *(const GAS f32x4*)(W + (size_t)(256 * w + 64 * t + kr + 8 * i) * DFF + n0 + n4);
        float mx[4] = {0.f, 0.f, 0.f, 0.f};
#pragma unroll
        for (int t = 0; t < 4; ++t)
#pragma unroll
            for (int i = 0; i < 8; ++i) { mx[0] = fmaxf(mx[0], fabsf(v[t][i].x)); mx[1] = fmaxf(mx[1], fabsf(v[t][i].y)); mx[2] = fmaxf(mx[2], fabsf(v[t][i].z)); mx[3] = fmaxf(mx[3], fabsf(v[t][i].w)); }
#pragma unroll
        for (int c = 0; c < 4; ++c) { float x = mx[c]; x = fmaxf(x, shx<8>(x, lane)); x = fmaxf(x, shx<16>(x, lane)); x = fmaxf(x, shx<32>(x, lane)); mx[c] = x; }
        if (lane < 8) {
#pragma unroll
            for (int c = 0; c < 4; ++c) cmx[w * 32 + n4 + c] = mx[c]; }
        __syncthreads();
        int row[4]; float inv[4];
#pragma unroll
        for (int j = 0; j < 4; ++j) { const int nl = (lane >> 3) + 8 * j, n = n0 + nl; float m = cmx[nl];
#pragma unroll
            for (int ww = 1; ww < 8; ++ww) m = fmaxf(m, cmx[ww * 32 + nl]);
            row[j] = ((n >> 7) << 8) + (which ? 128 : 0) + (n & 127); inv[j] = m > 0.f ? 127.0f / m : 0.f;
            if (w == 0 && (lane & 7) == 0) cm[row[j]] = __builtin_bit_cast(unsigned, m); }
#pragma unroll
        for (int t = 0; t < 4; ++t) p0_strip_store(scr, v[t], WT, D, 256 * w + 64 * t, row, inv, lane);
        __syncthreads();
    }
    for (int s = F.vcu; s < DEPTH * ((DIN + 31) / 32); s += F.G) {
        const int l = s / ((DIN + 31) / 32), nb = s - l * ((DIN + 31) / 32), n0 = 32 * nb;
        const float* W = in[I_WIN] + (size_t)l * D * DIN;
        unsigned char* WT = F.ws + WS_WIN + (size_t)l * SZ_WIN8;
        unsigned* cm = (unsigned*)(F.ctl + CW_CMAX3) + (size_t)l * LDP;
        const bool inr = n0 + n4 < DIN;
        f32x4 v[4][8];
#pragma unroll
        for (int t = 0; t < 4; ++t)
#pragma unroll
            for (int i = 0; i < 8; ++i) v[t][i] = inr ? *(const GAS f32x4*)(W + (size_t)(256 * w + 64 * t + kr + 8 * i) * DIN + n0 + n4) : (f32x4){0.f, 0.f, 0.f, 0.f};
        float mx[4] = {0.f, 0.f, 0.f, 0.f};
#pragma unroll
        for (int t = 0; t < 4; ++t)
#pragma unroll
            for (int i = 0; i < 8; ++i) { mx[0] = fmaxf(mx[0], fabsf(v[t][i].x)); mx[1] = fmaxf(mx[1], fabsf(v[t][i].y)); mx[2] = fmaxf(mx[2], fabsf(v[t][i].z)); mx[3] = fmaxf(mx[3], fabsf(v[t][i].w)); }
#pragma unroll
        for (int c = 0; c < 4; ++c) { float x = mx[c]; x = fmaxf(x, shx<8>(x, lane)); x = fmaxf(x, shx<16>(x, lane)); x = fmaxf(x, shx<32>(x, lane)); mx[c] = x; }
        if (lane < 8) {
#pragma unroll
            for (int c = 0; c < 4; ++c) cmx[w * 32 + n4 + c] = mx[c]; }
        __syncthreads();
        int row[4]; float inv[4];
#pragma unroll
        for (int j = 0; j < 4; ++j) { const int nl = (lane >> 3) + 8 * j, n = n0 + nl; float m = cmx[nl];
#pragma unroll
            for (int ww = 1; ww < 8; ++ww) m = fmaxf(m, cmx[ww * 32 + nl]);
            row[j] = n < DIN ? RowMapRt{3}(n) : -1; inv[j] = m > 0.f ? 127.0f / m : 0.f;
            if (w == 0 && (lane & 7) == 0 && n < DIN) cm[row[j]] = __builtin_bit_cast(unsigned, m); }
#pragma unroll
        for (int t = 0; t < 4; ++t) p0_strip_store(scr, v[t], WT, D, 256 * w + 64 * t, row, inv, lane);
        __syncthreads();
    }
    for (int s = F.vcu; s < DEPTH * 2 * (D / 32); s += F.G) {
        const int m2 = s / (D / 32), nb = s - m2 * (D / 32), l = m2 >> 1, ffn = m2 & 1, n0 = 32 * nb;
        const float* W = in[ffn ? I_F2D : I_F1D] + (size_t)l * D * DFF;
        unsigned char* WT = F.ws + WS_WD + (size_t)(l * 2 + ffn) * SZ_WD8;
        unsigned* cm = (unsigned*)(F.ctl + CW_CMAX2) + (size_t)(l * 2 + ffn) * D;
        float mx[4] = {0.f, 0.f, 0.f, 0.f};
        for (int kb = w; kb < DFF / 64; kb += 8) {
#pragma unroll
            for (int i = 0; i < 8; ++i) { const f32x4 x = *(const GAS f32x4*)(W + (size_t)(64 * kb + kr + 8 * i) * D + n0 + n4);
                mx[0] = fmaxf(mx[0], fabsf(x.x)); mx[1] = fmaxf(mx[1], fabsf(x.y)); mx[2] = fmaxf(mx[2], fabsf(x.z)); mx[3] = fmaxf(mx[3], fabsf(x.w)); } }
#pragma unroll
        for (int c = 0; c < 4; ++c) { float x = mx[c]; x = fmaxf(x, shx<8>(x, lane)); x = fmaxf(x, shx<16>(x, lane)); x = fmaxf(x, shx<32>(x, lane)); mx[c] = x; }
        if (lane < 8) {
#pragma unroll
            for (int c = 0; c < 4; ++c) cmx[w * 32 + n4 + c] = mx[c]; }
        __syncthreads();
        int row[4]; float inv[4];
#pragma unroll
        for (int j = 0; j < 4; ++j) { const int nl = (lane >> 3) + 8 * j; float m = cmx[nl];
#pragma unroll
            for (int ww = 1; ww < 8; ++ww) m = fmaxf(m, cmx[ww * 32 + nl]);
            row[j] = n0 + nl; inv[j] = m > 0.f ? 127.0f / m : 0.f;
            if (w == 0 && (lane & 7) == 0) cm[row[j]] = __builtin_bit_cast(unsigned, m); }
        for (int kb = w; kb < DFF / 64; kb += 8) { f32x4 x[8];
#pragma unroll
            for (int i = 0; i < 8; ++i) x[i] = *(const GAS f32x4*)(W + (size_t)(64 * kb + kr + 8 * i) * D + n0 + n4);
            p0_strip_store(scr, x, WT, DFF, 64 * kb, row, inv, lane); }
        __syncthreads();
    }
}
__device__ __forceinline__ void p0_prologue(const Ctx& F0, const float* const* in) {
    Ctx F = F0; { int w_ = F0.wave; asm volatile("" : "+s"(w_)); F.wave = w_; F.lane = lane_now(); F.tid = 64 * w_ + F.lane; }
    LAS float* scr = (LAS float*)(F.lds + F.wave * 16384);
    const int gw = F.vcu * NWAVES + F.wave, NGW = F.G * NWAVES;
    for (int it = gw; it < DEPTH * IT_REST; it += NGW) {
        const int l = it / IT_REST; int r = it - l * IT_REST;
        const float* W; bf16* WT; int K, N, kind = 0; const unsigned* cmx = nullptr;
        if (r < IT_WOUT) { W = in[I_WOUT] + (size_t)l * D * D; K = D; N = D; WT = (bf16*)(F.ws + WS_WOUT + (size_t)l * SZ_WOUT); }
        else if ((r -= IT_WOUT) < 2 * IT_W1) { const int kv = r / IT_W1; r -= kv * IT_W1; W = in[kv ? I_W1V : I_W1K] + (size_t)l * 4096 * 128; K = 4096; N = 128; WT = (bf16*)(F.ws + WS_W1 + (size_t)(l * 2 + kv) * SZ_W1); }
        else { r -= 2 * IT_W1; const int kv = r / IT_W2; r -= kv * IT_W2; W = in[kv ? I_W2V : I_W2K] + (size_t)l * 128 * 128; K = 128; N = 128; WT = (bf16*)(F.ws + WS_W2 + (size_t)(l * 2 + kv) * SZ_W2); }
        transpose_item(W, K, N, WT, RowMapRt{kind}, scr, r, F.lane, cmx);
    }
    const int gt = (F.vcu * NWAVES + F.wave) * 64 + F.lane, NGT = NGW * 64;
    constexpr int PADCH = (LDP - DIN) * D / 16;
    for (int i = gt; i < DEPTH * PADCH; i += NGT) { const int l = i / PADCH, c = i - l * PADCH;
        *(GAS v4u*)(F.ws + WS_WIN + (size_t)l * SZ_WIN8 + (size_t)DIN * D + (size_t)c * 16) = (v4u){0u, 0u, 0u, 0u}; }
    float* ctab = (float*)(F.ws + WS_ROPE); float* stab = ctab + T * 16;
    for (int i = gt; i < T * 16; i += NGT) { const int t = i >> 4, k = i & 15;
        const double inv = exp2(-(double)k * (18.931568569324174 / 16.0));
        double rev = (double)t * inv * 0.15915494309189535;
        rev -= floor(rev); const float fr = (float)rev;
        ctab[i] = __builtin_amdgcn_cosf(fr); stab[i] = __builtin_amdgcn_sinf(fr); }
}

__device__ __forceinline__ void load_xrow(const void* x, bool x_f32, int m, int lane, f32x4 (&v)[8]) {
    if (x_f32) { const GAS f32x4* xr = (const GAS f32x4*)((const float*)x + (size_t)m * D) + lane;
#pragma unroll
        for (int j = 0; j < 8; ++j) v[j] = xr[64 * j]; }
    else { const GAS v2u* xr = (const GAS v2u*)((const bf16*)x + (size_t)m * D) + lane;
#pragma unroll
        for (int j = 0; j < 8; ++j) { const v2u w = xr[64 * j]; v[j] = (f32x4){bflo(w.x), bfhi(w.x), bflo(w.y), bfhi(w.y)}; } }
}
__device__ __forceinline__ void rmsnorm_phase(const Ctx& F0, const void* x, bool x_f32, const float* gain, bf16* out) {
    Ctx F = F0; { int w_ = F0.wave; asm volatile("" : "+s"(w_)); F.wave = w_; F.lane = lane_now(); F.tid = 64 * w_ + F.lane; }
    const int gw = F.vcu * NWAVES + F.wave, NGW = F.G * NWAVES;
    f32x4 g[8];
#pragma unroll
    for (int j = 0; j < 8; ++j) g[j] = ((const GAS f32x4*)gain + F.lane)[64 * j];
    for (int m = gw; m < M; m += NGW) {
        f32x4 v[8]; float s = 0.f;
        load_xrow(x, x_f32, m, F.lane, v);
#pragma unroll
        for (int j = 0; j < 8; ++j) s += (v[j].x * v[j].x + v[j].y * v[j].y) + (v[j].z * v[j].z + v[j].w * v[j].w);
        const float r = 1.0f / sqrtf(wave_sum(s, F.lane) * (1.f / D) + NORM_EPS);
        GAS v2u* o8 = (GAS v2u*)(out + (size_t)m * D) + F.lane;
#pragma unroll
        for (int j = 0; j < 8; ++j) { v2u w; w.x = pk2(v[j].x * r * g[j].x, v[j].y * r * g[j].y); w.y = pk2(v[j].z * r * g[j].z, v[j].w * r * g[j].w); o8[64 * j] = w; }
    }
}

__device__ __forceinline__ void rmsnorm_q8_phase(const Ctx& F0, const void* x, bool x_f32, const float* gain, unsigned char* out, float* sa, bf16* xb_copy = nullptr  ) {
    Ctx F = F0; { int w_ = F0.wave; asm volatile("" : "+s"(w_)); F.wave = w_; F.lane = lane_now(); F.tid = 64 * w_ + F.lane; }
    const int gw = F.vcu * NWAVES + F.wave, NGW = F.G * NWAVES, lane = F.lane;
    f32x4 g[8];
#pragma unroll
    for (int j = 0; j < 8; ++j) g[j] = ((const GAS f32x4*)gain + lane)[64 * j];
    for (int mi = gw; mi < M; mi += NGW) { const int m = M - 1 - mi;
        f32x4 v[8]; float s = 0.f;
        load_xrow(x, x_f32, m, lane, v);
        if (xb_copy) { GAS v2u* xo = (GAS v2u*)(xb_copy + (size_t)m * D) + lane;
#pragma unroll
            for (int j = 0; j < 8; ++j) { v2u w; w.x = pk2(v[j].x, v[j].y); w.y = pk2(v[j].z, v[j].w); xo[64 * j] = w; } }
#pragma unroll
        for (int j = 0; j < 8; ++j) s += (v[j].x * v[j].x + v[j].y * v[j].y) + (v[j].z * v[j].z + v[j].w * v[j].w);
        const float r = 1.0f / sqrtf(wave_sum(s, lane) * (1.f / D) + NORM_EPS);
        float am = 0.f;
#pragma unroll
        for (int j = 0; j < 8; ++j) { v[j] = v[j] * g[j] * r; am = fmaxf(am, fmaxf(fmaxf(fabsf(v[j].x), fabsf(v[j].y)), fmaxf(fabsf(v[j].z), fabsf(v[j].w)))); }
        am = fmaxf(am, shx<1>(am, lane)); am = fmaxf(am, shx<2>(am, lane)); am = fmaxf(am, shx<4>(am, lane)); am = fmaxf(am, shx<8>(am, lane)); am = fmaxf(am, shx<16>(am, lane)); am = fmaxf(am, shx<32>(am, lane));
        am = fmaxf(am, 1e-30f);
        const float inv = 127.0f / am;
        if (lane == 0) sa[m] = am * (1.0f / 127.0f);
        GAS unsigned* o4 = (GAS unsigned*)(out + (size_t)m * D) + lane;
#pragma unroll
        for (int j = 0; j < 8; ++j) { const int q0 = (int)__builtin_rintf(v[j].x * inv) & 0xff, q1 = (int)__builtin_rintf(v[j].y * inv) & 0xff, q2 = (int)__builtin_rintf(v[j].z * inv) & 0xff, q3 = (int)__builtin_rintf(v[j].w * inv) & 0xff;
            o4[64 * j] = (unsigned)(q0 | (q1 << 8) | (q2 << 16) | (q3 << 24)); }
    }
}

__device__ __forceinline__ void hidden_q8_phase(const Ctx& F0, const bf16* hid, unsigned char* out, float* sa) {
    Ctx F = F0; { int w_ = F0.wave; asm volatile("" : "+s"(w_)); F.wave = w_; F.lane = lane_now(); F.tid = 64 * w_ + F.lane; }
    const int gw = F.vcu * NWAVES + F.wave, NGW = F.G * NWAVES, lane = F.lane;
    for (int mi = gw; mi < M; mi += NGW) { const int m = M - 1 - mi;
        const GAS v4u* hr = (const GAS v4u*)(hid + (size_t)m * DFF) + lane;
        v4u raw[11]; float am = 0.f;
#pragma unroll
        for (int j = 0; j < 11; ++j) { raw[j] = hr[64 * j];
#pragma unroll
            for (int q = 0; q < 4; ++q) am = fmaxf(am, fmaxf(fabsf(bflo(raw[j][q])), fabsf(bfhi(raw[j][q])))); }
        am = fmaxf(am, shx<1>(am, lane)); am = fmaxf(am, shx<2>(am, lane)); am = fmaxf(am, shx<4>(am, lane)); am = fmaxf(am, shx<8>(am, lane)); am = fmaxf(am, shx<16>(am, lane)); am = fmaxf(am, shx<32>(am, lane));
        am = fmaxf(am, 1e-30f);
        const float inv = 127.0f / am;
        if (lane == 0) sa[m] = am * (1.0f / 127.0f);
        GAS v2u* o8 = (GAS v2u*)(out + (size_t)m * DFF) + lane;
#pragma unroll
        for (int j = 0; j < 11; ++j) { int q[8];
#pragma unroll
            for (int k = 0; k < 4; ++k) { q[2 * k] = (int)__builtin_rintf(bflo(raw[j][k]) * inv) & 0xff; q[2 * k + 1] = (int)__builtin_rintf(bfhi(raw[j][k]) * inv) & 0xff; }
            v2u o; o.x = (unsigned)(q[0] | (q[1] << 8) | (q[2] << 16) | (q[3] << 24)); o.y = (unsigned)(q[4] | (q[5] << 8) | (q[6] << 16) | (q[7] << 24)); o8[64 * j] = o; }
    }
}

__device__ __forceinline__ void outnorm_phase(const Ctx& F0, bf16* mix, const float* gain_a, const float* gain_b) {
    Ctx F = F0; { int w_ = F0.wave; asm volatile("" : "+s"(w_)); F.wave = w_; F.lane = lane_now(); F.tid = 64 * w_ + F.lane; }
    const int gw = F.vcu * NWAVES + F.wave, NGW = F.G * NWAVES, lane = F.lane;
    for (int mi = gw; mi < M; mi += NGW) { const int m = M - 1 - mi;
        GAS v4u* row = (GAS v4u*)(mix + (size_t)m * D);
        const v4u a = row[lane], b0 = row[64 + lane], b1 = row[128 + lane];
        float sa = 0.f, sb = 0.f;
#pragma unroll
        for (int j = 0; j < 4; ++j) { const float l0 = bflo(a[j]), h0 = bfhi(a[j]); sa += l0 * l0 + h0 * h0;
            const float l1 = bflo(b0[j]), h1 = bfhi(b0[j]), l2 = bflo(b1[j]), h2 = bfhi(b1[j]); sb += (l1 * l1 + h1 * h1) + (l2 * l2 + h2 * h2); }
        const float ra = 1.0f / sqrtf(wave_sum(sa, lane) * (1.f / 512.f) + NORM_EPS), rb = 1.0f / sqrtf(wave_sum(sb, lane) * (1.f / 1024.f) + NORM_EPS);
        const GAS f32x4* ga = (const GAS f32x4*)gain_a + 2 * lane; const GAS f32x4* gb0 = (const GAS f32x4*)gain_b + 2 * lane; const GAS f32x4* gb1 = gb0 + 128;
        v4u oa, ob0, ob1; const f32x4 g0 = ga[0], g1 = ga[1], h0 = gb0[0], h1 = gb0[1], k0 = gb1[0], k1 = gb1[1];
        oa.x = pk2(bflo(a.x) * ra * g0.x, bfhi(a.x) * ra * g0.y); oa.y = pk2(bflo(a.y) * ra * g0.z, bfhi(a.y) * ra * g0.w);
        oa.z = pk2(bflo(a.z) * ra * g1.x, bfhi(a.z) * ra * g1.y); oa.w = pk2(bflo(a.w) * ra * g1.z, bfhi(a.w) * ra * g1.w);
        ob0.x = pk2(bflo(b0.x) * rb * h0.x, bfhi(b0.x) * rb * h0.y); ob0.y = pk2(bflo(b0.y) * rb * h0.z, bfhi(b0.y) * rb * h0.w);
        ob0.z = pk2(bflo(b0.z) * rb * h1.x, bfhi(b0.z) * rb * h1.y); ob0.w = pk2(bflo(b0.w) * rb * h1.z, bfhi(b0.w) * rb * h1.w);
        ob1.x = pk2(bflo(b1.x) * rb * k0.x, bfhi(b1.x) * rb * k0.y); ob1.y = pk2(bflo(b1.y) * rb * k0.z, bfhi(b1.y) * rb * k0.w);
        ob1.z = pk2(bflo(b1.z) * rb * k1.x, bfhi(b1.z) * rb * k1.y); ob1.w = pk2(bflo(b1.w) * rb * k1.z, bfhi(b1.w) * rb * k1.w);
        row[lane] = oa; row[64 + lane] = ob0; row[128 + lane] = ob1;
    }
}
constexpr float QSCALE = 0.08838834764831845f * 1.4426950408889634f;
__device__ __forceinline__ void qknorm_rows(const Ctx& F0, bf16* p, const float* qn, const float* ksn, const float* kwn, const float* ctab, const float* stab) {
    Ctx F = F0; { int w_ = F0.wave; asm volatile("" : "+s"(w_)); F.wave = w_; F.lane = lane_now(); F.tid = 64 * w_ + F.lane; }
    const int gw = F.vcu * NWAVES + F.wave, NGW = F.G * NWAVES, lane = F.lane, l16 = lane & 15, grp = lane >> 4;
    int col[3]; float gg[3][8];
#pragma unroll
    for (int rnd = 0; rnd < 3; ++rnd) { const int hv = rnd * 4 + grp;
        col[rnd] = (hv < 8 ? C_NQ + hv * 128 : (hv < 10 ? C_NKS + (hv - 8) * 128 : C_NKW + (hv - 10) * 128)) + 8 * l16;
        const float* gp = hv < 8 ? qn : (hv < 10 ? ksn : kwn);
        const f32x4 g0 = *(const GAS f32x4*)(gp + 8 * l16), g1 = *(const GAS f32x4*)(gp + 8 * l16 + 4);
        gg[rnd][0] = g0.x; gg[rnd][1] = g0.y; gg[rnd][2] = g0.z; gg[rnd][3] = g0.w; gg[rnd][4] = g1.x; gg[rnd][5] = g1.y; gg[rnd][6] = g1.z; gg[rnd][7] = g1.w; }
    v4u cur[3], nxt[3];
    if (gw < M) {
#pragma unroll
        for (int rnd = 0; rnd < 3; ++rnd) cur[rnd] = *(const GAS v4u*)(p + (size_t)(M - 1 - gw) * LDP + col[rnd]); }
    for (int mi = gw; mi < M; mi += NGW) {
        const int m = M - 1 - mi, t = m & (T - 1);
        if (mi + NGW < M) {
#pragma unroll
            for (int rnd = 0; rnd < 3; ++rnd) nxt[rnd] = *(const GAS v4u*)(p + (size_t)(m - NGW) * LDP + col[rnd]); }
        f32x4 c0 = {0.f, 0.f, 0.f, 0.f}, c1 = c0, s0 = c0, s1 = c0;
        if (l16 < 4) { const GAS f32x4* cp = (const GAS f32x4*)(ctab + t * 16 + (l16 & 1) * 8); const GAS f32x4* sp = (const GAS f32x4*)(stab + t * 16 + (l16 & 1) * 8);
            c0 = cp[0]; c1 = cp[1]; s0 = sp[0]; s1 = sp[1]; }
#pragma unroll
        for (int rnd = 0; rnd < 3; ++rnd) {
            const v4u raw = cur[rnd];
            float v[8];
#pragma unroll
            for (int j = 0; j < 4; ++j) { v[2 * j] = bflo(raw[j]); v[2 * j + 1] = bfhi(raw[j]); }
            float ss = 0.f;
#pragma unroll
            for (int j = 0; j < 8; ++j) ss += v[j] * v[j];
            ss += shx<1>(ss, lane); ss += shx<2>(ss, lane); ss += shx<4>(ss, lane); ss += shx<8>(ss, lane);
            const float r = 1.0f / sqrtf(ss * (1.f / 128.f) + NORM_EPS);
            const float rs = rnd < 2 ? r * QSCALE : r;
#pragma unroll
            for (int j = 0; j < 8; ++j) v[j] *= rs * gg[rnd][j];
            float part[8];
#pragma unroll
            for (int j = 0; j < 8; ++j) part[j] = shx<2>(v[j], lane);
            if (rnd == 2 && l16 < 4) {
                const float cs[8] = {c0.x, c0.y, c0.z, c0.w, c1.x, c1.y, c1.z, c1.w}, sn[8] = {s0.x, s0.y, s0.z, s0.w, s1.x, s1.y, s1.z, s1.w};
#pragma unroll
                for (int j = 0; j < 8; ++j) v[j] = (l16 < 2) ? (v[j] * cs[j] - part[j] * sn[j]) : (v[j] * cs[j] + part[j] * sn[j]);
            }
            v4u o; o.x = pk2(v[0], v[1]); o.y = pk2(v[2], v[3]); o.z = pk2(v[4], v[5]); o.w = pk2(v[6], v[7]);
            *(GAS v4u*)(p + (size_t)m * LDP + col[rnd]) = o;
        }
#pragma unroll
        for (int rnd = 0; rnd < 3; ++rnd) cur[rnd] = nxt[rnd];
    }
}
__device__ __forceinline__ void compress_items(const Ctx& F0, const bf16* p, const float* pe_k, const float* pe_v, const bf16* w1t  , const bf16* w2t  ,
                                               const float* kcn, bf16* kc, bf16* vc) {
    Ctx F = F0; { int w_ = F0.wave; asm volatile("" : "+s"(w_)); F.wave = w_; F.lane = lane_now(); F.tid = 64 * w_ + F.lane; }
    const int lane = F.lane, r = lane & 15, quad = lane >> 4, w = F.wave;
    LAS f32x4* red = (LAS f32x4*)F.lds;
    for (int item = F.vcu; item < 256; item += F.G) {
        const int which = (item >> 7) & 1, b = (item >> 4) & 7, kv = (item >> 3) & 1, rt2 = item & 7;
        const bf16* src[2];
#pragma unroll
        for (int t2 = 0; t2 < 2; ++t2) { const int n = 32 * rt2 + 16 * t2 + r, nc = n < NCMP ? n : NCMP - 1;
            src[t2] = p + (size_t)(b * T + 16 * nc) * LDP + (which ? C_NVC : C_NKC) + kv * 128; }
        const float* pe = which ? pe_v : pe_k;
        const bf16* w1 = w1t + (size_t)which * 128 * 4096;
        f32x4 acc[2][8];
#pragma unroll
        for (int t2 = 0; t2 < 2; ++t2)
#pragma unroll
            for (int i = 0; i < 8; ++i) acc[t2][i] = (f32x4){0.f, 0.f, 0.f, 0.f};
        for (int s2 = 0; s2 < 8; ++s2) {
            v4u raw[2][2]; f32x4 pp[2][2]; v4u yb[2][8];
#pragma unroll
            for (int h = 0; h < 2; ++h) { const int k = 32 * (16 * w + 2 * s2 + h) + 8 * quad, j = k >> 7, d = k & 127;
                raw[h][0] = *(const GAS v4u*)(src[0] + (size_t)j * LDP + d); raw[h][1] = *(const GAS v4u*)(src[1] + (size_t)j * LDP + d);
                pp[h][0] = *(const GAS f32x4*)(pe + j * 128 + d); pp[h][1] = *(const GAS f32x4*)(pe + j * 128 + d + 4);
#pragma unroll
                for (int tl = 0; tl < 8; ++tl) yb[h][tl] = *(const GAS v4u*)(w1 + (size_t)(16 * tl + r) * 4096 + k); }
#pragma unroll
            for (int h = 0; h < 2; ++h)
#pragma unroll
                for (int t2 = 0; t2 < 2; ++t2) { const v4u rw = raw[h][t2];
                    v4u xa; xa.x = pk2(bflo(rw.x) + pp[h][0].x, bfhi(rw.x) + pp[h][0].y); xa.y = pk2(bflo(rw.y) + pp[h][0].z, bfhi(rw.y) + pp[h][0].w);
                    xa.z = pk2(bflo(rw.z) + pp[h][1].x, bfhi(rw.z) + pp[h][1].y); xa.w = pk2(bflo(rw.w) + pp[h][1].z, bfhi(rw.w) + pp[h][1].w);
                    const bf16x8 xf = __builtin_bit_cast(bf16x8, xa);
#pragma unroll
                    for (int tl = 0; tl < 8; ++tl) acc[t2][tl] = mfma16(xf, __builtin_bit_cast(bf16x8, yb[h][tl]), acc[t2][tl]); }
        }
#pragma unroll
        for (int t2 = 0; t2 < 2; ++t2)
#pragma unroll
            for (int tl = 0; tl < 8; ++tl) red[((w * 2 + t2) * 8 + tl) * 64 + lane] = acc[t2][tl];
        __syncthreads();
        LAS bf16* hsw = (LAS bf16*)(F.lds + 131072 + (w >> 2) * 4352);
#pragma unroll
        for (int c2 = 0; c2 < 2; ++c2) { const int tl = 2 * (w & 3) + c2, t2 = w >> 2;
            f32x4 a = red[((0 * 2 + t2) * 8 + tl) * 64 + lane];
#pragma unroll
            for (int ww = 1; ww < 8; ++ww) a += red[((ww * 2 + t2) * 8 + tl) * 64 + lane];
#pragma unroll
            for (int j = 0; j < 4; ++j) hsw[(4 * quad + j) * 136 + 16 * tl + r] = (bf16)f2bf(gelu_tanh(a[j])); }
        __syncthreads();
        if (w < 2) {
            const int t2 = w; const LAS bf16* hs = (const LAS bf16*)(F.lds + 131072 + t2 * 4352);
            v4u w2f[4][8];
            { const bf16* w2p = w2t + (size_t)which * 128 * 128;
#pragma unroll
                for (int s = 0; s < 4; ++s)
#pragma unroll
                    for (int tl = 0; tl < 8; ++tl) w2f[s][tl] = *(const GAS v4u*)(w2p + (size_t)(16 * tl + r) * 128 + 32 * s + 8 * quad); }
            __builtin_amdgcn_sched_barrier(0);
            f32x4 a2[8];
#pragma unroll
            for (int i = 0; i < 8; ++i) a2[i] = (f32x4){0.f, 0.f, 0.f, 0.f};
#pragma unroll
            for (int s = 0; s < 4; ++s) {
                const bf16x8 xf = *(const LAS bf16x8*)(hs + r * 136 + 32 * s + 8 * quad);
#pragma unroll
                for (int tl = 0; tl < 8; ++tl) a2[tl] = mfma16(xf, __builtin_bit_cast(bf16x8, w2f[s][tl]), a2[tl]);
            }
            float sc[4] = {1.f, 1.f, 1.f, 1.f};
            if (which == 0) {
#pragma unroll
                for (int j = 0; j < 4; ++j) { float ss = 0.f;
#pragma unroll
                    for (int tl = 0; tl < 8; ++tl) ss += a2[tl][j] * a2[tl][j];
                    ss += shx<1>(ss, lane); ss += shx<2>(ss, lane); ss += shx<4>(ss, lane); ss += shx<8>(ss, lane);
                    sc[j] = 1.0f / sqrtf(ss * (1.f / 128.f) + NORM_EPS); }
            }
            bf16* dst = (which ? vc : kc) + (size_t)((b * 2 + kv) * NCMP_PAD) * 128;
#pragma unroll
            for (int tl = 0; tl < 8; ++tl) { const float g = which ? 1.f : kcn[16 * tl + r];
#pragma unroll
                for (int j = 0; j < 4; ++j) { const int row = 32 * rt2 + 16 * t2 + 4 * quad + j; dst[(size_t)row * 128 + 16 * tl + r] = row < NCMP ? (bf16)f2bf(a2[tl][j] * sc[j] * g) : (bf16)0; } }
        }
        __syncthreads();
    }
}
constexpr int LRU_WA = 0, LRU_WX = 9216, LRU_XC = 18432, LRU_XCF = 27648, LRU_A = LRU_XCF + 16640, LRU_MU = LRU_A + 16640, LRU_IX = LRU_MU + 16640,
              LRU_SEG = LRU_IX + 16640, LRU_H = LRU_SEG + 4096, LRU_CONST = LRU_H + 512, LRU_END = LRU_CONST + 8 * 256;
#define LRU_BAR() do { asm volatile("s_waitcnt lgkmcnt(0)" ::: "memory"); __builtin_amdgcn_s_barrier(); asm volatile("" ::: "memory"); } while (0)
__device__ __forceinline__ void lru_unit(const Ctx& F, int b, int nb, const bf16* p, bf16* mix, const float* conv_w, const float* conv_b, const float* ga_w, const float* ga_b,
                                         const float* gx_w, const float* gx_b, const float* lam) {
    LAS unsigned char* L = F.lds;
    LAS bf16* WaT = (LAS bf16*)(L + LRU_WA); LAS bf16* WxT = (LAS bf16*)(L + LRU_WX); LAS bf16* Xc = (LAS bf16*)(L + LRU_XC);
    LAS float* XcF = (LAS float*)(L + LRU_XCF); LAS float* Aa = (LAS float*)(L + LRU_A); LAS float* Mu = (LAS float*)(L + LRU_MU); LAS float* IX = (LAS float*)(L + LRU_IX);
    LAS float* SEG = (LAS float*)(L + LRU_SEG); LAS float* H = (LAS float*)(L + LRU_H); LAS float* CST = (LAS float*)(L + LRU_CONST);
    int w = F.wave; asm volatile("" : "+s"(w));
    const int tid = 64 * w + lane_now();
    const int lane = tid & 63, c = tid & 63, seg = tid >> 6, r = lane & 15, quad = lane >> 4;
    const int c0 = 64 * nb;
    for (int e = tid; e < 4096; e += 512) { const int i = e >> 6, o = e & 63; WaT[o * 72 + i] = (bf16)f2bf(ga_w[(size_t)nb * 4096 + e]); WxT[o * 72 + i] = (bf16)f2bf(gx_w[(size_t)nb * 4096 + e]); }
    if (tid < 64) { CST[0 * 64 + tid] = conv_w[0 * 512 + c0 + tid]; CST[1 * 64 + tid] = conv_w[1 * 512 + c0 + tid]; CST[2 * 64 + tid] = conv_w[2 * 512 + c0 + tid]; CST[3 * 64 + tid] = conv_w[3 * 512 + c0 + tid];
        CST[4 * 64 + tid] = conv_b[c0 + tid]; CST[5 * 64 + tid] = ga_b[c0 + tid]; CST[6 * 64 + tid] = gx_b[c0 + tid];
        const float nl = -lam[c0 + tid]; CST[7 * 64 + tid] = fmaxf(nl, 0.f) + log1pf(expf(-fabsf(nl)));
        H[tid] = 0.f; H[64 + tid] = 0.f; }
    __syncthreads();
    const float cw0 = CST[c], cw1 = CST[64 + c], cw2 = CST[128 + c], cw3 = CST[192 + c], cb = CST[256 + c];
    const bf16* ubase = p + (long)(b * T + 8 * seg - 3) * LDP + C_LRUX + c0 + c;
    const bf16* ybase = p + (size_t)(b * T + 8 * seg) * LDP + C_LRUY + c0 + c;
    bf16 un[11], yn[8];
#pragma unroll
    for (int k = 0; k < 11; ++k) un[k] = (8 * seg - 3 + k >= 0) ? ubase[(long)k * LDP] : (bf16)0;
#pragma unroll
    for (int k = 0; k < 8; ++k) yn[k] = ybase[(size_t)k * LDP];
    for (int tt = 0; tt < T / 64; ++tt) {
        const int t0 = 64 * tt, cur = tt & 1;
        float u[11], yv[8];
#pragma unroll
        for (int k = 0; k < 11; ++k) u[k] = bf2f(un[k]);
#pragma unroll
        for (int k = 0; k < 8; ++k) yv[k] = bf2f(yn[k]);
        if (tt + 1 < T / 64) {
#pragma unroll
            for (int k = 0; k < 11; ++k) un[k] = ubase[(long)(t0 + 64 + k) * LDP];
#pragma unroll
            for (int k = 0; k < 8; ++k) yn[k] = ybase[(size_t)(t0 + 64 + k) * LDP];
        }
#pragma unroll
        for (int k = 0; k < 8; ++k) { const float xc = u[k] * cw0 + u[k + 1] * cw1 + u[k + 2] * cw2 + u[k + 3] * cw3 + cb;
            XcF[(8 * seg + k) * 65 + c] = xc; Xc[(8 * seg + k) * 72 + c] = (bf16)f2bf(xc); }
        LRU_BAR();
        { const int tm = w & 3, ch = w >> 2;
            f32x4 aa[2], ax[2];
#pragma unroll
            for (int c2 = 0; c2 < 2; ++c2) { aa[c2] = (f32x4){0.f, 0.f, 0.f, 0.f}; ax[c2] = (f32x4){0.f, 0.f, 0.f, 0.f}; }
#pragma unroll
            for (int s = 0; s < 2; ++s) { const bf16x8 xf = *(const LAS bf16x8*)(Xc + (16 * tm + r) * 72 + 32 * s + 8 * quad);
#pragma unroll
                for (int c2 = 0; c2 < 2; ++c2) { const int ct = 2 * ch + c2;
                    const bf16x8 ya = *(const LAS bf16x8*)(WaT + (16 * ct + r) * 72 + 32 * s + 8 * quad), yx = *(const LAS bf16x8*)(WxT + (16 * ct + r) * 72 + 32 * s + 8 * quad);
                    aa[c2] = mfma16(xf, ya, aa[c2]); ax[c2] = mfma16(xf, yx, ax[c2]); } }
#pragma unroll
            for (int c2 = 0; c2 < 2; ++c2) { const int o = 16 * (2 * ch + c2) + r; const float ba = CST[5 * 64 + o], bx = CST[6 * 64 + o], sp = CST[7 * 64 + o];
#pragma unroll
                for (int j = 0; j < 4; ++j) { const int t = 16 * tm + 4 * quad + j;
                    const float rg = sigmoidf_(aa[c2][j] + ba); const float a = __builtin_amdgcn_exp2f(-8.0f * 1.44269504089f * rg * sp);
                    Aa[t * 65 + o] = a; Mu[t * 65 + o] = __builtin_amdgcn_sqrtf(fmaxf(1.0f - a * a, 0.f));
                    const float ig = sigmoidf_(ax[c2][j] + bx); IX[t * 65 + o] = ig * XcF[t * 65 + o]; } } }
        LRU_BAR();
        float hl[8], pc[8];
        { float h = 0.f, P = 1.f;
#pragma unroll
            for (int k = 0; k < 8; ++k) { const int t = 8 * seg + k; const float a = Aa[t * 65 + c]; h = a * h + Mu[t * 65 + c] * IX[t * 65 + c]; P *= a; hl[k] = h; pc[k] = P; }
            SEG[(seg * 64 + c) * 2] = P; SEG[(seg * 64 + c) * 2 + 1] = h; }
        LRU_BAR();
        { float carry = H[cur * 64 + c];
            float sp_[7], sh_[7];
#pragma unroll
            for (int s = 0; s < 7; ++s) { sp_[s] = SEG[(s * 64 + c) * 2]; sh_[s] = SEG[(s * 64 + c) * 2 + 1]; }
#pragma unroll
            for (int s = 0; s < 7; ++s) if (s < w) carry = sp_[s] * carry + sh_[s];
            bf16* op = mix + (size_t)(b * T + t0 + 8 * seg) * D + MIX_A + c0 + c;
            float hf = 0.f;
#pragma unroll
            for (int k = 0; k < 8; ++k) { hf = hl[k] + pc[k] * carry; op[(size_t)k * D] = (bf16)f2bf(hf * gelu_tanh(yv[k])); }
            if (seg == 7) H[(cur ^ 1) * 64 + c] = hf; }
        LRU_BAR();
    }
}
constexpr int GL_QT = 0, GL_KT = 9216, GL_KHT = 18432, GL_AM = 27648, GL_VT = 36864, GL_ST = GL_VT + 18432, GL_ALR = GL_ST + 18432, GL_EB = GL_ALR + 2 * 4096, GL_SEGS = GL_EB + 256,
              GL_RS = GL_SEGS + 2048, GL_END = GL_RS + 512;
__device__ __forceinline__ float exp_fast(float x) { return __builtin_amdgcn_exp2f(x * 1.44269504089f); }
__device__ __forceinline__ void gla_unit(const Ctx& F, int b, int h, const bf16* p, bf16* mix, const float* a_w2, const float* a_b, const float* onorm) {
    LAS unsigned char* L = F.lds;
    LAS bf16* Qt = (LAS bf16*)(L + GL_QT); LAS bf16* Kt = (LAS bf16*)(L + GL_KT); LAS bf16* KhT = (LAS bf16*)(L + GL_KHT); LAS bf16* Am = (LAS bf16*)(L + GL_AM);
    LAS bf16* VT = (LAS bf16*)(L + GL_VT); LAS bf16* ST = (LAS bf16*)(L + GL_ST); LAS float* ALR = (LAS float*)(L + GL_ALR); LAS float* EB = (LAS float*)(L + GL_EB); LAS float* SEGS = (LAS float*)(L + GL_SEGS);
    LAS float* RS = (LAS float*)(L + GL_RS);
    int w = F.wave; asm volatile("" : "+s"(w));
    const int tid = 64 * w + lane_now();
    const int lane = tid & 63, d = tid & 63, seg = tid >> 6, r = lane & 15, quad = lane >> 4;
    float aw[16];
#pragma unroll
    for (int rr = 0; rr < 16; ++rr) aw[rr] = a_w2[rr * 256 + h * 64 + d];
    const float abd = a_b[h * 64 + d];
    const int dt = w & 3, eh = w >> 2, it = w & 3;
    f32x4 Sacc[4];
#pragma unroll
    for (int et = 0; et < 4; ++et) Sacc[et] = (f32x4){0.f, 0.f, 0.f, 0.f};
    float gn[4][4];
#pragma unroll
    for (int et = 0; et < 4; ++et)
#pragma unroll
        for (int j = 0; j < 4; ++j) gn[et][j] = onorm[64 * eh + 16 * et + 4 * quad + j];
    const size_t rowb = (size_t)b * T;
    const bf16* qbase = p + (rowb + 8 * seg) * LDP + C_GQ + h * 64 + d;
    const bf16* vbase = p + (rowb + (tid >> 3)) * LDP + C_GV + h * 128 + 16 * (tid & 7);
    const bf16* abase = p + (rowb + (tid >> 1)) * LDP + C_GA + 8 * (tid & 1);
    const bf16* gbase = p + (rowb + 16 * it + r) * LDP + C_GG + h * 128 + 64 * eh + 4 * quad;
    bf16 qn[8], kn[8]; v4u vn0, vn1, an = {0u, 0u, 0u, 0u}; v2u ggn[4];
#pragma unroll
    for (int k = 0; k < 8; ++k) { qn[k] = qbase[(size_t)k * LDP]; kn[k] = qbase[(size_t)k * LDP + (C_GK - C_GQ)]; }
    vn0 = *(const GAS v4u*)vbase; vn1 = *(const GAS v4u*)(vbase + 8);
    if (tid < 128) an = *(const GAS v4u*)abase;
#pragma unroll
    for (int et = 0; et < 4; ++et) ggn[et] = *(const GAS v2u*)(gbase + 16 * et);
    if (tid < 128) { LAS float* ap = ALR + (tid >> 1) * 16 + 8 * (tid & 1);
#pragma unroll
        for (int q = 0; q < 4; ++q) { ap[2 * q] = bflo(an[q]); ap[2 * q + 1] = bfhi(an[q]); } }
    __syncthreads();
    for (int ch = 0; ch < T / 64; ++ch) {
        const size_t row0 = rowb + 64 * ch;
        const LAS float* alr = ALR + (ch & 1) * 1024;
        float qv[8], kv[8]; v4u v0 = vn0, v1 = vn1; v2u gg[4];
#pragma unroll
        for (int k = 0; k < 8; ++k) { qv[k] = bf2f(qn[k]) * 0.125f; kv[k] = bf2f(kn[k]); }
#pragma unroll
        for (int et = 0; et < 4; ++et) gg[et] = ggn[et];
        if (ch + 1 < T / 64) { const size_t o = (size_t)(64 * (ch + 1)) * LDP;
#pragma unroll
            for (int k = 0; k < 8; ++k) { qn[k] = qbase[o + (size_t)k * LDP]; kn[k] = qbase[o + (size_t)k * LDP + (C_GK - C_GQ)]; }
            vn0 = *(const GAS v4u*)(vbase + o); vn1 = *(const GAS v4u*)(vbase + o + 8);
            if (tid < 128) an = *(const GAS v4u*)(abase + o);
#pragma unroll
            for (int et = 0; et < 4; ++et) ggn[et] = *(const GAS v2u*)(gbase + o + 16 * et); }
        float bl[8];
        { float run = 0.f;
#pragma unroll
            for (int k = 0; k < 8; ++k) { const LAS f32x4* ar = (const LAS f32x4*)(alr + (8 * seg + k) * 16);
                float z = abd;
#pragma unroll
                for (int q = 0; q < 4; ++q) { const f32x4 a4 = ar[q]; z += (a4.x * aw[4 * q] + a4.y * aw[4 * q + 1]) + (a4.z * aw[4 * q + 2] + a4.w * aw[4 * q + 3]); }
                const float ls = fminf(z, 0.f) - 0.69314718056f * __builtin_amdgcn_logf(1.0f + exp_fast(-fabsf(z)));
                run += ls * (1.0f / 16.0f); bl[k] = run; }
            SEGS[seg * 64 + d] = run; }
#pragma unroll
        for (int et = 0; et < 4; ++et) { v2u wv; wv.x = pk2(Sacc[et][0], Sacc[et][1]); wv.y = pk2(Sacc[et][2], Sacc[et][3]);
            *(LAS v2u*)(ST + (64 * eh + 16 * et + r) * 72 + 16 * dt + 4 * quad) = wv; }
        { const int j = tid >> 3, e0 = 16 * (tid & 7);
#pragma unroll
            for (int q = 0; q < 4; ++q) { VT[(e0 + 2 * q) * 72 + j] = (bf16)(v0[q] & 0xffffu); VT[(e0 + 2 * q + 1) * 72 + j] = (bf16)(v0[q] >> 16);
                VT[(e0 + 8 + 2 * q) * 72 + j] = (bf16)(v1[q] & 0xffffu); VT[(e0 + 8 + 2 * q + 1) * 72 + j] = (bf16)(v1[q] >> 16); } }
        LRU_BAR();
        { float pre = 0.f, tot = 0.f;
#pragma unroll
            for (int s = 0; s < 8; ++s) { const float v = SEGS[s * 64 + d]; tot += v; if (s < seg) pre += v; }
            if (seg == 0) EB[d] = exp_fast(tot);
#pragma unroll
            for (int k = 0; k < 8; ++k) { const int j = 8 * seg + k; const float bb = bl[k] + pre;
                Qt[j * 72 + d] = (bf16)f2bf(qv[k] * exp_fast(bb)); Kt[j * 72 + d] = (bf16)f2bf(kv[k] * exp_fast(-bb)); KhT[d * 72 + j] = (bf16)f2bf(kv[k] * exp_fast(tot - bb)); } }
        LRU_BAR();
        f32x4 Oacc[4];
#pragma unroll
        for (int et = 0; et < 4; ++et) Oacc[et] = (f32x4){0.f, 0.f, 0.f, 0.f};
        { bf16x8 qf[2];
#pragma unroll
            for (int s = 0; s < 2; ++s) qf[s] = *(const LAS bf16x8*)(Qt + (16 * it + r) * 72 + 32 * s + 8 * quad);
#pragma unroll
            for (int et = 0; et < 4; ++et)
#pragma unroll
                for (int s = 0; s < 2; ++s) { const bf16x8 sf = *(const LAS bf16x8*)(ST + (64 * eh + 16 * et + r) * 72 + 32 * s + 8 * quad); Oacc[et] = mfma16(sf, qf[s], Oacc[et]); }
            const int jt = w & 3;
#pragma unroll
            for (int ii = 0; ii < 2; ++ii) { const int itl = 2 * (w >> 2) + ii; f32x4 a = (f32x4){0.f, 0.f, 0.f, 0.f};
#pragma unroll
                for (int s = 0; s < 2; ++s) { const bf16x8 kf = *(const LAS bf16x8*)(Kt + (16 * jt + r) * 72 + 32 * s + 8 * quad); const bf16x8 q2 = *(const LAS bf16x8*)(Qt + (16 * itl + r) * 72 + 32 * s + 8 * quad);
                    a = mfma16(kf, q2, a); }
                const int i = 16 * itl + r, j0 = 16 * jt + 4 * quad;
                v2u wv; wv.x = pk2(j0 <= i ? a[0] : 0.f, j0 + 1 <= i ? a[1] : 0.f); wv.y = pk2(j0 + 2 <= i ? a[2] : 0.f, j0 + 3 <= i ? a[3] : 0.f);
                *(LAS v2u*)(Am + i * 72 + j0) = wv; } }
        LRU_BAR();
        { bf16x8 af[2];
#pragma unroll
            for (int s = 0; s < 2; ++s) af[s] = *(const LAS bf16x8*)(Am + (16 * it + r) * 72 + 32 * s + 8 * quad);
#pragma unroll
            for (int et = 0; et < 4; ++et)
#pragma unroll
                for (int s = 0; s < 2; ++s) { const bf16x8 vf = *(const LAS bf16x8*)(VT + (64 * eh + 16 * et + r) * 72 + 32 * s + 8 * quad); Oacc[et] = mfma16(vf, af[s], Oacc[et]); }
            const f32x4 eb = *(const LAS f32x4*)(EB + 16 * dt + 4 * quad);
            bf16x8 kf[2];
#pragma unroll
            for (int s = 0; s < 2; ++s) kf[s] = *(const LAS bf16x8*)(KhT + (16 * dt + r) * 72 + 32 * s + 8 * quad);
#pragma unroll
            for (int et = 0; et < 4; ++et) { Sacc[et] = Sacc[et] * eb;
#pragma unroll
                for (int s = 0; s < 2; ++s) { const bf16x8 vf = *(const LAS bf16x8*)(VT + (64 * eh + 16 * et + r) * 72 + 32 * s + 8 * quad); Sacc[et] = mfma16(kf[s], vf, Sacc[et]); } } }
        if (tid < 128 && ch + 1 < T / 64) { LAS float* ap = ALR + ((ch + 1) & 1) * 1024 + (tid >> 1) * 16 + 8 * (tid & 1);
#pragma unroll
            for (int q = 0; q < 4; ++q) { ap[2 * q] = bflo(an[q]); ap[2 * q + 1] = bfhi(an[q]); } }
        { float ss = 0.f;
#pragma unroll
            for (int et = 0; et < 4; ++et) ss += (Oacc[et][0] * Oacc[et][0] + Oacc[et][1] * Oacc[et][1]) + (Oacc[et][2] * Oacc[et][2] + Oacc[et][3] * Oacc[et][3]);
            ss += shx<16>(ss, lane); ss += shx<32>(ss, lane);
            if (quad == 0) RS[(16 * it + r) * 2 + eh] = ss; }
        LRU_BAR();
        { const float tot = RS[(16 * it + r) * 2] + RS[(16 * it + r) * 2 + 1];
            const float rn = 1.0f / sqrtf(tot * (1.f / 128.f) + NORM_EPS);
            const size_t row = row0 + 16 * it + r;
#pragma unroll
            for (int et = 0; et < 4; ++et) { const int e = 64 * eh + 16 * et + 4 * quad;
                const float g0 = bflo(gg[et].x), g1 = bfhi(gg[et].x), g2 = bflo(gg[et].y), g3 = bfhi(gg[et].y);
                v2u o; o.x = pk2(Oacc[et][0] * rn * gn[et][0] * g0 * sigmoidf_(g0), Oacc[et][1] * rn * gn[et][1] * g1 * sigmoidf_(g1));
                o.y = pk2(Oacc[et][2] * rn * gn[et][2] * g2 * sigmoidf_(g2), Oacc[et][3] * rn * gn[et][3] * g3 * sigmoidf_(g3));
                *(GAS v2u*)(mix + row * D + MIX_C + h * 128 + e) = o; } }
    }
}
constexpr int AT_SLOT = 32768, AT_IMP = 65536, AT_SELM = 131072, AT_END = AT_SELM + 512;
typedef short v4i16_t __attribute__((ext_vector_type(4)));
__device__ __forceinline__ unsigned off_b(unsigned row, unsigned ch) { return 256u * row + 16u * (ch ^ (((row & 3u) << 2) | ((row >> 2) & 3u))); }
struct TileSrc { const bf16* base; size_t stride; };
__device__ __forceinline__ void glds16(const void* sbase, unsigned voff, unsigned lds_dst) { unsigned keep;
    asm volatile("s_mov_b32 %0, m0\n\ts_mov_b32 m0, %3\n\ts_nop 0\n\tglobal_load_lds_dwordx4 %1, %2\n\ts_mov_b32 m0, %0" : "=&s"(keep) : "v"(voff), "s"(sbase), "s"(lds_dst) : "memory"); }
__device__ __forceinline__ unsigned tile_lane_off(int i, int wave, int lane, unsigned stride) {
    const int seg = 2 * wave + i; const unsigned row = 4u * seg + (lane >> 4), ch = (lane & 15u) ^ (((row & 3u) << 2) | ((row >> 2) & 3u));
    return (row * stride + 8u * ch) * 2u; }
__device__ __forceinline__ void tile_dma(const TileSrc& s, int tl, LAS unsigned char* buf, int wave, unsigned lo0, unsigned lo1) {
    const bf16* tb = s.base + (size_t)(64 * tl) * s.stride;
    glds16(tb, lo0, (unsigned)(size_t)(buf + 1024 * (2 * wave))); glds16(tb, lo1, (unsigned)(size_t)(buf + 1024 * (2 * wave + 1)));
}
#define AT_LDS_BAR() do { asm volatile("s_waitcnt lgkmcnt(0)" ::: "memory"); __builtin_amdgcn_s_barrier(); asm volatile("" ::: "memory"); } while (0)
#define AT_DRAIN_BAR() do { asm volatile("s_waitcnt vmcnt(0) lgkmcnt(0)" ::: "memory"); __builtin_amdgcn_s_barrier(); asm volatile("" ::: "memory"); } while (0)
typedef float f32x2_t __attribute__((ext_vector_type(2))); typedef __bf16 bf16x2_t __attribute__((ext_vector_type(2)));
__device__ __forceinline__ unsigned cvtpk(float lo, float hi) { const f32x2_t v = {lo, hi}; const bf16x2_t b = __builtin_convertvector(v, bf16x2_t); return __builtin_bit_cast(unsigned, b); }
enum { BR_CMP = 0, BR_SEL = 1, BR_WIN = 2 };
constexpr float AT_SC = 0.08838834764831845f * 1.4426950408889634f;
__device__ __forceinline__ void qk_tile(const LAS unsigned char* kb, const bf16x8 (&qf)[8], int lane, f32x16 (&sacc)[2]) {
#pragma unroll
    for (int kt = 0; kt < 2; ++kt) {
        f32x16 a = {0.f, 0.f, 0.f, 0.f, 0.f, 0.f, 0.f, 0.f, 0.f, 0.f, 0.f, 0.f, 0.f, 0.f, 0.f, 0.f};
#pragma unroll
        for (int s = 0; s < 8; ++s) { const bf16x8 kf = *(const LAS bf16x8*)(kb + off_b(32 * kt + (lane & 31), 2 * s + (lane >> 5))); a = mfma32(kf, qf[s], a); }
        sacc[kt] = a;
    }
}
template <int BR> __device__ __forceinline__ bool key_ok(int key, int t, bool selbit) {
    if (BR == BR_CMP) return 16 * key + 31 <= t;
    if (BR == BR_SEL) return selbit && key <= t;
    return key <= t && key + 512 > t;
}
template <int BR, int MODE, int NSLOT>
__device__ __forceinline__ void attn_branch(const Ctx& F, const TileSrc& ks, const TileSrc& vs, int lo, int hi, const bf16x8 (&qf)[8], int t, float gate, float shift, unsigned long long selmask,
                                            float* yb  , bf16* outp  , LAS float* imp_row  ) {
    const int lane = F.lane, hh = lane >> 5, wv = F.wave;
    const float NEG_INF = -__builtin_inff();
    f32x16 obr[4];
#pragma unroll
    for (int c = 0; c < 4; ++c) obr[c] = (f32x16){0.f, 0.f, 0.f, 0.f, 0.f, 0.f, 0.f, 0.f, 0.f, 0.f, 0.f, 0.f, 0.f, 0.f, 0.f, 0.f};
    float imp_carry = 0.f; f32x2_t l2 = {0.f, 0.f};
    asm volatile("s_waitcnt lgkmcnt(0)" ::: "memory"); __builtin_amdgcn_s_barrier(); asm volatile("" ::: "memory");
    const int n = hi - lo;
    const unsigned lo0 = tile_lane_off(0, wv, lane, (unsigned)ks.stride), lo1 = tile_lane_off(1, wv, lane, (unsigned)ks.stride);
    constexpr int NPRE = NSLOT == 4 ? 2 : NSLOT - 1;
#pragma unroll
    for (int j = 0; j < NPRE; ++j) if (j < n) { tile_dma(ks, lo + j, F.lds + j * AT_SLOT, wv, lo0, lo1); tile_dma(vs, lo + j, F.lds + j * AT_SLOT + 16384, wv, lo0, lo1); }
    const unsigned trq = (lane & 15) >> 2, trp = lane & 3, trblk = (lane >> 4) & 1;
    unsigned vof0[4], vof1[4];
    { const unsigned lc = 2u * trblk + (trp >> 1), hq = (unsigned)hh;
#pragma unroll
        for (unsigned c = 0; c < 4; ++c) { vof0[c] = 256u * (4u * hq + trq) + 16u * (((c ^ trq) << 2) | (lc ^ hq)) + 8u * (trp & 1u);
            vof1[c] = 256u * (4u * hq + trq + 8u) + 16u * (((c ^ trq) << 2) | (lc ^ (hq + 2u))) + 8u * (trp & 1u); } }
    for (int i = 0; i < n; ++i) {
        const int tl = lo + i, slot = i & (NSLOT - 1);
        if (NSLOT == 4) {
            if ((i & 1) == 0) {
                asm volatile("s_waitcnt vmcnt(0) lgkmcnt(0)" ::: "memory"); __builtin_amdgcn_s_barrier(); asm volatile("" ::: "memory");
#pragma unroll
                for (int j = 2; j < 4; ++j) if (i + j < n) { const int ns = (i + j) & 3; tile_dma(ks, tl + j, F.lds + ns * AT_SLOT, wv, lo0, lo1); tile_dma(vs, tl + j, F.lds + ns * AT_SLOT + 16384, wv, lo0, lo1); }
            }
        } else {
            asm volatile("s_waitcnt vmcnt(0) lgkmcnt(0)" ::: "memory"); __builtin_amdgcn_s_barrier(); asm volatile("" ::: "memory");
            if (i + 1 < n) { const int ns = (i + 1) & 1; tile_dma(ks, tl + 1, F.lds + ns * AT_SLOT, wv, lo0, lo1); tile_dma(vs, tl + 1, F.lds + ns * AT_SLOT + 16384, wv, lo0, lo1); }
        }
        const LAS unsigned char* kb = F.lds + slot * AT_SLOT; const LAS unsigned char* vb = kb + 16384;
        const bool selbit = (selmask >> tl) & 1ull;
        const float ainit = (BR == BR_SEL && !selbit) ? NEG_INF : -shift;
        const bool masked = BR == BR_CMP || tl == hi - 1 || (BR == BR_WIN && tl + 8 == hi - 1);
        bf16x8 pf[2][2];
#pragma unroll
        for (int kt = 0; kt < 2; ++kt) {
            f32x16 sa = {ainit, ainit, ainit, ainit, ainit, ainit, ainit, ainit, ainit, ainit, ainit, ainit, ainit, ainit, ainit, ainit};
            bf16x8 kfr[8];
#pragma unroll
            for (int s = 0; s < 8; ++s) kfr[s] = *(const LAS bf16x8*)(kb + off_b(32 * kt + (lane & 31), 2 * s + (lane >> 5)));
            __builtin_amdgcn_sched_barrier(0);
#pragma unroll
            for (int s = 0; s < 8; ++s) sa = mfma32(kfr[s], qf[s], sa);
            float pv[16];
            if (masked) {
#pragma unroll
                for (int i2 = 0; i2 < 16; ++i2) { const int key = 64 * tl + 32 * kt + (i2 & 3) + 8 * (i2 >> 2) + 4 * hh;
                    pv[i2] = __builtin_amdgcn_exp2f(key_ok<BR>(key, t, true) ? sa[i2] : NEG_INF); }
            } else {
#pragma unroll
                for (int i2 = 0; i2 < 16; ++i2) pv[i2] = __builtin_amdgcn_exp2f(sa[i2]);
            }
            { f32x2_t t0 = (f32x2_t){pv[0], pv[1]} + (f32x2_t){pv[2], pv[3]}, t1 = (f32x2_t){pv[4], pv[5]} + (f32x2_t){pv[6], pv[7]}, t2 = (f32x2_t){pv[8], pv[9]} + (f32x2_t){pv[10], pv[11]}, t3 = (f32x2_t){pv[12], pv[13]} + (f32x2_t){pv[14], pv[15]};
              l2 += (t0 + t1) + (t2 + t3); }
            if (BR == BR_CMP) {
                float x[4];
#pragma unroll
                for (int gi = 0; gi < 4; ++gi) x[gi] = shx<32>(pv[4 * gi + 3], lane);
#pragma unroll
                for (int gi = 0; gi < 4; ++gi) { const int sb = 16 * tl + 8 * kt + 2 * gi + hh;
                    const float s4 = (pv[4 * gi] + pv[4 * gi + 1]) + (pv[4 * gi + 2] + pv[4 * gi + 3]);
                    const float extra = hh ? x[gi] : (gi == 0 ? imp_carry : x[gi > 0 ? gi - 1 : 0]);
                    imp_row[sb] = s4 + extra; }
                imp_carry = x[3];
            }
            v4u w0, w1;
            w0.x = cvtpk(pv[0], pv[1]); w0.y = cvtpk(pv[2], pv[3]); w0.z = cvtpk(pv[4], pv[5]); w0.w = cvtpk(pv[6], pv[7]);
            w1.x = cvtpk(pv[8], pv[9]); w1.y = cvtpk(pv[10], pv[11]); w1.z = cvtpk(pv[12], pv[13]); w1.w = cvtpk(pv[14], pv[15]);
            pf[kt][0] = __builtin_bit_cast(bf16x8, w0); pf[kt][1] = __builtin_bit_cast(bf16x8, w1);
        }
#pragma unroll
        for (int c = 0; c < 4; ++c)
#pragma unroll
            for (int ksx = 0; ksx < 4; ++ksx) {
                const s16x4 v0 = __builtin_bit_cast(s16x4, __builtin_amdgcn_ds_read_tr16_b64_v4i16((LAS v4i16_t*)(vb + vof0[c] + 4096u * ksx)));
                const s16x4 v1 = __builtin_bit_cast(s16x4, __builtin_amdgcn_ds_read_tr16_b64_v4i16((LAS v4i16_t*)(vb + vof1[c] + 4096u * ksx)));
                const bf16x8 vf = {v0[0], v0[1], v0[2], v0[3], v1[0], v1[1], v1[2], v1[3]};
                obr[c] = mfma32(vf, pf[ksx >> 1][ksx & 1], obr[c]);
            }
    }
    float l = l2.x + l2.y; l += shx<32>(l, lane);
    const float inv_l = l > 0.f ? 1.0f / l : 0.f, coef = gate * inv_l;
    f32x4 ybv[4][4];
    if (MODE >= 1) {
#pragma unroll
        for (int c = 0; c < 4; ++c)
#pragma unroll
            for (int gi = 0; gi < 4; ++gi) ybv[c][gi] = *(const GAS f32x4*)(yb + 32 * c + 8 * gi + 4 * hh);
    }
    if (BR == BR_CMP) {
        float iv[32];
#pragma unroll
        for (int G = 0; G < 32; ++G) iv[G] = imp_row[2 * G + hh];
#pragma unroll
        for (int G = 0; G < 32; ++G) imp_row[2 * G + hh] = iv[G] * inv_l;
    }
    __builtin_amdgcn_sched_barrier(0);
#pragma unroll
    for (int c = 0; c < 4; ++c)
#pragma unroll
        for (int gi = 0; gi < 4; ++gi) { const int e = 32 * c + 8 * gi + 4 * hh;
            f32x4 v = (f32x4){obr[c][4 * gi], obr[c][4 * gi + 1], obr[c][4 * gi + 2], obr[c][4 * gi + 3]} * coef;
            if (MODE >= 1) v = v + ybv[c][gi];
            if (MODE <= 1) *(GAS f32x4*)(yb + e) = v;
            else { v2u o; o.x = pk2(v[0], v[1]); o.y = pk2(v[2], v[3]); *(GAS v2u*)(outp + e) = o; } }
}

__device__ __forceinline__ void attn_shifts(const float* qn, const float* kcn, const float* ksn, const float* kwn, float& shc, float& shs, float& shw) {
    const int lane = lane_now();
    float mq = fmaxf(fabsf(qn[lane]), fabsf(qn[lane + 64])), mc = fmaxf(fabsf(kcn[lane]), fabsf(kcn[lane + 64])), ms = fmaxf(fabsf(ksn[lane]), fabsf(ksn[lane + 64])), mw = fmaxf(fabsf(kwn[lane]), fabsf(kwn[lane + 64]));
#define AT_MX(O) do { mq = fmaxf(mq, shx<O>(mq, lane)); mc = fmaxf(mc, shx<O>(mc, lane)); ms = fmaxf(ms, shx<O>(ms, lane)); mw = fmaxf(mw, shx<O>(mw, lane)); } while (0)
    AT_MX(1); AT_MX(2); AT_MX(4); AT_MX(8); AT_MX(16); AT_MX(32);
#undef AT_MX
    const float k0 = 128.0f * AT_SC * 1.02f * mq;
    shc = __builtin_bit_cast(float, __builtin_amdgcn_readfirstlane(__builtin_bit_cast(int, k0 * mc))); shs = __builtin_bit_cast(float, __builtin_amdgcn_readfirstlane(__builtin_bit_cast(int, k0 * ms)));
    shw = __builtin_bit_cast(float, __builtin_amdgcn_readfirstlane(__builtin_bit_cast(int, k0 * mw)));
}

__device__ __forceinline__ void attn_unit(const Ctx& F0, int b, int kv, int qb, const bf16* p, bf16* mix, const bf16* kc, const bf16* vc, const float* gate_b, const float* ctab, const float* stab, float* ybuf, float shc, float shs, float shw) {
    Ctx F = F0; { int w_ = F0.wave; asm volatile("" : "+s"(w_)); F.wave = w_; F.lane = lane_now(); F.tid = 64 * w_ + F.lane; }
    const int tid = F.tid, lane = F.lane, w = F.wave, g = w >> 1, hh = lane >> 5, qq = 32 * (w & 1) + (lane & 31), t = 64 * qb + qq, head = kv * 4 + g;
    const size_t row = (size_t)b * T + t;
    LAS float* IMP = (LAS float*)(F.lds + AT_IMP); LAS unsigned long long* SELM = (LAS unsigned long long*)(F.lds + AT_SELM);
    bf16x8 qc[8];
    { const bf16* qp = p + row * LDP + C_NQ + head * 128 + 8 * hh;
#pragma unroll
        for (int s = 0; s < 8; ++s) qc[s] = __builtin_bit_cast(bf16x8, *(const GAS v4u*)(qp + 16 * s)); }
    float gt[3];
#pragma unroll
    for (int j = 0; j < 3; ++j) gt[j] = sigmoidf_(bf2f(p[row * LDP + C_NGATE + head * 3 + j]) + gate_b[head * 3 + j]);
    LAS float* imp_row = IMP + (g * 64 + qq) * 64;
    if (qb >= 16) {
#pragma unroll
        for (int i = 0; i < 32; ++i) imp_row[32 * hh + i] = 0.f; }
    float* yb = ybuf + row * 1024 + head * 128;
    bf16* outp = mix + row * D + MIX_B + head * 128;
    AT_LDS_BAR();
    { const TileSrc ks{kc + (size_t)(b * 2 + kv) * NCMP_PAD * 128, 128}, vs{vc + (size_t)(b * 2 + kv) * NCMP_PAD * 128, 128};
        const int ncmp = (4 * qb + 2) / 64 + 1;
        attn_branch<BR_CMP, 0, 2>(F, ks, vs, 0, ncmp, qc, t, gt[0], shc, 0ull, yb, outp, imp_row); }
    unsigned long long selmask = 0xFFFFull;
    if (qb >= 16) {
    AT_LDS_BAR();
    { LAS unsigned* KEYS = (LAS unsigned*)(F.lds) + w * 512;
        unsigned mykey[8];
#pragma unroll
        for (int qi = 0; qi < 8; ++qi) { const int q = 8 * w + qi;
            float v = ((IMP[(0 * 64 + q) * 64 + lane] + IMP[(1 * 64 + q) * 64 + lane]) + IMP[(2 * 64 + q) * 64 + lane]) + IMP[(3 * 64 + q) * 64 + lane];
            const bool forced = lane == 0 || lane == qb || lane == qb - 1, valid = lane <= qb;
            v = forced ? 1e30f : (valid ? v : -1e30f);
            const unsigned u = __builtin_bit_cast(unsigned, v), k = (u & 0x80000000u) ? ~u : (u | 0x80000000u);
            mykey[qi] = (k & ~63u) | (unsigned)(63 - lane);
            KEYS[qi * 64 + lane] = mykey[qi]; }
        asm volatile("s_waitcnt lgkmcnt(0)" ::: "memory");
#pragma unroll
        for (int qi = 0; qi < 8; ++qi) { int cnt = 0;
#pragma unroll
            for (int g4 = 0; g4 < 4; ++g4) { if (16 * g4 > qb) break;
                v4u kk[4];
#pragma unroll
                for (int i = 0; i < 4; ++i) kk[i] = *(const LAS v4u*)(KEYS + qi * 64 + 16 * g4 + 4 * i);
                __builtin_amdgcn_sched_barrier(0);
#pragma unroll
                for (int i = 0; i < 4; ++i) cnt += (kk[i].x > mykey[qi] ? 1 : 0) + (kk[i].y > mykey[qi] ? 1 : 0) + (kk[i].z > mykey[qi] ? 1 : 0) + (kk[i].w > mykey[qi] ? 1 : 0); }
            const unsigned long long msk = __ballot(cnt < 16);
            if (lane == 0) SELM[8 * w + qi] = msk; } }
    AT_LDS_BAR();
    selmask = SELM[qq]; }
    bf16x8 qr[8];
#pragma unroll
    for (int s = 2; s < 8; ++s) qr[s] = qc[s];
    { const GAS f32x4* cp = (const GAS f32x4*)(ctab + t * 16 + 8 * hh); const GAS f32x4* sp = (const GAS f32x4*)(stab + t * 16 + 8 * hh);
        const f32x4 c0 = cp[0], c1 = cp[1], s0 = sp[0], s1 = sp[1];
        const float cs[8] = {c0.x, c0.y, c0.z, c0.w, c1.x, c1.y, c1.z, c1.w}, sn[8] = {s0.x, s0.y, s0.z, s0.w, s1.x, s1.y, s1.z, s1.w};
        bf16x8 r0, r1;
#pragma unroll
        for (int j = 0; j < 8; ++j) { const float x1 = bf2f((bf16)qc[0][j]), x2 = bf2f((bf16)qc[1][j]);
            r0[j] = (short)f2bf(x1 * cs[j] - x2 * sn[j]); r1[j] = (short)f2bf(x2 * cs[j] + x1 * sn[j]); }
        qr[0] = r0; qr[1] = r1; }
    { const TileSrc ks{p + (size_t)b * T * LDP + C_NKS + kv * 128, LDP}, vs{p + (size_t)b * T * LDP + C_NVS + kv * 128, LDP};
        attn_branch<BR_SEL, 1, 4>(F, ks, vs, 0, qb + 1, qr, t, gt[1], shs, selmask, yb, outp, imp_row); }
    { const TileSrc ks{p + (size_t)b * T * LDP + C_NKW + kv * 128, LDP}, vs{p + (size_t)b * T * LDP + C_NVW + kv * 128, LDP};
        attn_branch<BR_WIN, 2, 4>(F, ks, vs, qb >= 8 ? qb - 8 : 0, qb + 1, qr, t, gt[2], shw, 0ull, yb, outp, imp_row); }
}
constexpr int PH_PER_LAYER = 12, N_PHASES = 1 + DEPTH * PH_PER_LAYER;
#ifndef MK_ONE_LAUNCH
#define MK_ONE_LAUNCH 1
#endif
struct Args { const float* in[N_IN]; float* out; unsigned char* ws; int ph_lo, ph_hi; };
static_assert(sizeof(Args) == N_IN * 8 + 8 + 8 + 8, "Args has no padding bytes");

__global__ void __launch_bounds__(NWAVES * 64, 2) nsa_fwd(Args args) {
    extern __shared__ __attribute__((aligned(16))) unsigned char lds_raw[];
    Ctx F;
    F.lds = (LAS unsigned char*)lds_raw;
    F.tid = threadIdx.x; F.lane = 0  ; F.wave = __builtin_amdgcn_readfirstlane(F.tid >> 6);
    F.G = gridDim.x; { const int bx = blockIdx.x; F.vcu = (F.G % 8 == 0) ? (bx % 8) * (F.G / 8) + bx / 8 : bx; }
    F.ws = args.ws; F.ctl = (gu32*)(args.ws + WS_CTL);
    volatile LAS unsigned* MISC = (volatile LAS unsigned*)(F.lds + MISC_OFF);
    for (int u = F.tid; u < (LDS_BYTES - LDSCTL_OFF) / 4; u += NWAVES * 64) ((LAS unsigned*)(F.lds + LDSCTL_OFF))[u] = 0u;
    __syncthreads();
    XcdBarrier bar; bar.bar = (unsigned*)(F.ctl + CW_BAR); bar.x = 0; bar.st = nullptr;
    if (MK_ONE_LAUNCH) bar = xcd_barrier_post((unsigned*)(F.ctl + CW_BAR), MISC + 8);
    bar.wave = F.wave;
    F.tid = -1;
    const int lo = args.ph_lo, hi = args.ph_hi;
#ifndef PH_MASK
#define PH_MASK 0xFFFF
#endif
#define EN(j) (((PH_MASK) >> (j)) & 1)
#ifndef PH_DOUBLE
#define PH_DOUBLE 0
#endif
#define NREP(j) ((((PH_DOUBLE) >> (j)) & 1) ? 2 : 1)
#define IN(k) (lo <= (k) && (k) < hi)
#define SEAM(k) do { if (IN(k) && IN((k) + 1)) xcd_barrier(bar); } while (0)

    bf16* const HN = (bf16*)(F.ws + WS_HN); bf16* const HP = (bf16*)(F.ws + WS_HP); bf16* const MIX = (bf16*)(F.ws + WS_MIX);
    bf16* const KC = (bf16*)(F.ws + WS_KC); bf16* const VC = (bf16*)(F.ws + WS_VC);
    const float* const ctab = (const float*)(F.ws + WS_ROPE); const float* const stab = ctab + T * 16;
    bf16* const XB = (bf16*)(F.ws + WS_XB);

    if (EN(0) && IN(0)) for (int rep = 0; rep < NREP(0); ++rep) { if (rep) xcd_barrier(bar); p0_ffn_strips(F, args.in); p0_prologue(F, args.in); }
    SEAM(0);

    for (int l = 0; l < DEPTH; ++l) {
        const int pb = 1 + l * PH_PER_LAYER;
        if (pb + PH_PER_LAYER <= lo || pb >= hi) continue;
        const void* xin = (l == 0) ? (const void*)args.in[I_X] : (const void*)XB; const bool xin_f32 = (l == 0);
        if (EN(1) && IN(pb + 0)) for (int rep = 0; rep < NREP(1); ++rep) { if (rep) xcd_barrier(bar); rmsnorm_q8_phase(F, xin, xin_f32, args.in[I_F1N] + (size_t)l * D, (unsigned char*)HN, (float*)(F.ws + WS_SA), xin_f32 ? XB : nullptr); }
        SEAM(pb + 0);
        if (EN(2) && IN(pb + 1)) for (int rep = 0; rep < NREP(2); ++rep) { if (rep) xcd_barrier(bar); pg8::Gemm g{HN, (const bf16*)(F.ws + WS_WGU + (size_t)(l * 2 + 0) * SZ_WGU8), M, 2 * DFF, D / 2}; pg8::StaticOrder S; S.init(M, 2 * DFF, F.G, (int)blockIdx.x);
            pg8::EpiSwiGLU8 E{HP, DFF, (const float*)(F.ws + WS_SA), (const float*)(F.ctl + CW_CMAX) + (size_t)(l * 2 + 0) * 2 * DFF};
            pg8::gemm_phase<pg8::EpiSwiGLU8, pg8::StaticOrder, true, true>(F.lds, g, S, E, F.wave * 64 + lane_now()); }
        SEAM(pb + 1);
        if (EN(3) && IN(pb + 2)) {
            hidden_q8_phase(F, HP, F.ws + WS_HQ2, (float*)(F.ws + WS_SA2));
            xcd_barrier(bar);
            pg8::Gemm g{(const bf16*)(F.ws + WS_HQ2), (const bf16*)(F.ws + WS_WD + (size_t)(l * 2 + 0) * SZ_WD8), M, D, DFF / 2}; pg8::StaticOrder S; S.init(M, D, F.G, (int)blockIdx.x);
            pg8::EpiResid8 E{XB, XB, D, 0.5f, (const float*)(F.ws + WS_SA2), (const float*)(F.ctl + CW_CMAX2) + (size_t)(l * 2 + 0) * D, false, false};
            pg8::gemm_phase<pg8::EpiResid8, pg8::StaticOrder, true, true>(F.lds, g, S, E, F.wave * 64 + lane_now()); }
        SEAM(pb + 2);
        if (EN(4) && IN(pb + 3)) for (int rep = 0; rep < NREP(4); ++rep) { if (rep) xcd_barrier(bar); rmsnorm_q8_phase(F, XB, false, args.in[I_MIXN] + (size_t)l * D, (unsigned char*)HN, (float*)(F.ws + WS_SA)); }
        SEAM(pb + 3);
        if (EN(5) && IN(pb + 4)) for (int rep = 0; rep < NREP(5); ++rep) { if (rep) xcd_barrier(bar); pg8::Gemm g{HN, (const bf16*)(F.ws + WS_WIN + (size_t)l * SZ_WIN8), M, LDP, D / 2}; pg8::StaticOrder S; S.init(M, LDP, F.G, (int)blockIdx.x);
            pg8::EpiBf16Plain8 E{HP, LDP, (const float*)(F.ws + WS_SA), (const float*)(F.ctl + CW_CMAX3) + (size_t)l * LDP};
            pg8::gemm_phase<pg8::EpiBf16Plain8, pg8::StaticOrder, true, true>(F.lds, g, S, E, F.wave * 64 + lane_now()); }
        SEAM(pb + 4);
        if (EN(6) && IN(pb + 5)) {
            qknorm_rows(F, HP, args.in[I_QN] + l * 128, args.in[I_KSN] + l * 128, args.in[I_KWN] + l * 128, ctab, stab);
            compress_items(F, HP, args.in[I_PEK] + (size_t)l * 4096, args.in[I_PEV] + (size_t)l * 4096, (const bf16*)(F.ws + WS_W1 + (size_t)l * 2 * SZ_W1), (const bf16*)(F.ws + WS_W2 + (size_t)l * 2 * SZ_W2),
                           args.in[I_KCN] + l * 128, KC, VC);
        }
        SEAM(pb + 5);
        if (EN(7) && IN(pb + 6)) for (int rep = 0; rep < NREP(7); ++rep) { if (rep) xcd_barrier(bar);
            const int bid = blockIdx.x;
#ifndef MIX_PARTS
#define MIX_PARTS 7
#endif
#ifndef MIX_REP2
#define MIX_REP2 7
#endif
#define MIXP (rep ? (MIX_REP2) : (MIX_PARTS))
            if ((MIXP & 1) && bid < 64) lru_unit(F, bid >> 3, bid & 7, HP, MIX, args.in[I_CONVW] + (size_t)l * 4 * 512, args.in[I_CONVB] + l * 512, args.in[I_GAW] + (size_t)l * 8 * 4096, args.in[I_GAB] + l * 512,
                                   args.in[I_GXW] + (size_t)l * 8 * 4096, args.in[I_GXB] + l * 512, args.in[I_LAM] + l * 512);
            else if ((MIXP & 2) && bid < 96) gla_unit(F, (bid - 64) >> 2, (bid - 64) & 3, HP, MIX, args.in[I_AW2] + (size_t)l * 16 * 256, args.in[I_AB] + l * 256, args.in[I_GLAN] + l * 128);
            AT_LDS_BAR();
            const unsigned myq = xb_xcc_id() & 7u;
            float shc, shs, shw; attn_shifts(args.in[I_QN] + l * 128, args.in[I_KCN] + l * 128, args.in[I_KSN] + l * 128, args.in[I_KWN] + l * 128, shc, shs, shw);
            for (;;) {
                if (F.wave == 0 && lane_now() == 0) { int got = -1;
                    for (unsigned a = 0; a < 8u && got < 0; ++a) { const unsigned qx = (myq + a) & 7u;
                        const unsigned j = __hip_atomic_fetch_add(F.ctl + CW_QUEUE + 32 * ((l + DEPTH * rep) * 8 + qx), 1u, RLX_AGENT);
                        if (j < 128u) got = (int)(((2u * qx + (j & 1u)) << 8) | (63u - (j >> 1))); }
                    MISC[0] = (unsigned)got; }
                AT_LDS_BAR();
                const int it = (int)MISC[0];
                AT_LDS_BAR();
                if (it < 0) break;
                if (MIXP & 4) attn_unit(F, (it >> 8) >> 1, (it >> 8) & 1, it & 255, HP, MIX, KC, VC, args.in[I_GATEB] + l * 24, ctab, stab, (float*)HN, shc, shs, shw);
            }
        }
        SEAM(pb + 6);
        if (EN(8) && IN(pb + 7)) outnorm_phase(F, MIX, args.in[I_LRUN] + l * 512, args.in[I_NSAN] + l * 1024);
        SEAM(pb + 7);
        if (EN(9) && IN(pb + 8)) for (int rep = 0; rep < NREP(9); ++rep) { if (rep) xcd_barrier(bar); pg8::Gemm g{MIX, (const bf16*)(F.ws + WS_WOUT + (size_t)l * SZ_WOUT), M, D, D}; pg8::StaticOrder S; S.init(M, D, F.G, (int)blockIdx.x);
            pg8::EpiResid E{XB, XB, D, rep ? 0.f : 1.0f};
            pg8::gemm_phase<pg8::EpiResid, pg8::StaticOrder, true, true>(F.lds, g, S, E, F.wave * 64 + lane_now()); }
        SEAM(pb + 8);
        if (EN(10) && IN(pb + 9)) for (int rep = 0; rep < NREP(10); ++rep) { if (rep) xcd_barrier(bar); rmsnorm_q8_phase(F, XB, false, args.in[I_F2N] + (size_t)l * D, (unsigned char*)HN, (float*)(F.ws + WS_SA)); }
        SEAM(pb + 9);
        if (EN(11) && IN(pb + 10)) for (int rep = 0; rep < NREP(11); ++rep) { if (rep) xcd_barrier(bar); pg8::Gemm g{HN, (const bf16*)(F.ws + WS_WGU + (size_t)(l * 2 + 1) * SZ_WGU8), M, 2 * DFF, D / 2}; pg8::StaticOrder S; S.init(M, 2 * DFF, F.G, (int)blockIdx.x);
            pg8::EpiSwiGLU8 E{HP, DFF, (const float*)(F.ws + WS_SA), (const float*)(F.ctl + CW_CMAX) + (size_t)(l * 2 + 1) * 2 * DFF};
            pg8::gemm_phase<pg8::EpiSwiGLU8, pg8::StaticOrder, true, true>(F.lds, g, S, E, F.wave * 64 + lane_now()); }
        SEAM(pb + 10);
        if (EN(12) && IN(pb + 11)) {
            hidden_q8_phase(F, HP, F.ws + WS_HQ2, (float*)(F.ws + WS_SA2));
            xcd_barrier(bar);
            pg8::Gemm g{(const bf16*)(F.ws + WS_HQ2), (const bf16*)(F.ws + WS_WD + (size_t)(l * 2 + 1) * SZ_WD8), M, D, DFF / 2}; pg8::StaticOrder S; S.init(M, D, F.G, (int)blockIdx.x);
            const bool last = (l + 1 == DEPTH);
            pg8::EpiResid8 E{XB, last ? (void*)args.out : (void*)XB, D, 0.5f, (const float*)(F.ws + WS_SA2), (const float*)(F.ctl + CW_CMAX2) + (size_t)(l * 2 + 1) * D, false, last};
            pg8::gemm_phase<pg8::EpiResid8, pg8::StaticOrder, true, true>(F.lds, g, S, E, F.wave * 64 + lane_now()); }
        SEAM(pb + 11);
    }
#undef IN
#undef SEAM
}

extern "C" void kernel_launch(void* const* d_in, const int* in_sizes, int n_in, void* d_out, int out_size, void* d_ws, size_t ws_size, hipStream_t stream) {
    static int grid = 0;
    if (grid == 0) {
        if (n_in != N_IN || in_sizes[0] != M * D || out_size != M * D || ws_size < WS_END) {
            fprintf(stderr, "kernel_launch: built for %d inputs, x/out of %d floats, >= %zu bytes of workspace; got n_in %d, in0 %d, out %d, ws %zu; nothing launched\n", N_IN, M * D, (size_t)WS_END, n_in, n_in > 0 ? in_sizes[0] : -1, out_size, ws_size);
            grid = -1; return; }
        int dev = 0, cus = 0, per_cu = 0;
        if (hipGetDevice(&dev) != hipSuccess || hipDeviceGetAttribute(&cus, hipDeviceAttributeMultiprocessorCount, dev) != hipSuccess) { fprintf(stderr, "kernel_launch: device query failed\n"); grid = -1; return; }
        if (hipFuncSetAttribute((const void*)nsa_fwd, hipFuncAttributeMaxDynamicSharedMemorySize, LDS_BYTES) != hipSuccess) { fprintf(stderr, "kernel_launch: hipFuncSetAttribute failed\n"); grid = -1; return; }
        if (hipOccupancyMaxActiveBlocksPerMultiprocessor(&per_cu, (const void*)nsa_fwd, NWAVES * 64, LDS_BYTES) != hipSuccess || per_cu < 1)
            fprintf(stderr, "kernel_launch: note: occupancy query reports %d workgroups per CU\n", per_cu);
        (void)hipGetLastError();
        grid = cus;
    }
    if (grid < 0) return;
    if (hipMemsetAsync((char*)d_ws + WS_CTL, 0, CTL_ZERO_BYTES, stream) != hipSuccess) { fprintf(stderr, "kernel_launch: memset failed\n"); return; }
    Args a{};
    for (int i = 0; i < N_IN; ++i) a.in[i] = (const float*)d_in[i];
    a.out = (float*)d_out; a.ws = (unsigned char*)d_ws;
#if MK_ONE_LAUNCH
    a.ph_lo = 0; a.ph_hi = N_PHASES;
    hipLaunchKernelGGL(nsa_fwd, dim3(grid), dim3(NWAVES * 64), LDS_BYTES, stream, a);
#else
    for (int ph = 0; ph < N_PHASES; ++ph) { a.ph_lo = ph; a.ph_hi = ph + 1; hipLaunchKernelGGL(nsa_fwd, dim3(grid), dim3(NWAVES * 64), LDS_BYTES, stream, a); }
#endif
    const hipError_t le = hipPeekAtLastError();
    if (le != hipSuccess) fprintf(stderr, "kernel_launch: launch failed: %s\n", hipGetErrorName(le));
}
```
